# Optimizing an MI355X kernel written in HIP

```python
import math
import jax
import jax.numpy as jnp
from jax import lax
import numpy as np

D_MODEL = 1024
BATCH = 4
SEQ = 8192
DEPTH = 1

CHUNK = 64
Q_BLOCK = 128
EPS = 1e-6

A_HEADS = 8
A_HEAD_DIM = 64
A_Q_LORA = 256
A_KV_LORA = 256
IDX_HEADS = 8
IDX_DIM = 64
IDX_TOPK_MAX = 256
ATTN_SCALE = A_HEAD_DIM ** -0.5
IDX_SCALE = (IDX_HEADS * IDX_DIM) ** -0.5

B_HEADS = 4
B_HEAD_DIM = 128
B_QK = B_HEADS * B_HEAD_DIM
CONV_WIDTH = 4

REL_BUCKETS = 32
REL_MAX_DIST = 128

MEM_LEN = 256
X_HEADS = 4
X_HEAD_DIM = 128

P_HEADS = 8
N_KEYS = 128
N_EXPERTS = N_KEYS * N_KEYS
P_TOPK = 16
P_QDIM = 256
P_TOKEN_BLOCK = 128

COL_WIDTHS = (A_Q_LORA, A_KV_LORA, IDX_DIM, IDX_HEADS, B_QK, B_QK, B_QK, B_QK, B_HEADS, B_HEADS)
IN_COLS = sum(COL_WIDTHS)
MIX_WIDTH = A_HEADS * A_HEAD_DIM + B_HEADS * B_HEAD_DIM

kernel_name = 'hybrid_dsa_gdn_peer_block'


def rmsnorm(x, g):
    xf = x.astype(jnp.float32)
    y = xf * lax.rsqrt(jnp.mean(xf * xf, axis=-1, keepdims=True) + EPS)
    return (y * g.astype(jnp.float32)).astype(x.dtype)


def l2norm(x):
    return x * lax.rsqrt(jnp.sum(x * x, axis=-1, keepdims=True) + EPS)


def split_columns(p, widths):
    out, start = [], 0
    for w in widths:
        out.append(p[..., start:start + w])
        start += w
    return out


def t5_bucket(rel):
    half = REL_BUCKETS // 2
    max_exact = half // 2
    n = jnp.abs(rel)
    nf = jnp.maximum(n, max_exact).astype(jnp.float32)
    large = max_exact + (jnp.log(nf / max_exact) / math.log(REL_MAX_DIST / max_exact)
                         * (half - max_exact)).astype(jnp.int32)
    large = jnp.minimum(large, half - 1)
    return jnp.where(rel > 0, half, 0) + jnp.where(n < max_exact, n, large)


def dsa_attention(cq, ckv, kidx, widx, g_cq, g_ckv, g_kidx, w_uq, w_iq, w_uk, w_uv, rel_bias):
    bsz, seq, _ = cq.shape
    topk = min(IDX_TOPK_MAX, seq // 4)
    n_blocks = seq // Q_BLOCK
    cq = rmsnorm(cq, g_cq)
    ckv = rmsnorm(ckv, g_ckv)
    kidx = rmsnorm(kidx, g_kidx).astype(jnp.float32)
    key_pos = jnp.arange(seq, dtype=jnp.int32)

    def blockify(a):
        return jnp.moveaxis(a.reshape(bsz, n_blocks, Q_BLOCK, a.shape[-1]), 1, 0)

    def one_block(args):
        cq_b, w_b, start = args
        qpos = start + jnp.arange(Q_BLOCK, dtype=jnp.int32)
        limit = (qpos // CHUNK + 1) * CHUNK
        admissible = key_pos[None, :] < limit[:, None]
        qi = jnp.einsum('bqc,chd->bqhd', cq_b, w_iq).astype(jnp.float32)
        dots = jax.nn.relu(jnp.einsum('bqhd,bsd->bqhs', qi, kidx))
        score = jnp.einsum('bqh,bqhs->bqs', w_b.astype(jnp.float32) * IDX_SCALE, dots)
        score = jnp.where(admissible[None], score, -jnp.inf)
        _, sel = lax.top_k(score, topk)
        valid = sel < limit[None, :, None]
        c_sel = jax.vmap(lambda c, i: c[i])(ckv, sel)
        q = jnp.einsum('bqc,chd->bqhd', cq_b, w_uq)
        q_lat = jnp.einsum('bqhd,chd->bqhc', q, w_uk)
        logits = jnp.einsum('bqhc,bqkc->bhqk', q_lat, c_sel).astype(jnp.float32) * ATTN_SCALE
        bias = rel_bias[t5_bucket(sel - qpos[None, :, None])].astype(jnp.float32)
        logits = logits + jnp.transpose(bias, (0, 3, 1, 2))
        logits = jnp.where(valid[:, None], logits, -jnp.inf)
        p = jax.nn.softmax(logits, axis=-1).astype(c_sel.dtype)
        o_lat = jnp.einsum('bhqk,bqkc->bqhc', p, c_sel)
        o = jnp.einsum('bqhc,chd->bqhd', o_lat, w_uv)
        return o.reshape(bsz, Q_BLOCK, A_HEADS * A_HEAD_DIM)

    starts = jnp.arange(n_blocks, dtype=jnp.int32) * Q_BLOCK
    o = lax.map(one_block, (blockify(cq), blockify(widx), starts))
    return jnp.moveaxis(o, 0, 1).reshape(bsz, seq, A_HEADS * A_HEAD_DIM)


def causal_dwconv(x, w):
    ch = x.shape[-1]
    return lax.conv_general_dilated(x, w[:, None, :].astype(x.dtype), window_strides=(1,),
                                    padding=[(CONV_WIDTH - 1, 0)],
                                    dimension_numbers=('NWC', 'WIO', 'NWC'),
                                    feature_group_count=ch)


def gated_deltanet(q, k, v, z, a, b, conv_w, A_log, dt_bias, g_onorm):
    bsz, seq, _ = q.shape
    f32 = jnp.float32
    H, Dh = B_HEADS, B_HEAD_DIM
    nc = seq // CHUNK
    qkv = jax.nn.silu(causal_dwconv(jnp.concatenate([q, k, v], axis=-1), conv_w)).astype(f32)
    q, k, v = [t.reshape(bsz, seq, H, Dh) for t in jnp.split(qkv, 3, axis=-1)]
    q = l2norm(q) * (Dh ** -0.5)
    k = l2norm(k)
    beta = jax.nn.sigmoid(b.astype(f32))
    g = -jnp.exp(A_log.astype(f32)) * jax.nn.softplus(a.astype(f32) + dt_bias.astype(f32))

    def to_chunks(t):
        t = t.reshape(bsz, nc, CHUNK, *t.shape[2:])
        return jnp.moveaxis(t, 3, 1)

    q, k, v, beta = to_chunks(q), to_chunks(k), to_chunks(v), to_chunks(beta)
    g = jnp.cumsum(to_chunks(g), axis=-1)
    pos = jnp.arange(CHUNK)
    causal = pos[:, None] >= pos[None, :]
    strict = pos[:, None] > pos[None, :]
    decay = jnp.exp(jnp.where(causal, g[..., :, None] - g[..., None, :], -jnp.inf))
    m = jnp.where(strict, beta[..., :, None] * jnp.einsum('bhnid,bhnjd->bhnij', k, k) * decay, 0.0)
    rhs = jnp.concatenate([v * beta[..., None], k * (beta * jnp.exp(g))[..., None]], axis=-1)
    sol = lax.linalg.triangular_solve(m, rhs, left_side=True, lower=True, unit_diagonal=True)
    u, w = sol[..., :Dh], sol[..., Dh:]
    intra = jnp.einsum('bhnid,bhnjd->bhnij', q, k) * decay
    q_dec = q * jnp.exp(g)[..., None]
    k_tail = k * jnp.exp(g[..., -1:] - g)[..., None]
    chunk_decay = jnp.exp(g[..., -1])

    def step(state, inp):
        q_c, u_c, w_c, a_c, kt_c, d_c = inp
        v_new = u_c - jnp.einsum('bhcd,bhde->bhce', w_c, state)
        o_c = jnp.einsum('bhcd,bhde->bhce', q_c, state) + jnp.einsum('bhij,bhje->bhie', a_c, v_new)
        state = state * d_c[..., None, None] + jnp.einsum('bhcd,bhce->bhde', kt_c, v_new)
        return state, o_c

    xs = tuple(jnp.moveaxis(t, 2, 0) for t in (q_dec, u, w, intra, k_tail, chunk_decay))
    _, o = lax.scan(step, jnp.zeros((bsz, H, Dh, Dh), f32), xs)
    o = jnp.transpose(o, (1, 0, 3, 2, 4)).reshape(bsz, seq, H, Dh)
    o = o * lax.rsqrt(jnp.mean(o * o, axis=-1, keepdims=True) + EPS) * g_onorm.astype(f32)
    o = o * jax.nn.silu(z.astype(f32).reshape(bsz, seq, H, Dh))
    return o.reshape(bsz, seq, H * Dh).astype(z.dtype)


def memory_cross_attention(h, mem_n, wq, wk, wv, wo):
    q = jnp.einsum('bsd,dhe->bhse', h, wq)
    k = jnp.einsum('bmd,dhe->bhme', mem_n, wk)
    v = jnp.einsum('bmd,dhe->bhme', mem_n, wv)
    logits = jnp.einsum('bhse,bhme->bhsm', q, k).astype(jnp.float32) * (X_HEAD_DIM ** -0.5)
    p = jax.nn.softmax(logits, axis=-1).astype(v.dtype)
    o = jnp.einsum('bhsm,bhme->bshe', p, v)
    return jnp.einsum('bshe,hed->bsd', o, wo)


def peer_ffn(h, w_pq, sub_keys, u_emb, v_emb):
    bsz, seq, d = h.shape
    n_tok = bsz * seq
    hb = h.reshape(n_tok // P_TOKEN_BLOCK, P_TOKEN_BLOCK, d)

    def one_block(xb):
        n = xb.shape[0]
        qr = jnp.einsum('nd,dhe->nhe', xb, w_pq).reshape(n, P_HEADS, 2, P_QDIM // 2)
        s = jnp.einsum('nhpe,hpke->nhpk', qr, sub_keys).astype(jnp.float32)
        s1, i1 = lax.top_k(s[:, :, 0], P_TOPK)
        s2, i2 = lax.top_k(s[:, :, 1], P_TOPK)
        cand = (s1[..., :, None] + s2[..., None, :]).reshape(n, P_HEADS, P_TOPK * P_TOPK)
        cidx = (i1[..., :, None] * N_KEYS + i2[..., None, :]).reshape(n, P_HEADS, P_TOPK * P_TOPK)
        best, pos = lax.top_k(cand, P_TOPK)
        eidx = jnp.take_along_axis(cidx, pos, axis=-1)
        gate = jax.nn.softmax(best, axis=-1).astype(xb.dtype)
        act = jax.nn.gelu(jnp.einsum('nhkd,nd->nhk', u_emb[eidx], xb), approximate=False)
        return jnp.einsum('nhk,nhkd->nd', gate * act, v_emb[eidx])

    return lax.map(one_block, hb).reshape(bsz, seq, d)


def setup_inputs(seed: int = 0) -> dict:
    key = jax.random.key(seed)
    ks = jax.random.split(key, 32)
    f32 = jnp.float32
    L = DEPTH

    def nrm(k, shape, scale):
        return jax.random.normal(k, shape, f32) * scale

    def gain(k, shape):
        return 1.0 + 0.02 * jax.random.normal(k, shape, f32)

    dt = jnp.exp(jax.random.uniform(ks[14], (L, B_HEADS), f32, math.log(1e-3), math.log(1e-1)))
    return {
        'x': nrm(ks[0], (BATCH, SEQ, D_MODEL), 1.0),
        'mem': nrm(ks[1], (BATCH, MEM_LEN, D_MODEL), 1.0),
        'g_mix': gain(ks[2], (L, D_MODEL)),
        'w_in': nrm(ks[3], (L, D_MODEL, IN_COLS), D_MODEL ** -0.5),
        'g_cq': gain(ks[4], (L, A_Q_LORA)),
        'g_ckv': gain(ks[5], (L, A_KV_LORA)),
        'g_kidx': gain(ks[6], (L, IDX_DIM)),
        'w_uq': nrm(ks[7], (L, A_Q_LORA, A_HEADS, A_HEAD_DIM), A_Q_LORA ** -0.5),
        'w_iq': nrm(ks[8], (L, A_Q_LORA, IDX_HEADS, IDX_DIM), A_Q_LORA ** -0.5),
        'w_uk': nrm(ks[9], (L, A_KV_LORA, A_HEADS, A_HEAD_DIM), A_KV_LORA ** -0.5),
        'w_uv': nrm(ks[10], (L, A_KV_LORA, A_HEADS, A_HEAD_DIM), A_KV_LORA ** -0.5),
        'rel_bias': nrm(ks[11], (REL_BUCKETS, A_HEADS), 0.3),
        'conv_w': nrm(ks[12], (L, CONV_WIDTH, 3 * B_QK), CONV_WIDTH ** -0.5),
        'A_log': jnp.log(jax.random.uniform(ks[13], (L, B_HEADS), f32, 1.0, 16.0)),
        'dt_bias': dt + jnp.log(-jnp.expm1(-dt)),
        'g_onorm': gain(ks[15], (L, B_HEAD_DIM)),
        'w_out': nrm(ks[16], (L, MIX_WIDTH, D_MODEL), MIX_WIDTH ** -0.5),
        'g_cross': gain(ks[17], (L, D_MODEL)),
        'g_mem': gain(ks[18], (L, D_MODEL)),
        'wq_x': nrm(ks[19], (L, D_MODEL, X_HEADS, X_HEAD_DIM), D_MODEL ** -0.5),
        'wk_x': nrm(ks[20], (L, D_MODEL, X_HEADS, X_HEAD_DIM), D_MODEL ** -0.5),
        'wv_x': nrm(ks[21], (L, D_MODEL, X_HEADS, X_HEAD_DIM), D_MODEL ** -0.5),
        'wo_x': nrm(ks[22], (L, X_HEADS, X_HEAD_DIM, D_MODEL), (X_HEADS * X_HEAD_DIM) ** -0.5),
        'g_ffn': gain(ks[23], (L, D_MODEL)),
        'w_pq': nrm(ks[24], (L, D_MODEL, P_HEADS, P_QDIM), D_MODEL ** -0.5),
        'sub_keys': nrm(ks[25], (L, P_HEADS, 2, N_KEYS, P_QDIM // 2), (P_QDIM // 2) ** -0.5),
        'u_emb': nrm(ks[26], (L, N_EXPERTS, D_MODEL), D_MODEL ** -0.5),
        'v_emb': nrm(ks[27], (L, N_EXPERTS, D_MODEL), P_HEADS ** -0.5),
        'g_final': gain(ks[28], (D_MODEL,)),
    }


def reference(x, mem, g_mix, w_in, g_cq, g_ckv, g_kidx, w_uq, w_iq, w_uk, w_uv, rel_bias, conv_w, A_log, dt_bias, g_onorm, w_out, g_cross, g_mem, wq_x, wk_x, wv_x, wo_x, g_ffn, w_pq, sub_keys, u_emb, v_emb, g_final):
    for l in range(DEPTH):
        h = rmsnorm(x, g_mix[l])
        proj = jnp.einsum('bsd,dc->bsc', h, w_in[l])
        cq, ckv, kidx, widx, bq, bk, bv, bz, ba, bb = split_columns(proj, COL_WIDTHS)
        o_a = dsa_attention(cq, ckv, kidx, widx, g_cq[l], g_ckv[l], g_kidx[l],
                            w_uq[l], w_iq[l], w_uk[l], w_uv[l], rel_bias)
        o_b = gated_deltanet(bq, bk, bv, bz, ba, bb, conv_w[l], A_log[l], dt_bias[l], g_onorm[l])
        x = x + jnp.einsum('bsc,cd->bsd', jnp.concatenate([o_a, o_b], axis=-1), w_out[l])
        x = x + memory_cross_attention(rmsnorm(x, g_cross[l]), rmsnorm(mem, g_mem[l]),
                                       wq_x[l], wk_x[l], wv_x[l], wo_x[l])
        x = x + peer_ffn(rmsnorm(x, g_ffn[l]), w_pq[l], sub_keys[l], u_emb[l], v_emb[l])
    return rmsnorm(x, g_final)
```

```cpp
#include <hip/hip_runtime.h>
#include <stdint.h>
#include <stdio.h>

typedef unsigned short u16;
typedef __attribute__((ext_vector_type(8))) short bf16x8;
typedef __attribute__((ext_vector_type(4))) short s16x4;
typedef __attribute__((ext_vector_type(4))) float f32x4;
typedef __attribute__((ext_vector_type(4))) unsigned u32x4;
typedef __attribute__((ext_vector_type(2))) unsigned u32x2;
#define LAS __attribute__((address_space(3)))

#define T_TOK 32768
#define SEQ 8192
#define NB 4
#define DM 1024
#define NTHR 512
#define EPSV 1e-6f

__device__ __forceinline__ u16 f2bf(float f) { __bf16 b = (__bf16)f; return __builtin_bit_cast(u16, b); }
__device__ __forceinline__ float bf2f(u16 h) { return __uint_as_float(((unsigned)h) << 16); }
__device__ __forceinline__ unsigned pack2(float a, float b) { return (unsigned)f2bf(a) | ((unsigned)f2bf(b) << 16); }
__device__ __forceinline__ float lo2f(unsigned v) { return __uint_as_float(v << 16); }
__device__ __forceinline__ float hi2f(unsigned v) { return __uint_as_float(v & 0xffff0000u); }
__device__ __forceinline__ float wave_sum(float v) {
#pragma unroll
  for (int o = 32; o >= 1; o >>= 1) v += __shfl_xor(v, o);
  return v;
}
__device__ __forceinline__ f32x4 mfma16(bf16x8 a, bf16x8 b, f32x4 c) { return __builtin_amdgcn_mfma_f32_16x16x32_bf16(a, b, c, 0, 0, 0); }
__device__ __forceinline__ unsigned umed3(unsigned a, unsigned b, unsigned c) { unsigned r; asm("v_med3_u32 %0, %1, %2, %3" : "=v"(r) : "v"(a), "v"(b), "v"(c)); return r; }
__device__ __forceinline__ unsigned fkey(float f) { unsigned u = __float_as_uint(f); return u ^ ((u >> 31) ? 0xffffffffu : 0x80000000u); }
__device__ __forceinline__ float keyf(unsigned m) { unsigned u = (m & 0x80000000u) ? (m ^ 0x80000000u) : ~m; return __uint_as_float(u); }

#define MB (1024ull * 1024ull)
#define OFF_BAR      0ull
#define OFF_WINT     (1 * MB)
#define OFF_WG2T     (7 * MB)
#define OFF_WUQ      (9 * MB)
#define OFF_WUK      (9 * MB + 512 * 1024)
#define OFF_WUVT     (10 * MB)
#define OFF_WOUTT    (11 * MB)
#define OFF_WQT      (13 * MB)
#define OFF_WKT      (14 * MB)
#define OFF_WVT      (15 * MB)
#define OFF_WOT      (16 * MB)
#define OFF_WPQ      (17 * MB)
#define OFF_SUBK     (21 * MB)
#define OFF_WEFFT    (22 * MB)
#define OFF_MEMN     (26 * MB)
#define OFF_KX       (28 * MB)
#define OFF_VTX      (29 * MB)
#define OFF_KIDXN    (30 * MB)
#define OFF_WIDX     (34 * MB)
#define OFF_GB       (35 * MB)
#define OFF_INTRA    (37 * MB)
#define OFF_WDN      (53 * MB)
#define OFF_SEL      (85 * MB)
#define OFF_H        (101 * MB)
#define OFF_QI       (OFF_H)
#define OFF_CQN      (OFF_H + 32 * MB)
#define OFF_CKVN     (OFF_H + 48 * MB)
#define OFF_PA       (165 * MB)
#define OFF_PB       (205 * MB)
#define OFF_SCORES   (OFF_PA)
#define OFF_UEMB     (OFF_PA)
#define OFF_VEMB     (OFF_PA + 32 * MB)
#define OFF_BZ       (301 * MB)
#define OFF_QKV      (333 * MB)
#define OFF_QX       (OFF_QKV)
#define OFF_OX       (OFF_QKV + 32 * MB)
#define OFF_PLIST    (OFF_QKV + 64 * MB)
#define OFF_MIX      (429 * MB)
#define WS_NEED      (493 * MB)

struct CvtJob { const float* src; u16* dst; int R, C; long sld, dld; float scale; int transpose; };
#define MAXJOBS 24
struct CvtJobs { CvtJob j[MAXJOBS]; int n; int pad; };

__device__ void cvt_run(const CvtJobs& J, char* smem, int bid, int nblk) {
  float* tile = (float*)smem;
  for (int ji = 0; ji < J.n; ++ji) {
    const CvtJob jb = J.j[ji];
    if (!jb.transpose) {
      const long nvec = (long)jb.R * (jb.C >> 2);
      const int cv = jb.C >> 2;
      for (long i = (long)bid * NTHR + threadIdx.x; i < nvec; i += (long)nblk * NTHR) {
        const long r = i / cv; const int c = (int)(i - r * cv) * 4;
        const float4 v = *(const float4*)(jb.src + r * jb.sld + c);
        u32x2 o; o[0] = pack2(v.x * jb.scale, v.y * jb.scale); o[1] = pack2(v.z * jb.scale, v.w * jb.scale);
        *(u32x2*)(jb.dst + r * jb.dld + c) = o;
      }
    } else {
      const int tr = (jb.R + 63) >> 6, tc = (jb.C + 63) >> 6;
      for (int t = bid; t < tr * tc; t += nblk) {
        const int r0 = (t / tc) * 64, c0 = (t % tc) * 64;
        __syncthreads();
        for (int i = threadIdx.x; i < 4096; i += NTHR) {
          const int r = i >> 6, c = i & 63;
          float v = 0.f;
          if (r0 + r < jb.R && c0 + c < jb.C) v = jb.src[(long)(r0 + r) * jb.sld + c0 + c];
          tile[r * 65 + c] = v;
        }
        __syncthreads();
        for (int i = threadIdx.x; i < 4096; i += NTHR) {
          const int c = i >> 6, r = i & 63;
          if (r0 + r < jb.R && c0 + c < jb.C) jb.dst[(long)(c0 + c) * jb.dld + r0 + r] = f2bf(tile[r * 65 + c] * jb.scale);
        }
      }
    }
  }
}

__device__ void rmsnorm_rows(const float* src, const float* g, u16* dst, int nrows, int bid, int nblk) {
  const int lane = threadIdx.x & 63, wv = threadIdx.x >> 6;
  for (int r = bid * 8 + wv; r < nrows; r += nblk * 8) {
    const float* p = src + (long)r * DM;
    float4 v[4]; float ss = 0.f;
#pragma unroll
    for (int i = 0; i < 4; ++i) { v[i] = *(const float4*)(p + i * 256 + lane * 4); ss += v[i].x * v[i].x + v[i].y * v[i].y + v[i].z * v[i].z + v[i].w * v[i].w; }
    ss = wave_sum(ss);
    const float rs = rsqrtf(ss * (1.f / DM) + EPSV);
#pragma unroll
    for (int i = 0; i < 4; ++i) {
      const float4 gg = *(const float4*)(g + i * 256 + lane * 4);
      u32x2 o; o[0] = pack2(v[i].x * rs * gg.x, v[i].y * rs * gg.y); o[1] = pack2(v[i].z * rs * gg.z, v[i].w * rs * gg.w);
      *(u32x2*)(dst + (long)r * DM + i * 256 + lane * 4) = o;
    }
  }
}

template <int LDC>
__device__ __forceinline__ void gemm_tile(const u16* __restrict__ A, long lda, const u16* __restrict__ Bt, long ldb, int K, char* smem) {
  const int tid = threadIdx.x, lane = tid & 63, wv = tid >> 6, lr = lane & 15, g = lane >> 4;
  const int wm = wv >> 1, wn = wv & 1;
  f32x4 acc[4][4];
#pragma unroll
  for (int i = 0; i < 4; ++i)
#pragma unroll
    for (int j = 0; j < 4; ++j) acc[i][j] = (f32x4){0.f, 0.f, 0.f, 0.f};
  u32x4 ra[4], rb[2];
  const int nk = K >> 6;
  const int srow = tid >> 3, sch = tid & 7;
  const u16* pa = A + (long)srow * lda + sch * 8;
  const u16* pb = Bt + (long)srow * ldb + sch * 8;
  const unsigned lds_off = (unsigned)(srow * 128 + ((sch ^ (srow & 7)) << 4));
#pragma unroll
  for (int i = 0; i < 4; ++i) ra[i] = *(const u32x4*)(pa + (long)(i * 64) * lda);
#pragma unroll
  for (int i = 0; i < 2; ++i) rb[i] = *(const u32x4*)(pb + (long)(i * 64) * ldb);
  __syncthreads();
#pragma unroll
  for (int i = 0; i < 4; ++i) *(u32x4*)(smem + lds_off + i * 8192) = ra[i];
#pragma unroll
  for (int i = 0; i < 2; ++i) *(u32x4*)(smem + 32768 + lds_off + i * 8192) = rb[i];
  __syncthreads();
  for (int kt = 0; kt < nk; ++kt) {
    const char* sA = smem + (kt & 1) * 49152;
    const char* sB = sA + 32768;
    if (kt + 1 < nk) {
#pragma unroll
      for (int i = 0; i < 4; ++i) ra[i] = *(const u32x4*)(pa + (long)(i * 64) * lda + (kt + 1) * 64);
#pragma unroll
      for (int i = 0; i < 2; ++i) rb[i] = *(const u32x4*)(pb + (long)(i * 64) * ldb + (kt + 1) * 64);
    }
#pragma unroll
    for (int ks = 0; ks < 2; ++ks) {
      bf16x8 a[4], b[4];
#pragma unroll
      for (int mi = 0; mi < 4; ++mi) { const int row = wm * 64 + mi * 16 + lr; a[mi] = *(const bf16x8*)(sA + row * 128 + (((ks * 4 + g) ^ (row & 7)) << 4)); }
#pragma unroll
      for (int ni = 0; ni < 4; ++ni) { const int row = wn * 64 + ni * 16 + lr; b[ni] = *(const bf16x8*)(sB + row * 128 + (((ks * 4 + g) ^ (row & 7)) << 4)); }
#pragma unroll
      for (int mi = 0; mi < 4; ++mi)
#pragma unroll
        for (int ni = 0; ni < 4; ++ni) acc[mi][ni] = mfma16(a[mi], b[ni], acc[mi][ni]);
    }
    if (kt + 1 < nk) {
      char* dA = smem + ((kt + 1) & 1) * 49152;
#pragma unroll
      for (int i = 0; i < 4; ++i) *(u32x4*)(dA + lds_off + i * 8192) = ra[i];
#pragma unroll
      for (int i = 0; i < 2; ++i) *(u32x4*)(dA + 32768 + lds_off + i * 8192) = rb[i];
    }
    __syncthreads();
  }
  float* sC = (float*)smem;
#pragma unroll
  for (int mi = 0; mi < 4; ++mi)
#pragma unroll
    for (int ni = 0; ni < 4; ++ni)
#pragma unroll
      for (int r = 0; r < 4; ++r) sC[(wm * 64 + mi * 16 + g * 4 + r) * LDC + wn * 64 + ni * 16 + lr] = acc[mi][ni][r];
  __syncthreads();
}

__device__ __forceinline__ void epi_store_bf16(const char* smem, u16* C, long ldc, float scale, int ncols) {
  const float* sC = (const float*)smem;
  const int cv = ncols >> 2;
  for (int i = threadIdx.x; i < 256 * cv; i += NTHR) {
    const int r = i / cv, c = (i - r * cv) * 4;
    const float4 v = *(const float4*)(sC + r * 132 + c);
    u32x2 o; o[0] = pack2(v.x * scale, v.y * scale); o[1] = pack2(v.z * scale, v.w * scale);
    *(u32x2*)(C + (long)r * ldc + c) = o;
  }
}
__device__ __forceinline__ void epi_resid_f32(const char* smem, const float* R, float* C, long ldc) {
  const float* sC = (const float*)smem;
  for (int i = threadIdx.x; i < 256 * 32; i += NTHR) {
    const int r = i >> 5, c = (i & 31) * 4;
    const float4 v = *(const float4*)(sC + r * 132 + c);
    const float4 x = *(const float4*)(R + (long)r * ldc + c);
    float4 o; o.x = v.x + x.x; o.y = v.y + x.y; o.z = v.z + x.z; o.w = v.w + x.w;
    *(float4*)(C + (long)r * ldc + c) = o;
  }
}

struct Params {
  const float *x, *mem, *g_mix, *w_in, *g_cq, *g_ckv, *g_kidx, *w_uq, *w_iq, *w_uk, *w_uv, *rel_bias, *conv_w, *A_log, *dt_bias, *g_onorm,
      *w_out, *g_cross, *g_mem, *wq_x, *wk_x, *wv_x, *wo_x, *g_ffn, *w_pq, *sub_keys, *u_emb, *v_emb, *g_final;
  float* out;
  char* ws;
};

__global__ void __launch_bounds__(NTHR, 2) k_cvt(CvtJobs J) {
  extern __shared__ __attribute__((aligned(16))) char smem[];
  cvt_run(J, smem, blockIdx.x, gridDim.x);
}
__global__ void __launch_bounds__(NTHR, 2) k_norm(const float* src, const float* g, u16* dst, int nrows) { rmsnorm_rows(src, g, dst, nrows, blockIdx.x, gridDim.x); }

struct GemmP { const u16* A; long lda, a_bs; const u16* Bt; long ldb, b_bs; u16* C; long ldc, c_bs; int M, N, K, nbatch; float scale; int ncols; int tstore; };
__device__ void gemm_bf16_phase(const GemmP& p, char* smem, int bid, int nblk) {
  const int nm = p.M >> 8, nn = p.N >> 7, per = nm * nn;
  for (int t = bid; t < per * p.nbatch; t += nblk) {
    const int b = t / per, r = t - b * per, mp = r / nn, np = r - mp * nn;
    gemm_tile<132>(p.A + b * p.a_bs + (long)mp * 256 * p.lda, p.lda, p.Bt + b * p.b_bs + (long)np * 128 * p.ldb, p.ldb, p.K, smem);
    if (!p.tstore) epi_store_bf16(smem, p.C + b * p.c_bs + (long)mp * 256 * p.ldc + np * 128, p.ldc, p.scale, p.ncols);
    else {
      const float* sC = (const float*)smem;
      u16* C = p.C + b * p.c_bs + (long)np * 128 * p.ldc + mp * 256;
      for (int i = threadIdx.x; i < 256 * 128; i += NTHR) { const int n = i >> 8, m = i & 255; C[(long)n * p.ldc + m] = f2bf(sC[m * 132 + n] * p.scale); }
    }
  }
}
__global__ void __launch_bounds__(NTHR, 2) k_gemm_bf16(GemmP p) {
  extern __shared__ __attribute__((aligned(16))) char smem[];
  gemm_bf16_phase(p, smem, blockIdx.x, gridDim.x);
}

__device__ void g1_phase(const Params& P, char* smem, int bid, int nblk) {
  const u16* A = (const u16*)(P.ws + OFF_H); const u16* Bt = (const u16*)(P.ws + OFF_WINT);
  for (int t = bid; t < 128 * 21; t += nblk) {
    const int mp = t / 21, np = t - mp * 21;
    gemm_tile<132>(A + (long)mp * 256 * DM, DM, Bt + (long)np * 128 * DM, DM, DM, smem);
    u16* C; long ldc;
    if (np < 5) { C = (u16*)(P.ws + OFF_PA) + np * 128; ldc = 640; }
    else if (np < 17) { C = (u16*)(P.ws + OFF_PB) + (np - 5) * 128; ldc = 1536; }
    else { C = (u16*)(P.ws + OFF_BZ) + (np - 17) * 128; ldc = 512; }
    epi_store_bf16(smem, C + (long)mp * 256 * ldc, ldc, 1.f, 128);
  }
}
__global__ void __launch_bounds__(NTHR, 2) k_g1(Params P) { extern __shared__ __attribute__((aligned(16))) char smem[]; g1_phase(P, smem, blockIdx.x, gridDim.x); }

__device__ void g2_phase(const Params& P, char* smem, int bid, int nblk) {
  const u16* A = (const u16*)(P.ws + OFF_CQN); const u16* Bt = (const u16*)(P.ws + OFF_WG2T);
  for (int t = bid; t < 128 * 20; t += nblk) {
    const int mp = t / 20, np = t - mp * 20;
    gemm_tile<132>(A + (long)mp * 256 * 256, 256, Bt + (long)np * 128 * 256, 256, 256, smem);
    if (np < 4) epi_store_bf16(smem, (u16*)(P.ws + OFF_QI) + (long)mp * 256 * 512 + np * 128, 512, 1.f, 128);
    else epi_store_bf16(smem, (u16*)P.out + (long)mp * 256 * 2048 + (np - 4) * 128, 2048, 1.f, 128);
  }
}
__global__ void __launch_bounds__(NTHR, 2) k_g2(Params P) { extern __shared__ __attribute__((aligned(16))) char smem[]; g2_phase(P, smem, blockIdx.x, gridDim.x); }

struct GemmR { const u16* A; long lda; const u16* Bt; long ldb; const float* R; float* C; int K; };
__device__ void gemm_resid_phase(const GemmR& p, char* smem, int bid, int nblk) {
  for (int t = bid; t < 128 * 8; t += nblk) {
    const int mp = t >> 3, np = t & 7;
    gemm_tile<132>(p.A + (long)mp * 256 * p.lda, p.lda, p.Bt + (long)np * 128 * p.ldb, p.ldb, p.K, smem);
    epi_resid_f32(smem, p.R + (long)mp * 256 * DM + np * 128, p.C + (long)mp * 256 * DM + np * 128, DM);
  }
}
__global__ void __launch_bounds__(NTHR, 2) k_gemm_resid(GemmR p) { extern __shared__ __attribute__((aligned(16))) char smem[]; gemm_resid_phase(p, smem, blockIdx.x, gridDim.x); }

__device__ void dsa_prep_phase(const Params& P, int bid, int nblk) {
  const int lane = threadIdx.x & 63, wv = threadIdx.x >> 6;
  const u16* Pa = (const u16*)(P.ws + OFF_PA);
  u16* cqn = (u16*)(P.ws + OFF_CQN); u16* ckvn = (u16*)(P.ws + OFF_CKVN); u16* kidxn = (u16*)(P.ws + OFF_KIDXN); float* widx = (float*)(P.ws + OFF_WIDX);
  for (int t = bid * 8 + wv; t < T_TOK; t += nblk * 8) {
    const u16* row = Pa + (long)t * 640;
    const u32x2 a = *(const u32x2*)(row + lane * 4);
    const u32x2 c = *(const u32x2*)(row + 256 + lane * 4);
    const float k = bf2f(row[512 + lane]);
    float a0 = lo2f(a[0]), a1 = hi2f(a[0]), a2 = lo2f(a[1]), a3 = hi2f(a[1]);
    float c0 = lo2f(c[0]), c1 = hi2f(c[0]), c2 = lo2f(c[1]), c3 = hi2f(c[1]);
    const float sa = wave_sum(a0 * a0 + a1 * a1 + a2 * a2 + a3 * a3), sc = wave_sum(c0 * c0 + c1 * c1 + c2 * c2 + c3 * c3), sk = wave_sum(k * k);
    const float ra = rsqrtf(sa * (1.f / 256) + EPSV), rc = rsqrtf(sc * (1.f / 256) + EPSV), rk = rsqrtf(sk * (1.f / 64) + EPSV);
    const float4 ga = *(const float4*)(P.g_cq + lane * 4), gc = *(const float4*)(P.g_ckv + lane * 4);
    u32x2 o; o[0] = pack2(a0 * ra * ga.x, a1 * ra * ga.y); o[1] = pack2(a2 * ra * ga.z, a3 * ra * ga.w);
    *(u32x2*)(cqn + (long)t * 256 + lane * 4) = o;
    o[0] = pack2(c0 * rc * gc.x, c1 * rc * gc.y); o[1] = pack2(c2 * rc * gc.z, c3 * rc * gc.w);
    *(u32x2*)(ckvn + (long)t * 256 + lane * 4) = o;
    kidxn[(long)t * 64 + lane] = f2bf(k * rk * P.g_kidx[lane]);
    if (lane < 8) widx[(long)t * 8 + lane] = bf2f(row[576 + lane]) * 0.04419417382415922f;
  }
}
__global__ void __launch_bounds__(NTHR, 2) k_dsa_prep(Params P) { dsa_prep_phase(P, blockIdx.x, gridDim.x); }

__device__ __forceinline__ int idx_unit_map(int v) {
  const int b = v >> 9, r = v & 511;
  const int p = (r < 256) ? r : 767 - r;
  return b * 512 + p;
}
__device__ void select_query(const float* __restrict__ row, int L, u16* __restrict__ sel, unsigned* hist, float* cval, int lane) {
  const int n64 = L >> 6;
  float lo = 3.0e38f, hi = -3.0e38f;
  for (int i = 0; i < n64; ++i) { const float v = row[i * 64 + lane]; lo = fminf(lo, v); hi = fmaxf(hi, v); }
#pragma unroll
  for (int o = 32; o >= 1; o >>= 1) { lo = fminf(lo, __shfl_xor(lo, o)); hi = fmaxf(hi, __shfl_xor(hi, o)); }
  int need = 256;
  float tau = lo;
  for (int iter = 0; iter < 64; ++iter) {
    if (!(hi > lo)) { tau = lo; break; }
    for (int i = lane; i < 1024; i += 64) hist[i] = 0u;
    __builtin_amdgcn_wave_barrier();
    const float scale = 1024.f / (hi - lo);
    for (int i = 0; i < n64; ++i) {
      const float v = row[i * 64 + lane];
      if (v >= lo && v <= hi) { int b = (int)((v - lo) * scale); b = b > 1023 ? 1023 : b; atomicAdd(&hist[b], 1u); }
    }
    __builtin_amdgcn_wave_barrier();
    unsigned c[16]; unsigned tot = 0;
#pragma unroll
    for (int j = 0; j < 16; ++j) { c[j] = hist[1023 - 16 * lane - j]; tot += c[j]; }
    unsigned incl = tot;
#pragma unroll
    for (int o = 1; o < 64; o <<= 1) { const unsigned v = __shfl_up(incl, o); if (lane >= o) incl += v; }
    const unsigned excl = incl - tot;
    const bool mine = (excl < (unsigned)need) && (incl >= (unsigned)need);
    int bsel = 0; unsigned above = 0, nstar = 0;
    if (mine) {
      unsigned run = excl;
#pragma unroll
      for (int j = 0; j < 16; ++j) { if (run < (unsigned)need && run + c[j] >= (unsigned)need) { bsel = 1023 - 16 * lane - j; above = run; nstar = c[j]; } run += c[j]; }
    }
    const unsigned long long mk = __ballot(mine);
    const int src = __ffsll((long long)mk) - 1;
    bsel = __shfl(bsel, src); above = __shfl(above, src); nstar = __shfl(nstar, src);
    need -= (int)above;
    float nlo = 3.0e38f, nhi = -3.0e38f; int cnt = 0;
    for (int i = 0; i < n64; ++i) {
      const float v = row[i * 64 + lane];
      bool in = false;
      if (v >= lo && v <= hi) { int b = (int)((v - lo) * scale); b = b > 1023 ? 1023 : b; in = (b == bsel); }
      if (in) { nlo = fminf(nlo, v); nhi = fmaxf(nhi, v); }
      if (nstar <= 64u) {
        const unsigned long long m = __ballot(in);
        if (in) { const int pos = cnt + __builtin_amdgcn_mbcnt_hi((unsigned)(m >> 32), __builtin_amdgcn_mbcnt_lo((unsigned)m, 0u)); cval[pos] = v; }
        cnt += __popcll(m);
      }
    }
#pragma unroll
    for (int o = 32; o >= 1; o >>= 1) { nlo = fminf(nlo, __shfl_xor(nlo, o)); nhi = fmaxf(nhi, __shfl_xor(nhi, o)); }
    if (nstar <= 64u) {
      __builtin_amdgcn_wave_barrier();
      const float mv = (lane < (int)nstar) ? cval[lane] : -3.0e38f;
      int rank = 0;
      for (int j = 0; j < (int)nstar; ++j) { const float o = cval[j]; rank += (o > mv || (o == mv && j < lane)) ? 1 : 0; }
      const unsigned long long mm = __ballot(lane < (int)nstar && rank == need - 1);
      const int s2 = __ffsll((long long)mm) - 1;
      tau = __shfl(mv, s2 < 0 ? 0 : s2);
      break;
    }
    lo = nlo; hi = nhi;
    tau = lo;
  }
  int cgt = 0;
  for (int i = 0; i < n64; ++i) { const float v = row[i * 64 + lane]; cgt += __popcll(__ballot(v > tau)); }
  int need_eq = 256 - cgt, pos = 0, eqtaken = 0;
  for (int i = 0; i < n64; ++i) {
    const float v = row[i * 64 + lane];
    const bool gt = v > tau; const bool eq = (v == tau);
    const unsigned long long me = __ballot(eq);
    const int eqrank = __builtin_amdgcn_mbcnt_hi((unsigned)(me >> 32), __builtin_amdgcn_mbcnt_lo((unsigned)me, 0u));
    const bool take = gt || (eq && (eqtaken + eqrank) < need_eq);
    const unsigned long long mt = __ballot(take);
    if (take) { const int p = pos + __builtin_amdgcn_mbcnt_hi((unsigned)(mt >> 32), __builtin_amdgcn_mbcnt_lo((unsigned)mt, 0u)); if (p < 256) sel[p] = (u16)(i * 64 + lane); }
    pos += __popcll(mt); eqtaken += __popcll(me);
  }
}

__device__ void indexer_phase(const Params& P, char* smem, int bid, int nblk) {
  const int tid = threadIdx.x, lane = tid & 63, wv = tid >> 6, lr = lane & 15, g = lane >> 4;
  const u16* qi = (const u16*)(P.ws + OFF_QI); const u16* kidx = (const u16*)(P.ws + OFF_KIDXN); const float* widx = (const float*)(P.ws + OFF_WIDX);
  float* scr = (float*)(P.ws + OFF_SCORES) + (long)bid * 16 * 8192;
  u16* selb = (u16*)(P.ws + OFF_SEL);
  unsigned* hist = (unsigned*)smem + wv * 1024;
  float* cval = (float*)(smem + 32768) + wv * 64;
  for (int v = bid; v < 2048; v += nblk) {
    const int unit = idx_unit_map(v);
    const int t0 = unit * 16, b = t0 >> 13, pos0 = t0 & 8191, L = ((pos0 >> 6) + 1) * 64;
    if (L > 256) {
      bf16x8 a[8][2];
#pragma unroll
      for (int h = 0; h < 8; ++h)
#pragma unroll
        for (int ks = 0; ks < 2; ++ks) a[h][ks] = *(const bf16x8*)(qi + (long)(t0 + lr) * 512 + h * 64 + ks * 32 + g * 8);
      float wq[4][8];
#pragma unroll
      for (int r = 0; r < 4; ++r) {
        const float4 w0 = *(const float4*)(widx + (long)(t0 + g * 4 + r) * 8), w1 = *(const float4*)(widx + (long)(t0 + g * 4 + r) * 8 + 4);
        wq[r][0] = w0.x; wq[r][1] = w0.y; wq[r][2] = w0.z; wq[r][3] = w0.w; wq[r][4] = w1.x; wq[r][5] = w1.y; wq[r][6] = w1.z; wq[r][7] = w1.w;
      }
      const u16* kb = kidx + (long)(b * SEQ) * 64;
      const int nkt = L >> 4;
      for (int kt = wv; kt < nkt; kt += 8) {
        const bf16x8 b0 = *(const bf16x8*)(kb + (long)(kt * 16 + lr) * 64 + g * 8);
        const bf16x8 b1 = *(const bf16x8*)(kb + (long)(kt * 16 + lr) * 64 + 32 + g * 8);
        float s[4] = {0.f, 0.f, 0.f, 0.f};
#pragma unroll
        for (int h = 0; h < 8; ++h) {
          f32x4 d = (f32x4){0.f, 0.f, 0.f, 0.f};
          d = mfma16(a[h][0], b0, d); d = mfma16(a[h][1], b1, d);
#pragma unroll
          for (int r = 0; r < 4; ++r) s[r] = fmaf(fmaxf(d[r], 0.f), wq[r][h], s[r]);
        }
#pragma unroll
        for (int r = 0; r < 4; ++r) scr[(long)(g * 4 + r) * 8192 + kt * 16 + lr] = s[r];
      }
    }
    __syncthreads();
#pragma unroll 1
    for (int qq = 0; qq < 2; ++qq) {
      const int ql = wv * 2 + qq;
      u16* sel = selb + (long)(t0 + ql) * 256;
      if (L <= 256) { for (int j = lane; j < 256; j += 64) sel[j] = (u16)(j < L ? j : 0); }
      else select_query(scr + (long)ql * 8192, L, sel, hist, cval, lane);
    }
    __syncthreads();
  }
}
__global__ void __launch_bounds__(NTHR, 2) k_indexer(Params P) { extern __shared__ __attribute__((aligned(16))) char smem[]; indexer_phase(P, smem, blockIdx.x, gridDim.x); }

#define ATT_ROWB 544
__device__ __forceinline__ int t5_bucket(int rel) {
  const int n = rel < 0 ? -rel : rel;
  const int lg = 8 + (n >= 12) + (n >= 16) + (n >= 23) + (n >= 32) + (n >= 46) + (n >= 64) + (n >= 91);
  return (rel > 0 ? 16 : 0) + (n < 8 ? n : lg);
}
__device__ void dsa_attn_phase(const Params& P, char* smem, int bid, int nblk) {
  const int tid = threadIdx.x, lane = tid & 63, wv = tid >> 6, lr = lane & 15, g = lane >> 4;
  const u16* ckv = (const u16*)(P.ws + OFF_CKVN);
  u16* qlat = (u16*)P.out;
  const u16* selb = (const u16*)(P.ws + OFF_SEL);
  char* rows = smem + wv * (32 * ATT_ROWB);
  float* sbias = (float*)(smem + 8 * 32 * ATT_ROWB);
  u16* ssel = (u16*)(smem + 8 * 32 * ATT_ROWB + 1024) + wv * 256;
  for (int i = tid; i < 256; i += NTHR) sbias[i] = P.rel_bias[i];
  __syncthreads();
  for (int t = bid * 8 + wv; t < T_TOK; t += nblk * 8) {
    const int b = t >> 13, pos = t & 8191, L = ((pos >> 6) + 1) * 64, n = L < 256 ? L : 256;
    const u16* kb = ckv + (long)(b * SEQ) * 256;
    bf16x8 bq[8];
#pragma unroll
    for (int ks = 0; ks < 8; ++ks) {
      bf16x8 v = (bf16x8){0, 0, 0, 0, 0, 0, 0, 0};
      if (lr < 8) v = *(const bf16x8*)(qlat + (long)t * 2048 + lr * 256 + ks * 32 + g * 8);
      bq[ks] = v;
    }
    __builtin_amdgcn_wave_barrier();
    *(u32x2*)(ssel + lane * 4) = *(const u32x2*)(selb + (long)t * 256 + lane * 4);
    __builtin_amdgcn_wave_barrier();
    float m_run = -3.0e38f, l_run = 0.f;
    f32x4 O[16];
#pragma unroll
    for (int i = 0; i < 16; ++i) O[i] = (f32x4){0.f, 0.f, 0.f, 0.f};
    for (int kbk = 0; kbk < (n >> 5); ++kbk) {
      u32x4 gr[16];
#pragma unroll
      for (int i = 0; i < 16; ++i) {
        const int r = i * 2 + (lane >> 5);
        const int idx = ssel[kbk * 32 + r];
        gr[i] = *(const u32x4*)(kb + (long)idx * 256 + (lane & 31) * 8);
      }
      __builtin_amdgcn_wave_barrier();
#pragma unroll
      for (int i = 0; i < 16; ++i) { const int r = i * 2 + (lane >> 5); *(u32x4*)(rows + r * ATT_ROWB + (lane & 31) * 16) = gr[i]; }
      __builtin_amdgcn_wave_barrier();
      f32x4 S[2];
#pragma unroll
      for (int mt = 0; mt < 2; ++mt) {
        f32x4 d = (f32x4){0.f, 0.f, 0.f, 0.f};
#pragma unroll
        for (int ks = 0; ks < 8; ++ks) { const bf16x8 a = *(const bf16x8*)(rows + (mt * 16 + lr) * ATT_ROWB + (ks * 4 + g) * 16); d = mfma16(a, bq[ks], d); }
        S[mt] = d;
      }
      float mx = -3.0e38f;
#pragma unroll
      for (int mt = 0; mt < 2; ++mt)
#pragma unroll
        for (int r = 0; r < 4; ++r) {
          const int idx = ssel[kbk * 32 + mt * 16 + g * 4 + r];
          const float bs = sbias[t5_bucket(idx - pos) * 8 + (lr & 7)];
          S[mt][r] += bs; mx = fmaxf(mx, S[mt][r]);
        }
      mx = fmaxf(mx, __shfl_xor(mx, 16)); mx = fmaxf(mx, __shfl_xor(mx, 32));
      const float m_new = fmaxf(m_run, mx);
      const float alpha = __expf(m_run - m_new);
      float ps = 0.f; float p[8];
#pragma unroll
      for (int mt = 0; mt < 2; ++mt)
#pragma unroll
        for (int r = 0; r < 4; ++r) { p[mt * 4 + r] = __expf(S[mt][r] - m_new); ps += p[mt * 4 + r]; }
      l_run = l_run * alpha + ps; m_run = m_new;
      bf16x8 ap;
#pragma unroll
      for (int j = 0; j < 8; ++j) ap[j] = (short)f2bf(p[j]);
      float al[4];
#pragma unroll
      for (int r = 0; r < 4; ++r) al[r] = __shfl(alpha, g * 4 + r);
      const int q = lr >> 2, pp = lr & 3;
      const char* tb0 = rows + (4 * g + q) * ATT_ROWB + pp * 8;
      const char* tb1 = rows + (16 + 4 * g + q) * ATT_ROWB + pp * 8;
#pragma unroll
      for (int ct = 0; ct < 16; ++ct) {
        const s16x4 v0 = __builtin_amdgcn_ds_read_tr16_b64_v4i16((LAS s16x4*)(tb0 + ct * 32));
        const s16x4 v1 = __builtin_amdgcn_ds_read_tr16_b64_v4i16((LAS s16x4*)(tb1 + ct * 32));
        bf16x8 bb; bb[0] = v0[0]; bb[1] = v0[1]; bb[2] = v0[2]; bb[3] = v0[3]; bb[4] = v1[0]; bb[5] = v1[1]; bb[6] = v1[2]; bb[7] = v1[3];
        f32x4 o = O[ct];
#pragma unroll
        for (int r = 0; r < 4; ++r) o[r] *= al[r];
        O[ct] = mfma16(ap, bb, o);
      }
      __builtin_amdgcn_wave_barrier();
    }
    float lt = l_run; lt += __shfl_xor(lt, 16); lt += __shfl_xor(lt, 32);
    const float inv = 1.f / lt;
    float iv[4];
#pragma unroll
    for (int r = 0; r < 4; ++r) iv[r] = __shfl(inv, g * 4 + r);
    if (g < 2) {
#pragma unroll
      for (int ct = 0; ct < 16; ++ct)
#pragma unroll
        for (int r = 0; r < 4; ++r) qlat[(long)t * 2048 + (g * 4 + r) * 256 + ct * 16 + lr] = f2bf(O[ct][r] * iv[r]);
    }
  }
}
__global__ void __launch_bounds__(NTHR, 2) k_dsa_attn(Params P) { extern __shared__ __attribute__((aligned(16))) char smem[]; dsa_attn_phase(P, smem, blockIdx.x, gridDim.x); }

__device__ void dn_prep_phase(const Params& P, int bid, int nblk) {
  const int lane = threadIdx.x & 63, wv = threadIdx.x >> 6, hh = lane >> 4, cg = lane & 15;
  const u16* Pb = (const u16*)(P.ws + OFF_PB); const u16* Pa = (const u16*)(P.ws + OFF_PA);
  u16* qkv = (u16*)(P.ws + OFF_QKV);
  float* gg = (float*)(P.ws + OFF_GB); float* bt = gg + 16 * 8192;
  for (int t = bid * 8 + wv; t < T_TOK; t += nblk * 8) {
    const int b = t >> 13, pos = t & 8191;
#pragma unroll
    for (int sec = 0; sec < 3; ++sec) {
      const int col = sec * 512 + hh * 128 + cg * 8;
      float y[8];
#pragma unroll
      for (int e = 0; e < 8; ++e) y[e] = 0.f;
#pragma unroll
      for (int j = 0; j < 4; ++j) {
        if (pos - 3 + j >= 0) {
          const u32x4 xv = *(const u32x4*)(Pb + (long)(t - 3 + j) * 1536 + col);
          const float4 w0 = *(const float4*)(P.conv_w + j * 1536 + col), w1 = *(const float4*)(P.conv_w + j * 1536 + col + 4);
          y[0] += w0.x * lo2f(xv[0]); y[1] += w0.y * hi2f(xv[0]); y[2] += w0.z * lo2f(xv[1]); y[3] += w0.w * hi2f(xv[1]);
          y[4] += w1.x * lo2f(xv[2]); y[5] += w1.y * hi2f(xv[2]); y[6] += w1.z * lo2f(xv[3]); y[7] += w1.w * hi2f(xv[3]);
        }
      }
      float ss = 0.f;
#pragma unroll
      for (int e = 0; e < 8; ++e) { y[e] = y[e] / (1.f + __expf(-y[e])); ss += y[e] * y[e]; }
      ss += __shfl_xor(ss, 1); ss += __shfl_xor(ss, 2); ss += __shfl_xor(ss, 4); ss += __shfl_xor(ss, 8);
      float sc = 1.f;
      if (sec == 0) sc = rsqrtf(ss + EPSV) * 0.08838834764831845f;
      else if (sec == 1) sc = rsqrtf(ss + EPSV);
      u32x4 o;
#pragma unroll
      for (int e = 0; e < 4; ++e) o[e] = pack2(y[2 * e] * sc, y[2 * e + 1] * sc);
      *(u32x4*)(qkv + (long)sec * (16l * 8192 * 128) + ((long)(b * 4 + hh) * 8192 + pos) * 128 + cg * 8) = o;
    }
    if (cg == 0) {
      const float a = bf2f(Pa[(long)t * 640 + 584 + hh]), bb = bf2f(Pa[(long)t * 640 + 588 + hh]);
      const float z = a + P.dt_bias[hh];
      const float sp = z > 20.f ? z : log1pf(__expf(z));
      gg[(long)(b * 4 + hh) * 8192 + pos] = -__expf(P.A_log[hh]) * sp;
      bt[(long)(b * 4 + hh) * 8192 + pos] = 1.f / (1.f + __expf(-bb));
    }
  }
}
__global__ void __launch_bounds__(NTHR, 2) k_dn_prep(Params P) { dn_prep_phase(P, blockIdx.x, gridDim.x); }

__device__ __forceinline__ int perm32_pos(int c) {
  const int blk = c & ~31, w = c & 31;
  const int hi = w >> 4, gq = (w >> 2) & 3, lo = w & 3;
  return blk + gq * 8 + hi * 4 + lo;
}
__device__ void dn_intra_phase(const Params& P, char* smem, int bid, int nblk) {
  const int tid = threadIdx.x, lane = tid & 63, wv = tid >> 6, lr = lane & 15, g = lane >> 4;
  u16* qkv = (u16*)(P.ws + OFF_QKV);
  const float* gg = (const float*)(P.ws + OFF_GB); const float* bt = gg + 16 * 8192; float* cdec = (float*)(P.ws + OFF_GB) + 32 * 8192;
  u16* wdn = (u16*)(P.ws + OFF_WDN); u16* intra = (u16*)(P.ws + OFF_INTRA);
  char* sQ = smem;
  char* sK = smem + 16384;
  char* sV = smem + 32768;
  float* sMT = (float*)(smem + 49152);
  float* sG = (float*)(smem + 66560);
  float* sX = (float*)(smem + 67584);
  for (int u = bid; u < 2048; u += nblk) {
    const int bh = u >> 7, ch = u & 127;
    const long tbase = ((long)bh * 8192 + ch * 64) * 128;
    u16* tq = qkv + tbase; u16* tk = qkv + 16l * 8192 * 128 + tbase; u16* tv = qkv + 32l * 8192 * 128 + tbase;
    __syncthreads();
    for (int i = tid; i < 3072; i += NTHR) {
      const int which = i >> 10, q = i & 1023, row = q >> 4, chk = q & 15;
      const u16* src = (which == 0 ? tq : which == 1 ? tk : tv) + row * 128 + chk * 8;
      *(u32x4*)(smem + which * 16384 + row * 256 + ((chk ^ (row & 15)) << 4)) = *(const u32x4*)src;
    }
    if (tid < 64) {
      float s = 0.f;
      for (int j = 0; j <= tid; ++j) s += gg[(long)bh * 8192 + ch * 64 + j];
      sG[tid] = s; sG[64 + tid] = bt[(long)bh * 8192 + ch * 64 + tid];
    }
    __syncthreads();
    {
      const int mi = wv & 3; const char* sAop = (wv < 4) ? sK : sQ;
      bf16x8 a[4];
#pragma unroll
      for (int ks = 0; ks < 4; ++ks) { const int row = mi * 16 + lr; a[ks] = *(const bf16x8*)(sAop + row * 256 + (((ks * 4 + g) ^ (row & 15)) << 4)); }
#pragma unroll
      for (int ni = 0; ni < 4; ++ni) {
        f32x4 d = (f32x4){0.f, 0.f, 0.f, 0.f};
#pragma unroll
        for (int ks = 0; ks < 4; ++ks) { const int row = ni * 16 + lr; const bf16x8 bb = *(const bf16x8*)(sK + row * 256 + (((ks * 4 + g) ^ (row & 15)) << 4)); d = mfma16(a[ks], bb, d); }
        const int j = ni * 16 + lr; const float gj = sG[j];
#pragma unroll
        for (int r = 0; r < 4; ++r) {
          const int i = mi * 16 + g * 4 + r; const float gi = sG[i];
          if (wv < 4) { sMT[j * 68 + i] = (j < i) ? sG[64 + i] * d[r] * __expf(gi - gj) : 0.f; }
          else { const float v = (j <= i) ? d[r] * __expf(gi - gj) : 0.f; intra[(long)u * 4096 + i * 64 + perm32_pos(j)] = f2bf(v); }
        }
      }
    }
    __syncthreads();
    if (wv < 4) {
      const int c = tid;
      const char* sSrc = (c < 128) ? sV : sK; const int cc = c & 127;
      const int pc = perm32_pos(cc);
#pragma unroll 1
      for (int bi = 0; bi < 4; ++bi) {
        float acc[16];
#pragma unroll
        for (int r = 0; r < 16; ++r) {
          const int i = bi * 16 + r;
          const float raw = bf2f(*(const u16*)(sSrc + i * 256 + (((cc >> 3) ^ (i & 15)) << 4) + (cc & 7) * 2));
          acc[r] = raw * sG[64 + i] * ((c < 128) ? 1.f : __expf(sG[i]));
        }
        for (int j = 0; j < bi * 16; ++j) {
          const float xj = sX[j * 256 + c];
          const float* mrow = sMT + j * 68 + bi * 16;
#pragma unroll
          for (int q4 = 0; q4 < 4; ++q4) {
            const float4 m = *(const float4*)(mrow + q4 * 4);
            acc[q4 * 4 + 0] = fmaf(-m.x, xj, acc[q4 * 4 + 0]); acc[q4 * 4 + 1] = fmaf(-m.y, xj, acc[q4 * 4 + 1]);
            acc[q4 * 4 + 2] = fmaf(-m.z, xj, acc[q4 * 4 + 2]); acc[q4 * 4 + 3] = fmaf(-m.w, xj, acc[q4 * 4 + 3]);
          }
        }
#pragma unroll
        for (int r = 1; r < 16; ++r)
#pragma unroll
          for (int q = 0; q < r; ++q) acc[r] = fmaf(-sMT[(bi * 16 + q) * 68 + bi * 16 + r], acc[q], acc[r]);
#pragma unroll
        for (int r = 0; r < 16; ++r) sX[(bi * 16 + r) * 256 + c] = acc[r];
        if (c < 128) {
#pragma unroll
          for (int h8 = 0; h8 < 2; ++h8) {
            u32x4 o;
#pragma unroll
            for (int e = 0; e < 4; ++e) o[e] = pack2(acc[h8 * 8 + 2 * e], acc[h8 * 8 + 2 * e + 1]);
            *(u32x4*)(tv + c * 64 + bi * 16 + h8 * 8) = o;
          }
        } else {
#pragma unroll
          for (int r = 0; r < 16; ++r) wdn[tbase + (bi * 16 + r) * 128 + pc] = f2bf(acc[r]);
        }
      }
    } else {
      const int t2 = tid - 256;
      const float glast = sG[63];
      for (int i = t2; i < 64 * 128; i += 256) {
        const int row = i >> 7, c = i & 127;
        const float v = bf2f(*(const u16*)(sQ + row * 256 + (((c >> 3) ^ (row & 15)) << 4) + (c & 7) * 2)) * __expf(sG[row]);
        tq[row * 128 + perm32_pos(c)] = f2bf(v);
      }
      for (int i = t2; i < 64 * 128; i += 256) {
        const int dk = i >> 6, row = i & 63;
        const float v = bf2f(*(const u16*)(sK + row * 256 + (((dk >> 3) ^ (row & 15)) << 4) + (dk & 7) * 2)) * __expf(glast - sG[row]);
        tk[dk * 64 + perm32_pos(row)] = f2bf(v);
      }
      if (t2 == 0) cdec[u] = __expf(glast);
    }
  }
}
__global__ void __launch_bounds__(NTHR, 2) k_dn_intra(Params P) { extern __shared__ __attribute__((aligned(16))) char smem[]; dn_intra_phase(P, smem, blockIdx.x, gridDim.x); }

#define SCAN_BUF 73728
__device__ void dn_scan_phase(const Params& P, char* smem, int bid, int nblk) {
  const int tid = threadIdx.x, lane = tid & 63, wv = tid >> 6, lr = lane & 15, g = lane >> 4;
  const u16* qkv = (const u16*)(P.ws + OFF_QKV);
  const u16* wdn = (const u16*)(P.ws + OFF_WDN); const u16* intra = (const u16*)(P.ws + OFF_INTRA);
  const float* cdec = (const float*)(P.ws + OFF_GB) + 32 * 8192;
  u16* mix = (u16*)(P.ws + OFF_MIX);
  for (int bh = bid; bh < 16; bh += nblk) {
    const int b = bh >> 2, hh = bh & 3;
    f32x4 S[8];
#pragma unroll
    for (int i = 0; i < 8; ++i) S[i] = (f32x4){0.f, 0.f, 0.f, 0.f};
    u32x4 st[9];
    auto load_chunk = [&](int n) {
      const long tb = ((long)bh * 8192 + n * 64) * 128;
#pragma unroll
      for (int i = 0; i < 9; ++i) {
        const int q = tid + i * NTHR;
        const u16* src;
        if (q < 1024) src = wdn + tb + q * 8;
        else if (q < 2048) src = qkv + tb + (q - 1024) * 8;
        else if (q < 3072) src = qkv + 16l * 8192 * 128 + tb + (q - 2048) * 8;
        else if (q < 4096) src = qkv + 32l * 8192 * 128 + tb + (q - 3072) * 8;
        else src = intra + ((long)bh * 128 + n) * 4096 + (q - 4096) * 8;
        st[i] = *(const u32x4*)src;
      }
    };
    auto store_chunk = [&](int bufi) {
      char* base = smem + bufi * SCAN_BUF;
#pragma unroll
      for (int i = 0; i < 9; ++i) {
        const int q = tid + i * NTHR;
        unsigned off;
        if (q < 2048) { const int qq = q & 1023, row = qq >> 4, chk = qq & 15; off = (q >> 10) * 16384 + row * 256 + ((chk ^ (row & 15)) << 4); }
        else if (q < 4096) { const int qq = q & 1023, row = qq >> 3, chk = qq & 7; off = (q >> 10) * 16384 + row * 128 + ((chk ^ (row & 7)) << 4); }
        else { const int qq = q - 4096, row = qq >> 3, chk = qq & 7; off = 65536 + row * 128 + ((chk ^ (row & 7)) << 4); }
        *(u32x4*)(base + off) = st[i];
      }
    };
    __syncthreads();
    load_chunk(0); store_chunk(0); load_chunk(1);
    __syncthreads();
    for (int n = 0; n < 128; ++n) {
      const char* base = smem + (n & 1) * SCAN_BUF;
      const char* sW = base; const char* sQd = base + 16384; const char* sKT = base + 32768; const char* sUT = base + 49152; const char* sA = base + 65536;
      if (n + 1 < 128) { store_chunk((n + 1) & 1); if (n + 2 < 128) load_chunk(n + 2); }
      const float dcy = cdec[bh * 128 + n];
      bf16x8 sb[4];
#pragma unroll
      for (int s = 0; s < 4; ++s)
#pragma unroll
        for (int j = 0; j < 8; ++j) sb[s][j] = (short)f2bf(S[2 * s + (j >> 2)][j & 3]);
      f32x4 vn[4], o[4];
#pragma unroll
      for (int mi = 0; mi < 4; ++mi) {
        f32x4 dw = (f32x4){0.f, 0.f, 0.f, 0.f}, dq = (f32x4){0.f, 0.f, 0.f, 0.f};
        const int row = mi * 16 + lr;
#pragma unroll
        for (int s = 0; s < 4; ++s) {
          const unsigned off = row * 256 + (((s * 4 + g) ^ (row & 15)) << 4);
          dw = mfma16(*(const bf16x8*)(sW + off), sb[s], dw);
          dq = mfma16(*(const bf16x8*)(sQd + off), sb[s], dq);
        }
        const int urow = wv * 16 + lr;
        const int ucol = mi * 16 + g * 4;
        const u32x2 uv = *(const u32x2*)(sUT + urow * 128 + ((((ucol >> 3)) ^ (urow & 7)) << 4) + (ucol & 7) * 2);
        vn[mi][0] = lo2f(uv[0]) - dw[0]; vn[mi][1] = hi2f(uv[0]) - dw[1]; vn[mi][2] = lo2f(uv[1]) - dw[2]; vn[mi][3] = hi2f(uv[1]) - dw[3];
        o[mi] = dq;
      }
      bf16x8 vb[2];
#pragma unroll
      for (int s = 0; s < 2; ++s)
#pragma unroll
        for (int j = 0; j < 8; ++j) vb[s][j] = (short)f2bf(vn[2 * s + (j >> 2)][j & 3]);
#pragma unroll
      for (int mi = 0; mi < 4; ++mi) {
        const int row = mi * 16 + lr;
#pragma unroll
        for (int s = 0; s < 2; ++s) o[mi] = mfma16(*(const bf16x8*)(sA + row * 128 + (((s * 4 + g) ^ (row & 7)) << 4)), vb[s], o[mi]);
      }
#pragma unroll
      for (int m2 = 0; m2 < 8; ++m2) {
        f32x4 d = S[m2];
#pragma unroll
        for (int r = 0; r < 4; ++r) d[r] *= dcy;
        const int row = m2 * 16 + lr;
#pragma unroll
        for (int s = 0; s < 2; ++s) d = mfma16(*(const bf16x8*)(sKT + row * 128 + (((s * 4 + g) ^ (row & 7)) << 4)), vb[s], d);
        S[m2] = d;
      }
#pragma unroll
      for (int mi = 0; mi < 4; ++mi)
#pragma unroll
        for (int r = 0; r < 4; ++r) {
          const long t = (long)b * 8192 + n * 64 + mi * 16 + g * 4 + r;
          mix[t * 1024 + 512 + hh * 128 + wv * 16 + lr] = f2bf(o[mi][r]);
        }
      __syncthreads();
    }
  }
}
__global__ void __launch_bounds__(NTHR, 2) k_dn_scan(Params P) { extern __shared__ __attribute__((aligned(16))) char smem[]; dn_scan_phase(P, smem, blockIdx.x, gridDim.x); }

__device__ void dn_gate_phase(const Params& P, int bid, int nblk) {
  const int lane = threadIdx.x & 63, wv = threadIdx.x >> 6, hh = lane >> 4, cg = lane & 15;
  u16* mix = (u16*)(P.ws + OFF_MIX); const u16* bz = (const u16*)(P.ws + OFF_BZ);
  for (int t = bid * 8 + wv; t < T_TOK; t += nblk * 8) {
    u16* p = mix + (long)t * 1024 + 512 + hh * 128 + cg * 8;
    const u32x4 ov = *(const u32x4*)p; const u32x4 zv = *(const u32x4*)(bz + (long)t * 512 + hh * 128 + cg * 8);
    float o[8], z[8];
#pragma unroll
    for (int e = 0; e < 4; ++e) { o[2 * e] = lo2f(ov[e]); o[2 * e + 1] = hi2f(ov[e]); z[2 * e] = lo2f(zv[e]); z[2 * e + 1] = hi2f(zv[e]); }
    float ss = 0.f;
#pragma unroll
    for (int e = 0; e < 8; ++e) ss += o[e] * o[e];
    ss += __shfl_xor(ss, 1); ss += __shfl_xor(ss, 2); ss += __shfl_xor(ss, 4); ss += __shfl_xor(ss, 8);
    const float rs = rsqrtf(ss * (1.f / 128) + EPSV);
    u32x4 r;
#pragma unroll
    for (int e = 0; e < 4; ++e) {
      const float a = o[2 * e] * rs * P.g_onorm[cg * 8 + 2 * e] * (z[2 * e] / (1.f + __expf(-z[2 * e])));
      const float bq = o[2 * e + 1] * rs * P.g_onorm[cg * 8 + 2 * e + 1] * (z[2 * e + 1] / (1.f + __expf(-z[2 * e + 1])));
      r[e] = pack2(a, bq);
    }
    *(u32x4*)p = r;
  }
}
__global__ void __launch_bounds__(NTHR, 2) k_dn_gate(Params P) { dn_gate_phase(P, blockIdx.x, gridDim.x); }

__device__ void xattn_phase(const Params& P, int bid, int nblk) {
  const int tid = threadIdx.x, lane = tid & 63, wv = tid >> 6, lr = lane & 15, g = lane >> 4;
  const u16* qx = (const u16*)(P.ws + OFF_QX); const u16* kx = (const u16*)(P.ws + OFF_KX); const u16* vtx = (const u16*)(P.ws + OFF_VTX);
  u16* ox = (u16*)(P.ws + OFF_OX);
  for (int u = bid * 8 + wv; u < 2048 * 4; u += nblk * 8) {
    const int qt = u >> 2, hh = u & 3, t0 = qt * 16, b = t0 >> 13;
    bf16x8 bq[4];
#pragma unroll
    for (int ks = 0; ks < 4; ++ks) bq[ks] = *(const bf16x8*)(qx + (long)(t0 + lr) * 512 + hh * 128 + ks * 32 + g * 8);
    f32x4 S[16];
    float mx = -3.0e38f;
#pragma unroll
    for (int m = 0; m < 16; ++m) {
      f32x4 d = (f32x4){0.f, 0.f, 0.f, 0.f};
#pragma unroll
      for (int ks = 0; ks < 4; ++ks) { const bf16x8 a = *(const bf16x8*)(kx + (long)(b * 256 + m * 16 + lr) * 512 + hh * 128 + ks * 32 + g * 8); d = mfma16(a, bq[ks], d); }
      S[m] = d;
#pragma unroll
      for (int r = 0; r < 4; ++r) mx = fmaxf(mx, d[r]);
    }
    mx = fmaxf(mx, __shfl_xor(mx, 16)); mx = fmaxf(mx, __shfl_xor(mx, 32));
    float sum = 0.f;
#pragma unroll
    for (int m = 0; m < 16; ++m)
#pragma unroll
      for (int r = 0; r < 4; ++r) { S[m][r] = __expf(S[m][r] - mx); sum += S[m][r]; }
    sum += __shfl_xor(sum, 16); sum += __shfl_xor(sum, 32);
    const float inv = 1.f / sum;
    bf16x8 pb[8];
#pragma unroll
    for (int s = 0; s < 8; ++s)
#pragma unroll
      for (int j = 0; j < 8; ++j) pb[s][j] = (short)f2bf(S[2 * s + (j >> 2)][j & 3]);
#pragma unroll
    for (int dt = 0; dt < 8; ++dt) {
      f32x4 o = (f32x4){0.f, 0.f, 0.f, 0.f};
      const u16* vrow = vtx + ((long)b * 512 + hh * 128 + dt * 16 + lr) * 256;
#pragma unroll
      for (int s = 0; s < 8; ++s) {
        const u32x2 v0 = *(const u32x2*)(vrow + s * 32 + g * 4);
        const u32x2 v1 = *(const u32x2*)(vrow + s * 32 + 16 + g * 4);
        bf16x8 a; u32x4 tmp; tmp[0] = v0[0]; tmp[1] = v0[1]; tmp[2] = v1[0]; tmp[3] = v1[1]; a = __builtin_bit_cast(bf16x8, tmp);
        o = mfma16(a, pb[s], o);
      }
      u32x2 w; w[0] = pack2(o[0] * inv, o[1] * inv); w[1] = pack2(o[2] * inv, o[3] * inv);
      *(u32x2*)(ox + (long)(t0 + lr) * 512 + hh * 128 + dt * 16 + g * 4) = w;
    }
  }
}
__global__ void __launch_bounds__(NTHR, 2) k_xattn(Params P) { xattn_phase(P, blockIdx.x, gridDim.x); }

__device__ void g6_phase(const Params& P, char* smem, int bid, int nblk) {
  const u16* A = (const u16*)(P.ws + OFF_H); const u16* Bt = (const u16*)(P.ws + OFF_WEFFT);
  unsigned* plist = (unsigned*)(P.ws + OFF_PLIST);
  const int tid = threadIdx.x;
  for (int t = bid; t < 128 * 16; t += nblk) {
    const int mp = t >> 4, np = t & 15;
    gemm_tile<133>(A + (long)mp * 256 * DM, DM, Bt + (long)np * 128 * DM, DM, DM, smem);
    const float* sC = (const float*)smem;
    const int row = tid >> 1, half = tid & 1;
    unsigned tk[16];
#pragma unroll
    for (int i = 0; i < 16; ++i) tk[i] = 0u;
    for (int i = 0; i < 64; ++i) {
      const int c = half * 64 + ((i + half * 16) & 63);
      const unsigned key = (fkey(sC[row * 133 + c]) & ~127u) | (unsigned)(127 - c);
#pragma unroll
      for (int s = 15; s >= 1; --s) tk[s] = umed3(tk[s - 1], tk[s], key);
      tk[0] = tk[0] > key ? tk[0] : key;
    }
#pragma unroll
    for (int i = 0; i < 16; ++i) {
      const unsigned key = __shfl_xor(tk[i], 1);
      if (half == 0) {
#pragma unroll
        for (int s = 15; s >= 1; --s) tk[s] = umed3(tk[s - 1], tk[s], key);
        tk[0] = tk[0] > key ? tk[0] : key;
      }
    }
    if (half == 0) {
      unsigned* dst = plist + ((long)(mp * 256 + row) * 16 + np) * 16;
#pragma unroll
      for (int i = 0; i < 4; ++i) { u32x4 o; o[0] = tk[4 * i]; o[1] = tk[4 * i + 1]; o[2] = tk[4 * i + 2]; o[3] = tk[4 * i + 3]; *(u32x4*)(dst + 4 * i) = o; }
    }
  }
}
__global__ void __launch_bounds__(NTHR, 2) k_g6(Params P) { extern __shared__ __attribute__((aligned(16))) char smem[]; g6_phase(P, smem, blockIdx.x, gridDim.x); }

__device__ void peer_phase(const Params& P, char* smem, int bid, int nblk) {
  const int tid = threadIdx.x, lane = tid & 63, wv = tid >> 6;
  const unsigned* plist = (const unsigned*)(P.ws + OFF_PLIST);
  const u16* h3 = (const u16*)(P.ws + OFF_H);
  const u16* ue = (const u16*)(P.ws + OFF_UEMB); const u16* ve = (const u16*)(P.ws + OFF_VEMB);
  unsigned* skeys = (unsigned*)smem + wv * 256;
  unsigned* sidx = (unsigned*)(smem + 8192) + wv * 128;
  float* sgate = (float*)(smem + 12288) + wv * 128;
  for (int t = bid * 8 + wv; t < T_TOK; t += nblk * 8) {
    __builtin_amdgcn_wave_barrier();
    *(u32x4*)(skeys + lane * 4) = *(const u32x4*)(plist + (long)t * 256 + lane * 4);
    __builtin_amdgcn_wave_barrier();
    if (lane < 8) {
      const unsigned* k1 = skeys + lane * 32; const unsigned* k2 = k1 + 16;
      float s1[16], s2[16];
#pragma unroll
      for (int i = 0; i < 16; ++i) { s1[i] = keyf(k1[i] & ~127u); s2[i] = keyf(k2[i] & ~127u); }
      unsigned tk[16];
#pragma unroll
      for (int i = 0; i < 16; ++i) tk[i] = 0u;
#pragma unroll
      for (int i = 0; i < 16; ++i)
#pragma unroll
        for (int j = 0; j < 16; ++j)
          if ((i + 1) * (j + 1) <= 16) {
            const unsigned key = (fkey(s1[i] + s2[j]) & ~255u) | (unsigned)(255 - (i * 16 + j));
#pragma unroll
            for (int s = 15; s >= 1; --s) tk[s] = umed3(tk[s - 1], tk[s], key);
            tk[0] = tk[0] > key ? tk[0] : key;
          }
      float best[16]; float mx = -3.0e38f;
#pragma unroll
      for (int k = 0; k < 16; ++k) {
        const int cid = 255 - (int)(tk[k] & 255u); const int i = cid >> 4, j = cid & 15;
        const unsigned ka = k1[i], kb2 = k2[j];
        best[k] = keyf(ka & ~127u) + keyf(kb2 & ~127u);
        sidx[lane * 16 + k] = (unsigned)((127 - (int)(ka & 127u)) * 128 + (127 - (int)(kb2 & 127u)));
        mx = fmaxf(mx, best[k]);
      }
      float sm = 0.f;
#pragma unroll
      for (int k = 0; k < 16; ++k) { best[k] = __expf(best[k] - mx); sm += best[k]; }
      const float inv = 1.f / sm;
#pragma unroll
      for (int k = 0; k < 16; ++k) sgate[lane * 16 + k] = best[k] * inv;
    }
    __builtin_amdgcn_wave_barrier();
    float xa[16];
    {
      const u32x4 v0 = *(const u32x4*)(h3 + (long)t * DM + lane * 8), v1 = *(const u32x4*)(h3 + (long)t * DM + 512 + lane * 8);
#pragma unroll
      for (int e = 0; e < 4; ++e) { xa[2 * e] = lo2f(v0[e]); xa[2 * e + 1] = hi2f(v0[e]); xa[8 + 2 * e] = lo2f(v1[e]); xa[8 + 2 * e + 1] = hi2f(v1[e]); }
    }
    float acc[16];
#pragma unroll
    for (int e = 0; e < 16; ++e) acc[e] = 0.f;
    for (int bt = 0; bt < 16; ++bt) {
      u32x4 uu[8][2], vv[8][2];
#pragma unroll
      for (int k = 0; k < 8; ++k) {
        const long e = (long)sidx[bt * 8 + k];
        uu[k][0] = *(const u32x4*)(ue + e * DM + lane * 8); uu[k][1] = *(const u32x4*)(ue + e * DM + 512 + lane * 8);
        vv[k][0] = *(const u32x4*)(ve + e * DM + lane * 8); vv[k][1] = *(const u32x4*)(ve + e * DM + 512 + lane * 8);
      }
      float pd[8];
#pragma unroll
      for (int k = 0; k < 8; ++k) {
        float s = 0.f;
#pragma unroll
        for (int e = 0; e < 4; ++e) {
          s = fmaf(lo2f(uu[k][0][e]), xa[2 * e], s); s = fmaf(hi2f(uu[k][0][e]), xa[2 * e + 1], s);
          s = fmaf(lo2f(uu[k][1][e]), xa[8 + 2 * e], s); s = fmaf(hi2f(uu[k][1][e]), xa[8 + 2 * e + 1], s);
        }
        pd[k] = s;
      }
      float r4[4], r2[2], r1;
      {
        const bool up = (lane & 32) != 0;
#pragma unroll
        for (int k = 0; k < 4; ++k) { const float mine = up ? pd[k + 4] : pd[k]; const float oth = up ? pd[k] : pd[k + 4]; r4[k] = mine + __shfl_xor(oth, 32); }
        const bool up2 = (lane & 16) != 0;
#pragma unroll
        for (int k = 0; k < 2; ++k) { const float mine = up2 ? r4[k + 2] : r4[k]; const float oth = up2 ? r4[k] : r4[k + 2]; r2[k] = mine + __shfl_xor(oth, 16); }
        const bool up3 = (lane & 8) != 0;
        { const float mine = up3 ? r2[1] : r2[0]; const float oth = up3 ? r2[0] : r2[1]; r1 = mine + __shfl_xor(oth, 8); }
        r1 += __shfl_xor(r1, 4); r1 += __shfl_xor(r1, 2); r1 += __shfl_xor(r1, 1);
      }
      const int myk = ((lane >> 5) & 1) * 4 + ((lane >> 4) & 1) * 2 + ((lane >> 3) & 1);
      const float act = 0.5f * r1 * (1.f + erff(r1 * 0.7071067811865475f));
      const float coef = sgate[bt * 8 + myk] * act;
#pragma unroll
      for (int k = 0; k < 8; ++k) {
        const int srcl = ((k >> 2) & 1) * 32 + ((k >> 1) & 1) * 16 + (k & 1) * 8;
        const float ck = __shfl(coef, srcl);
#pragma unroll
        for (int e = 0; e < 4; ++e) {
          acc[2 * e] = fmaf(ck, lo2f(vv[k][0][e]), acc[2 * e]); acc[2 * e + 1] = fmaf(ck, hi2f(vv[k][0][e]), acc[2 * e + 1]);
          acc[8 + 2 * e] = fmaf(ck, lo2f(vv[k][1][e]), acc[8 + 2 * e]); acc[8 + 2 * e + 1] = fmaf(ck, hi2f(vv[k][1][e]), acc[8 + 2 * e + 1]);
        }
      }
    }
    float* orow = P.out + (long)t * DM;
    float xr[16]; float ss = 0.f;
#pragma unroll
    for (int hf = 0; hf < 2; ++hf)
#pragma unroll
      for (int q = 0; q < 2; ++q) {
        const float4 v = *(const float4*)(orow + hf * 512 + lane * 8 + q * 4);
        xr[hf * 8 + q * 4 + 0] = v.x + acc[hf * 8 + q * 4 + 0]; xr[hf * 8 + q * 4 + 1] = v.y + acc[hf * 8 + q * 4 + 1];
        xr[hf * 8 + q * 4 + 2] = v.z + acc[hf * 8 + q * 4 + 2]; xr[hf * 8 + q * 4 + 3] = v.w + acc[hf * 8 + q * 4 + 3];
      }
#pragma unroll
    for (int e = 0; e < 16; ++e) ss += xr[e] * xr[e];
    ss = wave_sum(ss);
    const float rs = rsqrtf(ss * (1.f / DM) + EPSV);
#pragma unroll
    for (int hf = 0; hf < 2; ++hf)
#pragma unroll
      for (int q = 0; q < 2; ++q) {
        const float4 gf = *(const float4*)(P.g_final + hf * 512 + lane * 8 + q * 4);
        float4 o; o.x = xr[hf * 8 + q * 4 + 0] * rs * gf.x; o.y = xr[hf * 8 + q * 4 + 1] * rs * gf.y; o.z = xr[hf * 8 + q * 4 + 2] * rs * gf.z; o.w = xr[hf * 8 + q * 4 + 3] * rs * gf.w;
        *(float4*)(orow + hf * 512 + lane * 8 + q * 4) = o;
      }
  }
}
__global__ void __launch_bounds__(NTHR, 2) k_peer(Params P) { extern __shared__ __attribute__((aligned(16))) char smem[]; peer_phase(P, smem, blockIdx.x, gridDim.x); }

static void add_job(CvtJobs& J, const float* src, u16* dst, int R, int C, long sld, long dld, float scale, int tr) {
  CvtJob& j = J.j[J.n++]; j.src = src; j.dst = dst; j.R = R; j.C = C; j.sld = sld; j.dld = dld; j.scale = scale; j.transpose = tr;
}

extern "C" void kernel_launch(void* const* d_in, const int* in_sizes, int n_in, void* d_out, int out_size, void* d_ws, size_t ws_size, hipStream_t stream) {
  if (ws_size < WS_NEED) { fprintf(stderr, "workspace too small: %zu < %llu\n", ws_size, (unsigned long long)WS_NEED); return; }
  Params P{};
  const float** pp = (const float**)&P;
  for (int i = 0; i < 29; ++i) pp[i] = (const float*)d_in[i];
  P.out = (float*)d_out; P.ws = (char*)d_ws;
  char* ws = (char*)d_ws;
  static bool attr = false;
  const int GR = 256;
  const size_t LDS_G = 135168 + 1024, LDS_ATT = 8 * 32 * ATT_ROWB + 1024 + 8 * 512, LDS_SCAN = 2 * SCAN_BUF;
  if (!attr) {
    hipFuncSetAttribute((const void*)k_cvt, hipFuncAttributeMaxDynamicSharedMemorySize, 32768);
    hipFuncSetAttribute((const void*)k_gemm_bf16, hipFuncAttributeMaxDynamicSharedMemorySize, LDS_G);
    hipFuncSetAttribute((const void*)k_g1, hipFuncAttributeMaxDynamicSharedMemorySize, LDS_G);
    hipFuncSetAttribute((const void*)k_g2, hipFuncAttributeMaxDynamicSharedMemorySize, LDS_G);
    hipFuncSetAttribute((const void*)k_gemm_resid, hipFuncAttributeMaxDynamicSharedMemorySize, LDS_G);
    hipFuncSetAttribute((const void*)k_g6, hipFuncAttributeMaxDynamicSharedMemorySize, 256 * 133 * 4 + 1024);
    hipFuncSetAttribute((const void*)k_indexer, hipFuncAttributeMaxDynamicSharedMemorySize, 36864);
    hipFuncSetAttribute((const void*)k_dsa_attn, hipFuncAttributeMaxDynamicSharedMemorySize, LDS_ATT);
    hipFuncSetAttribute((const void*)k_dn_intra, hipFuncAttributeMaxDynamicSharedMemorySize, 133120);
    hipFuncSetAttribute((const void*)k_dn_scan, hipFuncAttributeMaxDynamicSharedMemorySize, LDS_SCAN);
    hipFuncSetAttribute((const void*)k_peer, hipFuncAttributeMaxDynamicSharedMemorySize, 16384);
    attr = true;
  }
  hipMemsetAsync(ws + OFF_WINT, 0, 2688ull * 1024 * 2, stream);
  hipMemsetAsync(ws + OFF_WUVT, 0, 8ull * 128 * 256 * 2, stream);
  {
    CvtJobs J{};
    u16* winT = (u16*)(ws + OFF_WINT);
    add_job(J, P.w_in, winT, 1024, 584, 2640, 1024, 1.f, 1);
    add_job(J, P.w_in + 2632, winT + 584l * 1024, 1024, 8, 2640, 1024, 1.f, 1);
    add_job(J, P.w_in + 584, winT + 640l * 1024, 1024, 1536, 2640, 1024, 1.f, 1);
    add_job(J, P.w_in + 2120, winT + 2176l * 1024, 1024, 512, 2640, 1024, 1.f, 1);
    add_job(J, P.w_iq, (u16*)(ws + OFF_WG2T), 256, 512, 512, 256, 1.f, 1);
    add_job(J, P.w_uq, (u16*)(ws + OFF_WUQ), 256, 512, 512, 512, 1.f, 0);
    add_job(J, P.w_uk, (u16*)(ws + OFF_WUK), 256, 512, 512, 512, 1.f, 0);
    for (int h = 0; h < 8; ++h) add_job(J, P.w_uv + h * 64, (u16*)(ws + OFF_WUVT) + h * 128l * 256, 256, 64, 512, 256, 1.f, 1);
    add_job(J, P.w_out, (u16*)(ws + OFF_WOUTT), 1024, 1024, 1024, 1024, 1.f, 1);
    add_job(J, P.wq_x, (u16*)(ws + OFF_WQT), 1024, 512, 512, 1024, 0.08838834764831845f, 1);
    add_job(J, P.wk_x, (u16*)(ws + OFF_WKT), 1024, 512, 512, 1024, 1.f, 1);
    add_job(J, P.wv_x, (u16*)(ws + OFF_WVT), 1024, 512, 512, 1024, 1.f, 1);
    add_job(J, P.wo_x, (u16*)(ws + OFF_WOT), 512, 1024, 1024, 512, 1.f, 1);
    add_job(J, P.w_pq, (u16*)(ws + OFF_WPQ), 1024, 2048, 2048, 2048, 1.f, 0);
    add_job(J, P.sub_keys, (u16*)(ws + OFF_SUBK), 2048, 128, 128, 128, 1.f, 0);
    hipLaunchKernelGGL(k_cvt, dim3(GR), dim3(NTHR), 32768, stream, J);
  }
  hipLaunchKernelGGL(k_norm, dim3(GR), dim3(NTHR), 0, stream, P.x, P.g_mix, (u16*)(ws + OFF_H), T_TOK);
  hipLaunchKernelGGL(k_norm, dim3(GR), dim3(NTHR), 0, stream, P.mem, P.g_mem, (u16*)(ws + OFF_MEMN), 1024);
  {
    GemmP g{};
    g.A = (u16*)(ws + OFF_WUK); g.lda = 512; g.a_bs = 64; g.Bt = (u16*)(ws + OFF_WUQ); g.ldb = 512; g.b_bs = 64;
    g.C = (u16*)(ws + OFF_WG2T) + 512l * 256; g.ldc = 256; g.c_bs = 256l * 256; g.M = 256; g.N = 256; g.K = 64; g.nbatch = 8; g.scale = 0.125f; g.ncols = 128; g.tstore = 0;
    hipLaunchKernelGGL(k_gemm_bf16, dim3(GR), dim3(NTHR), LDS_G, stream, g);
  }
  {
    GemmP g{};
    g.A = (u16*)(ws + OFF_WPQ); g.lda = 2048; g.a_bs = 128; g.Bt = (u16*)(ws + OFF_SUBK); g.ldb = 128; g.b_bs = 128l * 128;
    g.C = (u16*)(ws + OFF_WEFFT); g.ldc = 1024; g.c_bs = 128l * 1024; g.M = 1024; g.N = 128; g.K = 128; g.nbatch = 16; g.scale = 1.f; g.ncols = 128; g.tstore = 1;
    hipLaunchKernelGGL(k_gemm_bf16, dim3(GR), dim3(NTHR), LDS_G, stream, g);
  }
  {
    GemmP g{};
    g.A = (u16*)(ws + OFF_MEMN); g.lda = 1024; g.a_bs = 0; g.Bt = (u16*)(ws + OFF_WKT); g.ldb = 1024; g.b_bs = 0;
    g.C = (u16*)(ws + OFF_KX); g.ldc = 512; g.c_bs = 0; g.M = 1024; g.N = 512; g.K = 1024; g.nbatch = 1; g.scale = 1.f; g.ncols = 128; g.tstore = 0;
    hipLaunchKernelGGL(k_gemm_bf16, dim3(GR), dim3(NTHR), LDS_G, stream, g);
  }
  {
    GemmP g{};
    g.A = (u16*)(ws + OFF_WVT); g.lda = 1024; g.a_bs = 0; g.Bt = (u16*)(ws + OFF_MEMN); g.ldb = 1024; g.b_bs = 256l * 1024;
    g.C = (u16*)(ws + OFF_VTX); g.ldc = 256; g.c_bs = 512l * 256; g.M = 512; g.N = 256; g.K = 1024; g.nbatch = 4; g.scale = 1.f; g.ncols = 128; g.tstore = 0;
    hipLaunchKernelGGL(k_gemm_bf16, dim3(GR), dim3(NTHR), LDS_G, stream, g);
  }
  hipLaunchKernelGGL(k_g1, dim3(GR), dim3(NTHR), LDS_G, stream, P);
  hipLaunchKernelGGL(k_dsa_prep, dim3(GR), dim3(NTHR), 0, stream, P);
  hipLaunchKernelGGL(k_dn_prep, dim3(GR), dim3(NTHR), 0, stream, P);
  hipLaunchKernelGGL(k_dn_intra, dim3(GR), dim3(NTHR), 133120, stream, P);
  hipLaunchKernelGGL(k_dn_scan, dim3(16), dim3(NTHR), LDS_SCAN, stream, P);
  hipLaunchKernelGGL(k_dn_gate, dim3(GR), dim3(NTHR), 0, stream, P);
  hipLaunchKernelGGL(k_g2, dim3(GR), dim3(NTHR), LDS_G, stream, P);
  hipLaunchKernelGGL(k_indexer, dim3(GR), dim3(NTHR), 36864, stream, P);
  hipLaunchKernelGGL(k_dsa_attn, dim3(GR), dim3(NTHR), LDS_ATT, stream, P);
  {
    GemmP g{};
    g.A = (u16*)d_out; g.lda = 2048; g.a_bs = 256; g.Bt = (u16*)(ws + OFF_WUVT); g.ldb = 256; g.b_bs = 128l * 256;
    g.C = (u16*)(ws + OFF_MIX); g.ldc = 1024; g.c_bs = 64; g.M = T_TOK; g.N = 128; g.K = 256; g.nbatch = 8; g.scale = 1.f; g.ncols = 64; g.tstore = 0;
    hipLaunchKernelGGL(k_gemm_bf16, dim3(GR), dim3(NTHR), LDS_G, stream, g);
  }
  {
    GemmR g{}; g.A = (u16*)(ws + OFF_MIX); g.lda = 1024; g.Bt = (u16*)(ws + OFF_WOUTT); g.ldb = 1024; g.R = P.x; g.C = P.out; g.K = 1024;
    hipLaunchKernelGGL(k_gemm_resid, dim3(GR), dim3(NTHR), LDS_G, stream, g);
  }
  {
    CvtJobs J{};
    add_job(J, P.u_emb, (u16*)(ws + OFF_UEMB), 16384, 1024, 1024, 1024, 1.f, 0);
    add_job(J, P.v_emb, (u16*)(ws + OFF_VEMB), 16384, 1024, 1024, 1024, 1.f, 0);
    hipLaunchKernelGGL(k_cvt, dim3(GR), dim3(NTHR), 32768, stream, J);
  }
  hipLaunchKernelGGL(k_norm, dim3(GR), dim3(NTHR), 0, stream, (const float*)P.out, P.g_cross, (u16*)(ws + OFF_H), T_TOK);
  {
    GemmP g{}; g.A = (u16*)(ws + OFF_H); g.lda = 1024; g.a_bs = 0; g.Bt = (u16*)(ws + OFF_WQT); g.ldb = 1024; g.b_bs = 0;
    g.C = (u16*)(ws + OFF_QX); g.ldc = 512; g.c_bs = 0; g.M = T_TOK; g.N = 512; g.K = 1024; g.nbatch = 1; g.scale = 1.f; g.ncols = 128; g.tstore = 0;
    hipLaunchKernelGGL(k_gemm_bf16, dim3(GR), dim3(NTHR), LDS_G, stream, g);
  }
  hipLaunchKernelGGL(k_xattn, dim3(GR), dim3(NTHR), 0, stream, P);
  {
    GemmR g{}; g.A = (u16*)(ws + OFF_OX); g.lda = 512; g.Bt = (u16*)(ws + OFF_WOT); g.ldb = 512; g.R = P.out; g.C = P.out; g.K = 512;
    hipLaunchKernelGGL(k_gemm_resid, dim3(GR), dim3(NTHR), LDS_G, stream, g);
  }
  hipLaunchKernelGGL(k_norm, dim3(GR), dim3(NTHR), 0, stream, (const float*)P.out, P.g_ffn, (u16*)(ws + OFF_H), T_TOK);
  hipLaunchKernelGGL(k_g6, dim3(GR), dim3(NTHR), 256 * 133 * 4 + 1024, stream, P);
  hipLaunchKernelGGL(k_peer, dim3(GR), dim3(NTHR), 16384, stream, P);
}
```

```cpp
#include <hip/hip_runtime.h>
#include <stdint.h>
#include <stdio.h>
#include <string.h>

typedef unsigned short u16;
typedef __attribute__((ext_vector_type(8))) short bf16x8;
typedef __attribute__((ext_vector_type(4))) short s16x4;
typedef __attribute__((ext_vector_type(4))) float f32x4;
typedef __attribute__((ext_vector_type(4))) unsigned u32x4;
typedef __attribute__((ext_vector_type(2))) unsigned u32x2;
#define LAS __attribute__((address_space(3)))

#define T_TOK 32768
#define SEQ 8192
#define NB 4
#define DM 1024
#define NTHR 512
#define EPSV 1e-6f

__device__ __forceinline__ u16 f2bf(float f) { __bf16 b = (__bf16)f; return __builtin_bit_cast(u16, b); }
__device__ __forceinline__ float bf2f(u16 h) { return __uint_as_float(((unsigned)h) << 16); }
__device__ __forceinline__ unsigned pack2(float a, float b) { return (unsigned)f2bf(a) | ((unsigned)f2bf(b) << 16); }
__device__ __forceinline__ float lo2f(unsigned v) { return __uint_as_float(v << 16); }
__device__ __forceinline__ float hi2f(unsigned v) { return __uint_as_float(v & 0xffff0000u); }
__device__ __forceinline__ int otid() { int t = threadIdx.x; asm volatile("" : "+v"(t)); return t; }
__device__ __forceinline__ float wave_sum(float v) {
#pragma unroll
  for (int o = 32; o >= 1; o >>= 1) v += __shfl_xor(v, o);
  return v;
}
__device__ __forceinline__ f32x4 mfma16(bf16x8 a, bf16x8 b, f32x4 c) { return __builtin_amdgcn_mfma_f32_16x16x32_bf16(a, b, c, 0, 0, 0); }
__device__ __forceinline__ unsigned umed3(unsigned a, unsigned b, unsigned c) { unsigned r; asm("v_med3_u32 %0, %1, %2, %3" : "=v"(r) : "v"(a), "v"(b), "v"(c)); return r; }
__device__ __forceinline__ unsigned fkey(float f) { unsigned u = __float_as_uint(f); return u ^ ((u >> 31) ? 0xffffffffu : 0x80000000u); }
__device__ __forceinline__ float keyf(unsigned m) { unsigned u = (m & 0x80000000u) ? (m ^ 0x80000000u) : ~m; return __uint_as_float(u); }

#define MB (1024ull * 1024ull)
#define OFF_BAR      0ull
#define OFF_WINT     (1 * MB)
#define OFF_WG2T     (7 * MB)
#define OFF_WUQ      (9 * MB)
#define OFF_WUK      (9 * MB + 512 * 1024)
#define OFF_WUVT     (10 * MB)
#define OFF_WOUTT    (11 * MB)
#define OFF_WQT      (13 * MB)
#define OFF_WKT      (14 * MB)
#define OFF_WVT      (15 * MB)
#define OFF_WOT      (16 * MB)
#define OFF_WPQ      (17 * MB)
#define OFF_SUBK     (21 * MB)
#define OFF_WEFFT    (22 * MB)
#define OFF_MEMN     (26 * MB)
#define OFF_KX       (28 * MB)
#define OFF_VTX      (29 * MB)
#define OFF_KIDXN    (30 * MB)
#define OFF_WIDX     (34 * MB)
#define OFF_GB       (35 * MB)
#define OFF_INTRA    (37 * MB)
#define OFF_WDN      (53 * MB)
#define OFF_SEL      (85 * MB)
#define OFF_H        (101 * MB)
#define OFF_QI       (OFF_H)
#define OFF_CQN      (OFF_H + 32 * MB)
#define OFF_CKVN     (OFF_H + 48 * MB)
#define OFF_PA       (165 * MB)
#define OFF_PB       (205 * MB)
#define OFF_SCORES   (OFF_PA)
#define OFF_UEMB     (OFF_PA)
#define OFF_VEMB     (OFF_PA + 32 * MB)
#define OFF_BZ       (301 * MB)
#define OFF_QKV      (333 * MB)
#define OFF_QX       (OFF_QKV)
#define OFF_OX       (OFF_QKV + 32 * MB)
#define OFF_PLIST    (OFF_QKV + 64 * MB)
#define OFF_MIX      (429 * MB)
#define WS_NEED      (493 * MB)

struct CvtJob { const float* src; u16* dst; int R, C; long sld, dld; float scale; int transpose; };
#define MAXJOBS 24
struct CvtJobs { CvtJob j[MAXJOBS]; int n; int pad; };

__device__ __forceinline__ void cvt_run(const CvtJobs& J, char* smem, int bid, int nblk) {
  const int tidx = otid();
  float* tile = (float*)smem;
  for (int ji = 0; ji < J.n; ++ji) {
    const CvtJob jb = J.j[ji];
    if (!jb.transpose) {
      const long nvec = (long)jb.R * (jb.C >> 2);
      const int cv = jb.C >> 2;
      for (long i = (long)bid * NTHR + tidx; i < nvec; i += (long)nblk * NTHR) {
        const long r = i / cv; const int c = (int)(i - r * cv) * 4;
        const float4 v = *(const float4*)(jb.src + r * jb.sld + c);
        u32x2 o; o[0] = pack2(v.x * jb.scale, v.y * jb.scale); o[1] = pack2(v.z * jb.scale, v.w * jb.scale);
        *(u32x2*)(jb.dst + r * jb.dld + c) = o;
      }
    } else {
      const int tr = (jb.R + 63) >> 6, tc = (jb.C + 63) >> 6;
      for (int t = bid; t < tr * tc; t += nblk) {
        const int r0 = (t / tc) * 64, c0 = (t % tc) * 64;
        __syncthreads();
        for (int i = tidx; i < 4096; i += NTHR) {
          const int r = i >> 6, c = i & 63;
          float v = 0.f;
          if (r0 + r < jb.R && c0 + c < jb.C) v = jb.src[(long)(r0 + r) * jb.sld + c0 + c];
          tile[r * 65 + c] = v;
        }
        __syncthreads();
        for (int i = tidx; i < 4096; i += NTHR) {
          const int c = i >> 6, r = i & 63;
          if (r0 + r < jb.R && c0 + c < jb.C) jb.dst[(long)(c0 + c) * jb.dld + r0 + r] = f2bf(tile[r * 65 + c] * jb.scale);
        }
      }
    }
  }
}

__device__ __forceinline__ void rmsnorm_rows(const float* src, const float* g, u16* dst, int nrows, int bid, int nblk) {
  const int tidx = otid();
  const int lane = tidx & 63, wv = tidx >> 6;
  for (int r = bid * 8 + wv; r < nrows; r += nblk * 8) {
    const float* p = src + (long)r * DM;
    float4 v[4]; float ss = 0.f;
#pragma unroll
    for (int i = 0; i < 4; ++i) { v[i] = *(const float4*)(p + i * 256 + lane * 4); ss += v[i].x * v[i].x + v[i].y * v[i].y + v[i].z * v[i].z + v[i].w * v[i].w; }
    ss = wave_sum(ss);
    const float rs = rsqrtf(ss * (1.f / DM) + EPSV);
#pragma unroll
    for (int i = 0; i < 4; ++i) {
      const float4 gg = *(const float4*)(g + i * 256 + lane * 4);
      u32x2 o; o[0] = pack2(v[i].x * rs * gg.x, v[i].y * rs * gg.y); o[1] = pack2(v[i].z * rs * gg.z, v[i].w * rs * gg.w);
      *(u32x2*)(dst + (long)r * DM + i * 256 + lane * 4) = o;
    }
  }
}

template <int LDC>
__device__ __forceinline__ void gemm_tile(const u16* __restrict__ A, long lda, const u16* __restrict__ Bt, long ldb, int K, char* smem) {
  const int tidx = otid();
  const int tid = tidx, lane = tid & 63, wv = tid >> 6, lr = lane & 15, g = lane >> 4;
  const int wm = wv >> 1, wn = wv & 1;
  f32x4 acc[4][4];
#pragma unroll
  for (int i = 0; i < 4; ++i)
#pragma unroll
    for (int j = 0; j < 4; ++j) acc[i][j] = (f32x4){0.f, 0.f, 0.f, 0.f};
  u32x4 ra[4], rb[2];
  const int nk = K >> 6;
  const int srow = tid >> 3, sch = tid & 7;
  const u16* pa = A + (long)srow * lda + sch * 8;
  const u16* pb = Bt + (long)srow * ldb + sch * 8;
  const unsigned lds_off = (unsigned)(srow * 128 + ((sch ^ (srow & 7)) << 4));
#pragma unroll
  for (int i = 0; i < 4; ++i) ra[i] = *(const u32x4*)(pa + (long)(i * 64) * lda);
#pragma unroll
  for (int i = 0; i < 2; ++i) rb[i] = *(const u32x4*)(pb + (long)(i * 64) * ldb);
  __syncthreads();
#pragma unroll
  for (int i = 0; i < 4; ++i) *(u32x4*)(smem + lds_off + i * 8192) = ra[i];
#pragma unroll
  for (int i = 0; i < 2; ++i) *(u32x4*)(smem + 32768 + lds_off + i * 8192) = rb[i];
  __syncthreads();
  for (int kt = 0; kt < nk; ++kt) {
    const char* sA = smem + (kt & 1) * 49152;
    const char* sB = sA + 32768;
    if (kt + 1 < nk) {
#pragma unroll
      for (int i = 0; i < 4; ++i) ra[i] = *(const u32x4*)(pa + (long)(i * 64) * lda + (kt + 1) * 64);
#pragma unroll
      for (int i = 0; i < 2; ++i) rb[i] = *(const u32x4*)(pb + (long)(i * 64) * ldb + (kt + 1) * 64);
    }
#pragma unroll
    for (int ks = 0; ks < 2; ++ks) {
      bf16x8 a[4], b[4];
#pragma unroll
      for (int mi = 0; mi < 4; ++mi) { const int row = wm * 64 + mi * 16 + lr; a[mi] = *(const bf16x8*)(sA + row * 128 + (((ks * 4 + g) ^ (row & 7)) << 4)); }
#pragma unroll
      for (int ni = 0; ni < 4; ++ni) { const int row = wn * 64 + ni * 16 + lr; b[ni] = *(const bf16x8*)(sB + row * 128 + (((ks * 4 + g) ^ (row & 7)) << 4)); }
#pragma unroll
      for (int mi = 0; mi < 4; ++mi)
#pragma unroll
        for (int ni = 0; ni < 4; ++ni) acc[mi][ni] = mfma16(a[mi], b[ni], acc[mi][ni]);
    }
    if (kt + 1 < nk) {
      char* dA = smem + ((kt + 1) & 1) * 49152;
#pragma unroll
      for (int i = 0; i < 4; ++i) *(u32x4*)(dA + lds_off + i * 8192) = ra[i];
#pragma unroll
      for (int i = 0; i < 2; ++i) *(u32x4*)(dA + 32768 + lds_off + i * 8192) = rb[i];
    }
    __syncthreads();
  }
  float* sC = (float*)smem;
#pragma unroll
  for (int mi = 0; mi < 4; ++mi)
#pragma unroll
    for (int ni = 0; ni < 4; ++ni)
#pragma unroll
      for (int r = 0; r < 4; ++r) sC[(wm * 64 + mi * 16 + g * 4 + r) * LDC + wn * 64 + ni * 16 + lr] = acc[mi][ni][r];
  __syncthreads();
}

__device__ __forceinline__ void epi_store_bf16(const char* smem, u16* C, long ldc, float scale, int ncols) {
  const int tidx = otid();
  const float* sC = (const float*)smem;
  const int cv = ncols >> 2;
  for (int i = tidx; i < 256 * cv; i += NTHR) {
    const int r = i / cv, c = (i - r * cv) * 4;
    const float4 v = *(const float4*)(sC + r * 132 + c);
    u32x2 o; o[0] = pack2(v.x * scale, v.y * scale); o[1] = pack2(v.z * scale, v.w * scale);
    *(u32x2*)(C + (long)r * ldc + c) = o;
  }
}
__device__ __forceinline__ void epi_resid_f32(const char* smem, const float* R, float* C, long ldc) {
  const int tidx = otid();
  const float* sC = (const float*)smem;
  for (int i = tidx; i < 256 * 32; i += NTHR) {
    const int r = i >> 5, c = (i & 31) * 4;
    const float4 v = *(const float4*)(sC + r * 132 + c);
    const float4 x = *(const float4*)(R + (long)r * ldc + c);
    float4 o; o.x = v.x + x.x; o.y = v.y + x.y; o.z = v.z + x.z; o.w = v.w + x.w;
    *(float4*)(C + (long)r * ldc + c) = o;
  }
}

struct Params {
  const float *x, *mem, *g_mix, *w_in, *g_cq, *g_ckv, *g_kidx, *w_uq, *w_iq, *w_uk, *w_uv, *rel_bias, *conv_w, *A_log, *dt_bias, *g_onorm,
      *w_out, *g_cross, *g_mem, *wq_x, *wk_x, *wv_x, *wo_x, *g_ffn, *w_pq, *sub_keys, *u_emb, *v_emb, *g_final;
  float* out;
  char* ws;
};


struct GemmP { const u16* A; long lda, a_bs; const u16* Bt; long ldb, b_bs; u16* C; long ldc, c_bs; int M, N, K, nbatch; float scale; int ncols; int tstore; };
__device__ __forceinline__ void gemm_bf16_phase(const GemmP& p, char* smem, int bid, int nblk) {
  const int tidx = otid();
  const int nm = p.M >> 8, nn = p.N >> 7, per = nm * nn;
  for (int t = bid; t < per * p.nbatch; t += nblk) {
    const int b = t / per, r = t - b * per, mp = r / nn, np = r - mp * nn;
    gemm_tile<132>(p.A + b * p.a_bs + (long)mp * 256 * p.lda, p.lda, p.Bt + b * p.b_bs + (long)np * 128 * p.ldb, p.ldb, p.K, smem);
    if (!p.tstore) epi_store_bf16(smem, p.C + b * p.c_bs + (long)mp * 256 * p.ldc + np * 128, p.ldc, p.scale, p.ncols);
    else {
      const float* sC = (const float*)smem;
      u16* C = p.C + b * p.c_bs + (long)np * 128 * p.ldc + mp * 256;
      for (int i = tidx; i < 256 * 128; i += NTHR) { const int n = i >> 8, m = i & 255; C[(long)n * p.ldc + m] = f2bf(sC[m * 132 + n] * p.scale); }
    }
  }
}

__device__ __forceinline__ void g1_phase(const Params& P, char* smem, int bid, int nblk) {
  const u16* A = (const u16*)(P.ws + OFF_H); const u16* Bt = (const u16*)(P.ws + OFF_WINT);
  for (int t = bid; t < 128 * 21; t += nblk) {
    const int mp = t / 21, np = t - mp * 21;
    gemm_tile<132>(A + (long)mp * 256 * DM, DM, Bt + (long)np * 128 * DM, DM, DM, smem);
    u16* C; long ldc;
    if (np < 5) { C = (u16*)(P.ws + OFF_PA) + np * 128; ldc = 640; }
    else if (np < 17) { C = (u16*)(P.ws + OFF_PB) + (np - 5) * 128; ldc = 1536; }
    else { C = (u16*)(P.ws + OFF_BZ) + (np - 17) * 128; ldc = 512; }
    epi_store_bf16(smem, C + (long)mp * 256 * ldc, ldc, 1.f, 128);
  }
}

__device__ __forceinline__ void g2_phase(const Params& P, char* smem, int bid, int nblk) {
  const u16* A = (const u16*)(P.ws + OFF_CQN); const u16* Bt = (const u16*)(P.ws + OFF_WG2T);
  for (int t = bid; t < 128 * 20; t += nblk) {
    const int mp = t / 20, np = t - mp * 20;
    gemm_tile<132>(A + (long)mp * 256 * 256, 256, Bt + (long)np * 128 * 256, 256, 256, smem);
    if (np < 4) epi_store_bf16(smem, (u16*)(P.ws + OFF_QI) + (long)mp * 256 * 512 + np * 128, 512, 1.f, 128);
    else epi_store_bf16(smem, (u16*)P.out + (long)mp * 256 * 2048 + (np - 4) * 128, 2048, 1.f, 128);
  }
}

struct GemmR { const u16* A; long lda; const u16* Bt; long ldb; const float* R; float* C; int K; };
__device__ __forceinline__ void gemm_resid_phase(const GemmR& p, char* smem, int bid, int nblk) {
  for (int t = bid; t < 128 * 8; t += nblk) {
    const int mp = t >> 3, np = t & 7;
    gemm_tile<132>(p.A + (long)mp * 256 * p.lda, p.lda, p.Bt + (long)np * 128 * p.ldb, p.ldb, p.K, smem);
    epi_resid_f32(smem, p.R + (long)mp * 256 * DM + np * 128, p.C + (long)mp * 256 * DM + np * 128, DM);
  }
}

__device__ __forceinline__ void dsa_prep_phase(const Params& P, int bid, int nblk) {
  const int tidx = otid();
  const int lane = tidx & 63, wv = tidx >> 6;
  const u16* Pa = (const u16*)(P.ws + OFF_PA);
  u16* cqn = (u16*)(P.ws + OFF_CQN); u16* ckvn = (u16*)(P.ws + OFF_CKVN); u16* kidxn = (u16*)(P.ws + OFF_KIDXN); float* widx = (float*)(P.ws + OFF_WIDX);
  for (int t = bid * 8 + wv; t < T_TOK; t += nblk * 8) {
    const u16* row = Pa + (long)t * 640;
    const u32x2 a = *(const u32x2*)(row + lane * 4);
    const u32x2 c = *(const u32x2*)(row + 256 + lane * 4);
    const float k = bf2f(row[512 + lane]);
    float a0 = lo2f(a[0]), a1 = hi2f(a[0]), a2 = lo2f(a[1]), a3 = hi2f(a[1]);
    float c0 = lo2f(c[0]), c1 = hi2f(c[0]), c2 = lo2f(c[1]), c3 = hi2f(c[1]);
    const float sa = wave_sum(a0 * a0 + a1 * a1 + a2 * a2 + a3 * a3), sc = wave_sum(c0 * c0 + c1 * c1 + c2 * c2 + c3 * c3), sk = wave_sum(k * k);
    const float ra = rsqrtf(sa * (1.f / 256) + EPSV), rc = rsqrtf(sc * (1.f / 256) + EPSV), rk = rsqrtf(sk * (1.f / 64) + EPSV);
    const float4 ga = *(const float4*)(P.g_cq + lane * 4), gc = *(const float4*)(P.g_ckv + lane * 4);
    u32x2 o; o[0] = pack2(a0 * ra * ga.x, a1 * ra * ga.y); o[1] = pack2(a2 * ra * ga.z, a3 * ra * ga.w);
    *(u32x2*)(cqn + (long)t * 256 + lane * 4) = o;
    o[0] = pack2(c0 * rc * gc.x, c1 * rc * gc.y); o[1] = pack2(c2 * rc * gc.z, c3 * rc * gc.w);
    *(u32x2*)(ckvn + (long)t * 256 + lane * 4) = o;
    kidxn[(long)t * 64 + lane] = f2bf(k * rk * P.g_kidx[lane]);
    if (lane < 8) widx[(long)t * 8 + lane] = bf2f(row[576 + lane]) * 0.04419417382415922f;
  }
}

__device__ __forceinline__ int idx_unit_map(int v) {
  const int b = v >> 9, r = v & 511;
  const int p = (r < 256) ? r : 767 - r;
  return b * 512 + p;
}
__device__ __forceinline__ void select_query(const float* __restrict__ row, int L, u16* __restrict__ sel, unsigned* hist, float* cval, int lane) {
  const int n64 = L >> 6;
  float lo = 3.0e38f, hi = -3.0e38f;
  for (int i = 0; i < n64; ++i) { const float v = row[i * 64 + lane]; lo = fminf(lo, v); hi = fmaxf(hi, v); }
#pragma unroll
  for (int o = 32; o >= 1; o >>= 1) { lo = fminf(lo, __shfl_xor(lo, o)); hi = fmaxf(hi, __shfl_xor(hi, o)); }
  int need = 256;
  float tau = lo;
  for (int iter = 0; iter < 64; ++iter) {
    if (!(hi > lo)) { tau = lo; break; }
    for (int i = lane; i < 1024; i += 64) hist[i] = 0u;
    __builtin_amdgcn_wave_barrier();
    const float scale = 1024.f / (hi - lo);
    for (int i = 0; i < n64; ++i) {
      const float v = row[i * 64 + lane];
      if (v >= lo && v <= hi) { int b = (int)((v - lo) * scale); b = b > 1023 ? 1023 : b; atomicAdd(&hist[b], 1u); }
    }
    __builtin_amdgcn_wave_barrier();
    unsigned c[16]; unsigned tot = 0;
#pragma unroll
    for (int j = 0; j < 16; ++j) { c[j] = hist[1023 - 16 * lane - j]; tot += c[j]; }
    unsigned incl = tot;
#pragma unroll
    for (int o = 1; o < 64; o <<= 1) { const unsigned v = __shfl_up(incl, o); if (lane >= o) incl += v; }
    const unsigned excl = incl - tot;
    const bool mine = (excl < (unsigned)need) && (incl >= (unsigned)need);
    int bsel = 0; unsigned above = 0, nstar = 0;
    if (mine) {
      unsigned run = excl;
#pragma unroll
      for (int j = 0; j < 16; ++j) { if (run < (unsigned)need && run + c[j] >= (unsigned)need) { bsel = 1023 - 16 * lane - j; above = run; nstar = c[j]; } run += c[j]; }
    }
    const unsigned long long mk = __ballot(mine);
    const int src = __ffsll((long long)mk) - 1;
    bsel = __shfl(bsel, src); above = __shfl(above, src); nstar = __shfl(nstar, src);
    need -= (int)above;
    float nlo = 3.0e38f, nhi = -3.0e38f; int cnt = 0;
    for (int i = 0; i < n64; ++i) {
      const float v = row[i * 64 + lane];
      bool in = false;
      if (v >= lo && v <= hi) { int b = (int)((v - lo) * scale); b = b > 1023 ? 1023 : b; in = (b == bsel); }
      if (in) { nlo = fminf(nlo, v); nhi = fmaxf(nhi, v); }
      if (nstar <= 64u) {
        const unsigned long long m = __ballot(in);
        if (in) { const int pos = cnt + __builtin_amdgcn_mbcnt_hi((unsigned)(m >> 32), __builtin_amdgcn_mbcnt_lo((unsigned)m, 0u)); cval[pos] = v; }
        cnt += __popcll(m);
      }
    }
#pragma unroll
    for (int o = 32; o >= 1; o >>= 1) { nlo = fminf(nlo, __shfl_xor(nlo, o)); nhi = fmaxf(nhi, __shfl_xor(nhi, o)); }
    if (nstar <= 64u) {
      __builtin_amdgcn_wave_barrier();
      const float mv = (lane < (int)nstar) ? cval[lane] : -3.0e38f;
      int rank = 0;
      for (int j = 0; j < (int)nstar; ++j) { const float o = cval[j]; rank += (o > mv || (o == mv && j < lane)) ? 1 : 0; }
      const unsigned long long mm = __ballot(lane < (int)nstar && rank == need - 1);
      const int s2 = __ffsll((long long)mm) - 1;
      tau = __shfl(mv, s2 < 0 ? 0 : s2);
      break;
    }
    lo = nlo; hi = nhi;
    tau = lo;
  }
  int cgt = 0;
  for (int i = 0; i < n64; ++i) { const float v = row[i * 64 + lane]; cgt += __popcll(__ballot(v > tau)); }
  int need_eq = 256 - cgt, pos = 0, eqtaken = 0;
  for (int i = 0; i < n64; ++i) {
    const float v = row[i * 64 + lane];
    const bool gt = v > tau; const bool eq = (v == tau);
    const unsigned long long me = __ballot(eq);
    const int eqrank = __builtin_amdgcn_mbcnt_hi((unsigned)(me >> 32), __builtin_amdgcn_mbcnt_lo((unsigned)me, 0u));
    const bool take = gt || (eq && (eqtaken + eqrank) < need_eq);
    const unsigned long long mt = __ballot(take);
    if (take) { const int p = pos + __builtin_amdgcn_mbcnt_hi((unsigned)(mt >> 32), __builtin_amdgcn_mbcnt_lo((unsigned)mt, 0u)); if (p < 256) sel[p] = (u16)(i * 64 + lane); }
    pos += __popcll(mt); eqtaken += __popcll(me);
  }
}

#define ATT_ROWB 544
__device__ __forceinline__ int t5_bucket(int rel) {
  const int n = rel < 0 ? -rel : rel;
  const int lg = 8 + (n >= 12) + (n >= 16) + (n >= 23) + (n >= 32) + (n >= 46) + (n >= 64) + (n >= 91);
  return (rel > 0 ? 16 : 0) + (n < 8 ? n : lg);
}
#define DSA_SBIAS 139264
#define DSA_SSEL 140288
#define LDS_XB 148480
#define LDS_UNIT 148496
#define LDS_TOTAL 148512
__device__ __forceinline__ void attn_query(const Params& P, int t, const u16* ssel, char* rows, const float* sbias, int lane) {
  const int lr = lane & 15, g = lane >> 4;
  const u16* ckv = (const u16*)(P.ws + OFF_CKVN);
  u16* qlat = (u16*)P.out;
  const int b = t >> 13, pos = t & 8191, L = ((pos >> 6) + 1) * 64, n = L < 256 ? L : 256;
  const u16* kb = ckv + (long)(b * SEQ) * 256;
  bf16x8 bq[8];
#pragma unroll
  for (int ks = 0; ks < 8; ++ks) {
    bf16x8 v = (bf16x8){0, 0, 0, 0, 0, 0, 0, 0};
    if (lr < 8) v = *(const bf16x8*)(qlat + (long)t * 2048 + lr * 256 + ks * 32 + g * 8);
    bq[ks] = v;
  }
  float m_run = -3.0e38f, l_run = 0.f;
  f32x4 O[16];
#pragma unroll
  for (int i = 0; i < 16; ++i) O[i] = (f32x4){0.f, 0.f, 0.f, 0.f};
  for (int kbk = 0; kbk < (n >> 5); ++kbk) {
#pragma unroll
    for (int hh = 0; hh < 2; ++hh) {
      u32x4 gr[8];
#pragma unroll
      for (int i = 0; i < 8; ++i) {
        const int r = hh * 16 + i * 2 + (lane >> 5);
        const int idx = ssel[kbk * 32 + r];
        gr[i] = *(const u32x4*)(kb + (long)idx * 256 + (lane & 31) * 8);
      }
#pragma unroll
      for (int i = 0; i < 8; ++i) { const int r = hh * 16 + i * 2 + (lane >> 5); *(u32x4*)(rows + r * ATT_ROWB + (lane & 31) * 16) = gr[i]; }
    }
    __builtin_amdgcn_wave_barrier();
    f32x4 S[2];
#pragma unroll
    for (int mt = 0; mt < 2; ++mt) {
      f32x4 d = (f32x4){0.f, 0.f, 0.f, 0.f};
#pragma unroll
      for (int ks = 0; ks < 8; ++ks) { const bf16x8 a = *(const bf16x8*)(rows + (mt * 16 + lr) * ATT_ROWB + (ks * 4 + g) * 16); d = mfma16(a, bq[ks], d); }
      S[mt] = d;
    }
    float mx = -3.0e38f;
#pragma unroll
    for (int mt = 0; mt < 2; ++mt)
#pragma unroll
      for (int r = 0; r < 4; ++r) {
        const int idx = ssel[kbk * 32 + mt * 16 + g * 4 + r];
        const float bs = sbias[t5_bucket(idx - pos) * 8 + (lr & 7)];
        S[mt][r] += bs; mx = fmaxf(mx, S[mt][r]);
      }
    mx = fmaxf(mx, __shfl_xor(mx, 16)); mx = fmaxf(mx, __shfl_xor(mx, 32));
    const float m_new = fmaxf(m_run, mx);
    const float alpha = __expf(m_run - m_new);
    float ps = 0.f; float p[8];
#pragma unroll
    for (int mt = 0; mt < 2; ++mt)
#pragma unroll
      for (int r = 0; r < 4; ++r) { p[mt * 4 + r] = __expf(S[mt][r] - m_new); ps += p[mt * 4 + r]; }
    l_run = l_run * alpha + ps; m_run = m_new;
    bf16x8 ap;
#pragma unroll
    for (int j = 0; j < 8; ++j) ap[j] = (short)f2bf(p[j]);
    float al[4];
#pragma unroll
    for (int r = 0; r < 4; ++r) al[r] = __shfl(alpha, g * 4 + r);
    const int q = lr >> 2, pp = lr & 3;
    const char* tb0 = rows + (4 * g + q) * ATT_ROWB + pp * 8;
    const char* tb1 = rows + (16 + 4 * g + q) * ATT_ROWB + pp * 8;
#pragma unroll
    for (int ct = 0; ct < 16; ++ct) {
      const s16x4 v0 = __builtin_amdgcn_ds_read_tr16_b64_v4i16((LAS s16x4*)(tb0 + ct * 32));
      const s16x4 v1 = __builtin_amdgcn_ds_read_tr16_b64_v4i16((LAS s16x4*)(tb1 + ct * 32));
      bf16x8 bb; bb[0] = v0[0]; bb[1] = v0[1]; bb[2] = v0[2]; bb[3] = v0[3]; bb[4] = v1[0]; bb[5] = v1[1]; bb[6] = v1[2]; bb[7] = v1[3];
      f32x4 o = O[ct];
#pragma unroll
      for (int r = 0; r < 4; ++r) o[r] *= al[r];
      O[ct] = mfma16(ap, bb, o);
    }
    __builtin_amdgcn_wave_barrier();
  }
  float lt = l_run; lt += __shfl_xor(lt, 16); lt += __shfl_xor(lt, 32);
  const float inv = 1.f / lt;
  float iv[4];
#pragma unroll
  for (int r = 0; r < 4; ++r) iv[r] = __shfl(inv, g * 4 + r);
  if (g < 2) {
#pragma unroll
    for (int ct = 0; ct < 16; ++ct)
#pragma unroll
      for (int r = 0; r < 4; ++r) qlat[(long)t * 2048 + (g * 4 + r) * 256 + ct * 16 + lr] = f2bf(O[ct][r] * iv[r]);
  }
}

__device__ __forceinline__ void dsa_unit(const Params& P, char* smem, int unit, int bid) {
  const int tidx = otid();
  const int tid = tidx, lane = tid & 63, wv = tid >> 6, lr = lane & 15, g = lane >> 4;
  const u16* qi = (const u16*)(P.ws + OFF_QI); const u16* kidx = (const u16*)(P.ws + OFF_KIDXN); const float* widx = (const float*)(P.ws + OFF_WIDX);
  float* scr = (float*)(P.ws + OFF_SCORES) + (long)bid * 16 * 8192;
  unsigned* hist = (unsigned*)smem + wv * 1024;
  float* cval = (float*)(smem + 32768) + wv * 64;
  u16* sselw = (u16*)(smem + DSA_SSEL) + wv * 512;
  const float* sbias = (const float*)(smem + DSA_SBIAS);
  const int t0 = unit * 16, b = t0 >> 13, pos0 = t0 & 8191, L = ((pos0 >> 6) + 1) * 64;
  if (L > 256) {
    bf16x8 a[8][2];
#pragma unroll
    for (int h = 0; h < 8; ++h)
#pragma unroll
      for (int ks = 0; ks < 2; ++ks) a[h][ks] = *(const bf16x8*)(qi + (long)(t0 + lr) * 512 + h * 64 + ks * 32 + g * 8);
    float wq[4][8];
#pragma unroll
    for (int r = 0; r < 4; ++r) {
      const float4 w0 = *(const float4*)(widx + (long)(t0 + g * 4 + r) * 8), w1 = *(const float4*)(widx + (long)(t0 + g * 4 + r) * 8 + 4);
      wq[r][0] = w0.x; wq[r][1] = w0.y; wq[r][2] = w0.z; wq[r][3] = w0.w; wq[r][4] = w1.x; wq[r][5] = w1.y; wq[r][6] = w1.z; wq[r][7] = w1.w;
    }
    const u16* kb = kidx + (long)(b * SEQ) * 64;
    const int nkt = L >> 4;
    for (int kt = wv; kt < nkt; kt += 8) {
      const bf16x8 b0 = *(const bf16x8*)(kb + (long)(kt * 16 + lr) * 64 + g * 8);
      const bf16x8 b1 = *(const bf16x8*)(kb + (long)(kt * 16 + lr) * 64 + 32 + g * 8);
      float s[4] = {0.f, 0.f, 0.f, 0.f};
#pragma unroll
      for (int h = 0; h < 8; ++h) {
        f32x4 d = (f32x4){0.f, 0.f, 0.f, 0.f};
        d = mfma16(a[h][0], b0, d); d = mfma16(a[h][1], b1, d);
#pragma unroll
        for (int r = 0; r < 4; ++r) s[r] = fmaf(fmaxf(d[r], 0.f), wq[r][h], s[r]);
      }
#pragma unroll
      for (int r = 0; r < 4; ++r) scr[(long)(g * 4 + r) * 8192 + kt * 16 + lr] = s[r];
    }
  }
  __syncthreads();
#pragma unroll 1
  for (int qq = 0; qq < 2; ++qq) {
    const int ql = wv * 2 + qq;
    u16* sel = sselw + qq * 256;
    if (L <= 256) { for (int j = lane; j < 256; j += 64) sel[j] = (u16)(j < L ? j : 0); }
    else select_query(scr + (long)ql * 8192, L, sel, hist, cval, lane);
  }
  __syncthreads();
#pragma unroll 1
  for (int qq = 0; qq < 2; ++qq) attn_query(P, t0 + wv * 2 + qq, sselw + qq * 256, smem + wv * (32 * ATT_ROWB), sbias, lane);
}
__device__ __forceinline__ void dsa_queue_phase(const Params& P, char* smem, int bid, unsigned* qctr) {
  const int tidx = otid();
  const int tid = tidx;
  float* sbias = (float*)(smem + DSA_SBIAS);
  volatile int* sunit = (volatile int*)(smem + LDS_UNIT);
  __syncthreads();
  for (int i = tid; i < 256; i += NTHR) sbias[i] = P.rel_bias[i];
  for (;;) {
    __syncthreads();
    if (tid == 0) *sunit = (int)atomicAdd(qctr, 1u);
    __syncthreads();
    const int v = *sunit;
    if (v >= 2048) break;
    const int unit = (v & 3) * 512 + (511 - (v >> 2));
    dsa_unit(P, smem, unit, bid);
  }
}
__device__ __forceinline__ void dn_prep_phase(const Params& P, int bid, int nblk) {
  const int tidx = otid();
  const int lane = tidx & 63, wv = tidx >> 6, hh = lane >> 4, cg = lane & 15;
  const u16* Pb = (const u16*)(P.ws + OFF_PB); const u16* Pa = (const u16*)(P.ws + OFF_PA);
  u16* qkv = (u16*)(P.ws + OFF_QKV);
  float* gg = (float*)(P.ws + OFF_GB); float* bt = gg + 16 * 8192;
  for (int t = bid * 8 + wv; t < T_TOK; t += nblk * 8) {
    const int b = t >> 13, pos = t & 8191;
#pragma unroll
    for (int sec = 0; sec < 3; ++sec) {
      const int col = sec * 512 + hh * 128 + cg * 8;
      float y[8];
#pragma unroll
      for (int e = 0; e < 8; ++e) y[e] = 0.f;
#pragma unroll
      for (int j = 0; j < 4; ++j) {
        if (pos - 3 + j >= 0) {
          const u32x4 xv = *(const u32x4*)(Pb + (long)(t - 3 + j) * 1536 + col);
          const float4 w0 = *(const float4*)(P.conv_w + j * 1536 + col), w1 = *(const float4*)(P.conv_w + j * 1536 + col + 4);
          y[0] += w0.x * lo2f(xv[0]); y[1] += w0.y * hi2f(xv[0]); y[2] += w0.z * lo2f(xv[1]); y[3] += w0.w * hi2f(xv[1]);
          y[4] += w1.x * lo2f(xv[2]); y[5] += w1.y * hi2f(xv[2]); y[6] += w1.z * lo2f(xv[3]); y[7] += w1.w * hi2f(xv[3]);
        }
      }
      float ss = 0.f;
#pragma unroll
      for (int e = 0; e < 8; ++e) { y[e] = y[e] / (1.f + __expf(-y[e])); ss += y[e] * y[e]; }
      ss += __shfl_xor(ss, 1); ss += __shfl_xor(ss, 2); ss += __shfl_xor(ss, 4); ss += __shfl_xor(ss, 8);
      float sc = 1.f;
      if (sec == 0) sc = rsqrtf(ss + EPSV) * 0.08838834764831845f;
      else if (sec == 1) sc = rsqrtf(ss + EPSV);
      u32x4 o;
#pragma unroll
      for (int e = 0; e < 4; ++e) o[e] = pack2(y[2 * e] * sc, y[2 * e + 1] * sc);
      *(u32x4*)(qkv + (long)sec * (16l * 8192 * 128) + ((long)(b * 4 + hh) * 8192 + pos) * 128 + cg * 8) = o;
    }
    if (cg == 0) {
      const float a = bf2f(Pa[(long)t * 640 + 584 + hh]), bb = bf2f(Pa[(long)t * 640 + 588 + hh]);
      const float z = a + P.dt_bias[hh];
      const float sp = z > 20.f ? z : log1pf(__expf(z));
      gg[(long)(b * 4 + hh) * 8192 + pos] = -__expf(P.A_log[hh]) * sp;
      bt[(long)(b * 4 + hh) * 8192 + pos] = 1.f / (1.f + __expf(-bb));
    }
  }
}

__device__ __forceinline__ int perm32_pos(int c) {
  const int blk = c & ~31, w = c & 31;
  const int hi = w >> 4, gq = (w >> 2) & 3, lo = w & 3;
  return blk + gq * 8 + hi * 4 + lo;
}
__device__ __forceinline__ void dn_intra_phase(const Params& P, char* smem, int bid, int nblk) {
  const int tidx = otid();
  const int tid = tidx, lane = tid & 63, wv = tid >> 6, lr = lane & 15, g = lane >> 4;
  u16* qkv = (u16*)(P.ws + OFF_QKV);
  const float* gg = (const float*)(P.ws + OFF_GB); const float* bt = gg + 16 * 8192; float* cdec = (float*)(P.ws + OFF_GB) + 32 * 8192;
  u16* wdn = (u16*)(P.ws + OFF_WDN); u16* intra = (u16*)(P.ws + OFF_INTRA);
  char* sQ = smem;
  char* sK = smem + 16384;
  char* sV = smem + 32768;
  float* sMT = (float*)(smem + 49152);
  float* sG = (float*)(smem + 66560);
  float* sX = (float*)(smem + 67584);
  for (int u = bid; u < 2048; u += nblk) {
    const int bh = u >> 7, ch = u & 127;
    const long tbase = ((long)bh * 8192 + ch * 64) * 128;
    u16* tq = qkv + tbase; u16* tk = qkv + 16l * 8192 * 128 + tbase; u16* tv = qkv + 32l * 8192 * 128 + tbase;
    __syncthreads();
    for (int i = tid; i < 3072; i += NTHR) {
      const int which = i >> 10, q = i & 1023, row = q >> 4, chk = q & 15;
      const u16* src = (which == 0 ? tq : which == 1 ? tk : tv) + row * 128 + chk * 8;
      *(u32x4*)(smem + which * 16384 + row * 256 + ((chk ^ (row & 15)) << 4)) = *(const u32x4*)src;
    }
    if (tid < 64) {
      float s = 0.f;
      for (int j = 0; j <= tid; ++j) s += gg[(long)bh * 8192 + ch * 64 + j];
      sG[tid] = s; sG[64 + tid] = bt[(long)bh * 8192 + ch * 64 + tid];
    }
    __syncthreads();
    {
      const int mi = wv & 3; const char* sAop = (wv < 4) ? sK : sQ;
      bf16x8 a[4];
#pragma unroll
      for (int ks = 0; ks < 4; ++ks) { const int row = mi * 16 + lr; a[ks] = *(const bf16x8*)(sAop + row * 256 + (((ks * 4 + g) ^ (row & 15)) << 4)); }
#pragma unroll
      for (int ni = 0; ni < 4; ++ni) {
        f32x4 d = (f32x4){0.f, 0.f, 0.f, 0.f};
#pragma unroll
        for (int ks = 0; ks < 4; ++ks) { const int row = ni * 16 + lr; const bf16x8 bb = *(const bf16x8*)(sK + row * 256 + (((ks * 4 + g) ^ (row & 15)) << 4)); d = mfma16(a[ks], bb, d); }
        const int j = ni * 16 + lr; const float gj = sG[j];
#pragma unroll
        for (int r = 0; r < 4; ++r) {
          const int i = mi * 16 + g * 4 + r; const float gi = sG[i];
          if (wv < 4) { sMT[j * 68 + i] = (j < i) ? sG[64 + i] * d[r] * __expf(gi - gj) : 0.f; }
          else { const float v = (j <= i) ? d[r] * __expf(gi - gj) : 0.f; intra[(long)u * 4096 + i * 64 + perm32_pos(j)] = f2bf(v); }
        }
      }
    }
    __syncthreads();
    if (wv < 4) {
      const int c = tid;
      const char* sSrc = (c < 128) ? sV : sK; const int cc = c & 127;
      const int pc = perm32_pos(cc);
#pragma unroll 1
      for (int bi = 0; bi < 4; ++bi) {
        float acc[16];
#pragma unroll
        for (int r = 0; r < 16; ++r) {
          const int i = bi * 16 + r;
          const float raw = bf2f(*(const u16*)(sSrc + i * 256 + (((cc >> 3) ^ (i & 15)) << 4) + (cc & 7) * 2));
          acc[r] = raw * sG[64 + i] * ((c < 128) ? 1.f : __expf(sG[i]));
        }
        for (int j = 0; j < bi * 16; ++j) {
          const float xj = sX[j * 256 + c];
          const float* mrow = sMT + j * 68 + bi * 16;
#pragma unroll
          for (int q4 = 0; q4 < 4; ++q4) {
            const float4 m = *(const float4*)(mrow + q4 * 4);
            acc[q4 * 4 + 0] = fmaf(-m.x, xj, acc[q4 * 4 + 0]); acc[q4 * 4 + 1] = fmaf(-m.y, xj, acc[q4 * 4 + 1]);
            acc[q4 * 4 + 2] = fmaf(-m.z, xj, acc[q4 * 4 + 2]); acc[q4 * 4 + 3] = fmaf(-m.w, xj, acc[q4 * 4 + 3]);
          }
        }
#pragma unroll
        for (int r = 1; r < 16; ++r)
#pragma unroll
          for (int q = 0; q < r; ++q) acc[r] = fmaf(-sMT[(bi * 16 + q) * 68 + bi * 16 + r], acc[q], acc[r]);
#pragma unroll
        for (int r = 0; r < 16; ++r) sX[(bi * 16 + r) * 256 + c] = acc[r];
        if (c < 128) {
#pragma unroll
          for (int h8 = 0; h8 < 2; ++h8) {
            u32x4 o;
#pragma unroll
            for (int e = 0; e < 4; ++e) o[e] = pack2(acc[h8 * 8 + 2 * e], acc[h8 * 8 + 2 * e + 1]);
            *(u32x4*)(tv + c * 64 + bi * 16 + h8 * 8) = o;
          }
        } else {
#pragma unroll
          for (int r = 0; r < 16; ++r) wdn[tbase + (bi * 16 + r) * 128 + pc] = f2bf(acc[r]);
        }
      }
    } else {
      const int t2 = tid - 256;
      const float glast = sG[63];
      for (int i = t2; i < 64 * 128; i += 256) {
        const int row = i >> 7, c = i & 127;
        const float v = bf2f(*(const u16*)(sQ + row * 256 + (((c >> 3) ^ (row & 15)) << 4) + (c & 7) * 2)) * __expf(sG[row]);
        tq[row * 128 + perm32_pos(c)] = f2bf(v);
      }
      for (int i = t2; i < 64 * 128; i += 256) {
        const int dk = i >> 6, row = i & 63;
        const float v = bf2f(*(const u16*)(sK + row * 256 + (((dk >> 3) ^ (row & 15)) << 4) + (dk & 7) * 2)) * __expf(glast - sG[row]);
        tk[dk * 64 + perm32_pos(row)] = f2bf(v);
      }
      if (t2 == 0) cdec[u] = __expf(glast);
    }
  }
}

#define SCAN_BUF 73728
__device__ __forceinline__ void dn_scan_phase(const Params& P, char* smem, int bid, int nblk) {
  const int tidx = otid();
  const int tid = tidx, lane = tid & 63, wv = tid >> 6, lr = lane & 15, g = lane >> 4;
  const u16* qkv = (const u16*)(P.ws + OFF_QKV);
  const u16* wdn = (const u16*)(P.ws + OFF_WDN); const u16* intra = (const u16*)(P.ws + OFF_INTRA);
  const float* cdec = (const float*)(P.ws + OFF_GB) + 32 * 8192;
  u16* mix = (u16*)(P.ws + OFF_MIX);
  for (int bh = bid; bh < 16; bh += nblk) {
    const int b = bh >> 2, hh = bh & 3;
    f32x4 S[8];
#pragma unroll
    for (int i = 0; i < 8; ++i) S[i] = (f32x4){0.f, 0.f, 0.f, 0.f};
    u32x4 st[9];
    unsigned lofs[9];
#pragma unroll
    for (int i = 0; i < 9; ++i) {
      const int q = tid + i * NTHR;
      unsigned o;
      if (q < 1024) o = (unsigned)OFF_WDN + (unsigned)bh * (8192u * 256u) + q * 16;
      else if (q < 4096) o = (unsigned)OFF_QKV + (unsigned)((q >> 10) - 1) * (16u * 8192u * 256u) + (unsigned)bh * (8192u * 256u) + (q & 1023) * 16;
      else o = (unsigned)OFF_INTRA + (unsigned)bh * (128u * 8192u) + (q - 4096) * 16;
      lofs[i] = o;
    }
    const char* wsb = P.ws;
    auto load_chunk = [&](int n) {
#pragma unroll
      for (int i = 0; i < 9; ++i) {
        const unsigned stride = (i < 8) ? 16384u : 8192u;
        st[i] = *(const u32x4*)(wsb + (size_t)(lofs[i] + (unsigned)n * stride));
      }
    };
    auto store_chunk = [&](int bufi) {
      char* base = smem + bufi * SCAN_BUF;
#pragma unroll
      for (int i = 0; i < 9; ++i) {
        const int q = tid + i * NTHR;
        unsigned off;
        if (q < 2048) { const int qq = q & 1023, row = qq >> 4, chk = qq & 15; off = (q >> 10) * 16384 + row * 256 + ((chk ^ (row & 15)) << 4); }
        else if (q < 4096) { const int qq = q & 1023, row = qq >> 3, chk = qq & 7; off = (q >> 10) * 16384 + row * 128 + ((chk ^ (row & 7)) << 4); }
        else { const int qq = q - 4096, row = qq >> 3, chk = qq & 7; off = 65536 + row * 128 + ((chk ^ (row & 7)) << 4); }
        *(u32x4*)(base + off) = st[i];
      }
    };
    __syncthreads();
    load_chunk(0); store_chunk(0); load_chunk(1);
    __syncthreads();
    for (int n = 0; n < 128; ++n) {
      const char* base = smem + (n & 1) * SCAN_BUF;
      const char* sW = base; const char* sQd = base + 16384; const char* sKT = base + 32768; const char* sUT = base + 49152; const char* sA = base + 65536;
      if (n + 1 < 128) { store_chunk((n + 1) & 1); if (n + 2 < 128) load_chunk(n + 2); }
      const float dcy = cdec[bh * 128 + n];
      bf16x8 sb[4];
#pragma unroll
      for (int s = 0; s < 4; ++s)
#pragma unroll
        for (int j = 0; j < 8; ++j) sb[s][j] = (short)f2bf(S[2 * s + (j >> 2)][j & 3]);
      f32x4 vn[4], o[4];
#pragma unroll
      for (int mi = 0; mi < 4; ++mi) {
        f32x4 dw = (f32x4){0.f, 0.f, 0.f, 0.f}, dq = (f32x4){0.f, 0.f, 0.f, 0.f};
        const int row = mi * 16 + lr;
#pragma unroll
        for (int s = 0; s < 4; ++s) {
          const unsigned off = row * 256 + (((s * 4 + g) ^ (row & 15)) << 4);
          dw = mfma16(*(const bf16x8*)(sW + off), sb[s], dw);
          dq = mfma16(*(const bf16x8*)(sQd + off), sb[s], dq);
        }
        const int urow = wv * 16 + lr;
        const int ucol = mi * 16 + g * 4;
        const u32x2 uv = *(const u32x2*)(sUT + urow * 128 + ((((ucol >> 3)) ^ (urow & 7)) << 4) + (ucol & 7) * 2);
        vn[mi][0] = lo2f(uv[0]) - dw[0]; vn[mi][1] = hi2f(uv[0]) - dw[1]; vn[mi][2] = lo2f(uv[1]) - dw[2]; vn[mi][3] = hi2f(uv[1]) - dw[3];
        o[mi] = dq;
      }
      bf16x8 vb[2];
#pragma unroll
      for (int s = 0; s < 2; ++s)
#pragma unroll
        for (int j = 0; j < 8; ++j) vb[s][j] = (short)f2bf(vn[2 * s + (j >> 2)][j & 3]);
#pragma unroll
      for (int mi = 0; mi < 4; ++mi) {
        const int row = mi * 16 + lr;
#pragma unroll
        for (int s = 0; s < 2; ++s) o[mi] = mfma16(*(const bf16x8*)(sA + row * 128 + (((s * 4 + g) ^ (row & 7)) << 4)), vb[s], o[mi]);
      }
#pragma unroll
      for (int m2 = 0; m2 < 8; ++m2) {
        f32x4 d = S[m2];
#pragma unroll
        for (int r = 0; r < 4; ++r) d[r] *= dcy;
        const int row = m2 * 16 + lr;
#pragma unroll
        for (int s = 0; s < 2; ++s) d = mfma16(*(const bf16x8*)(sKT + row * 128 + (((s * 4 + g) ^ (row & 7)) << 4)), vb[s], d);
        S[m2] = d;
      }
#pragma unroll
      for (int mi = 0; mi < 4; ++mi)
#pragma unroll
        for (int r = 0; r < 4; ++r) {
          const long t = (long)b * 8192 + n * 64 + mi * 16 + g * 4 + r;
          mix[t * 1024 + 512 + hh * 128 + wv * 16 + lr] = f2bf(o[mi][r]);
        }
      __syncthreads();
    }
  }
}

__device__ __forceinline__ void dn_gate_phase(const Params& P, int bid, int nblk) {
  const int tidx = otid();
  const int lane = tidx & 63, wv = tidx >> 6, hh = lane >> 4, cg = lane & 15;
  u16* mix = (u16*)(P.ws + OFF_MIX); const u16* bz = (const u16*)(P.ws + OFF_BZ);
  for (int t = bid * 8 + wv; t < T_TOK; t += nblk * 8) {
    u16* p = mix + (long)t * 1024 + 512 + hh * 128 + cg * 8;
    const u32x4 ov = *(const u32x4*)p; const u32x4 zv = *(const u32x4*)(bz + (long)t * 512 + hh * 128 + cg * 8);
    float o[8], z[8];
#pragma unroll
    for (int e = 0; e < 4; ++e) { o[2 * e] = lo2f(ov[e]); o[2 * e + 1] = hi2f(ov[e]); z[2 * e] = lo2f(zv[e]); z[2 * e + 1] = hi2f(zv[e]); }
    float ss = 0.f;
#pragma unroll
    for (int e = 0; e < 8; ++e) ss += o[e] * o[e];
    ss += __shfl_xor(ss, 1); ss += __shfl_xor(ss, 2); ss += __shfl_xor(ss, 4); ss += __shfl_xor(ss, 8);
    const float rs = rsqrtf(ss * (1.f / 128) + EPSV);
    u32x4 r;
#pragma unroll
    for (int e = 0; e < 4; ++e) {
      const float a = o[2 * e] * rs * P.g_onorm[cg * 8 + 2 * e] * (z[2 * e] / (1.f + __expf(-z[2 * e])));
      const float bq = o[2 * e + 1] * rs * P.g_onorm[cg * 8 + 2 * e + 1] * (z[2 * e + 1] / (1.f + __expf(-z[2 * e + 1])));
      r[e] = pack2(a, bq);
    }
    *(u32x4*)p = r;
  }
}

__device__ __forceinline__ void xattn_phase(const Params& P, int bid, int nblk) {
  const int tidx = otid();
  const int tid = tidx, lane = tid & 63, wv = tid >> 6, lr = lane & 15, g = lane >> 4;
  const u16* qx = (const u16*)(P.ws + OFF_QX); const u16* kx = (const u16*)(P.ws + OFF_KX); const u16* vtx = (const u16*)(P.ws + OFF_VTX);
  u16* ox = (u16*)(P.ws + OFF_OX);
  for (int u = bid * 8 + wv; u < 2048 * 4; u += nblk * 8) {
    const int qt = u >> 2, hh = u & 3, t0 = qt * 16, b = t0 >> 13;
    bf16x8 bq[4];
#pragma unroll
    for (int ks = 0; ks < 4; ++ks) bq[ks] = *(const bf16x8*)(qx + (long)(t0 + lr) * 512 + hh * 128 + ks * 32 + g * 8);
    f32x4 S[16];
    float mx = -3.0e38f;
#pragma unroll
    for (int m = 0; m < 16; ++m) {
      f32x4 d = (f32x4){0.f, 0.f, 0.f, 0.f};
#pragma unroll
      for (int ks = 0; ks < 4; ++ks) { const bf16x8 a = *(const bf16x8*)(kx + (long)(b * 256 + m * 16 + lr) * 512 + hh * 128 + ks * 32 + g * 8); d = mfma16(a, bq[ks], d); }
      S[m] = d;
#pragma unroll
      for (int r = 0; r < 4; ++r) mx = fmaxf(mx, d[r]);
    }
    mx = fmaxf(mx, __shfl_xor(mx, 16)); mx = fmaxf(mx, __shfl_xor(mx, 32));
    float sum = 0.f;
#pragma unroll
    for (int m = 0; m < 16; ++m)
#pragma unroll
      for (int r = 0; r < 4; ++r) { S[m][r] = __expf(S[m][r] - mx); sum += S[m][r]; }
    sum += __shfl_xor(sum, 16); sum += __shfl_xor(sum, 32);
    const float inv = 1.f / sum;
    bf16x8 pb[8];
#pragma unroll
    for (int s = 0; s < 8; ++s)
#pragma unroll
      for (int j = 0; j < 8; ++j) pb[s][j] = (short)f2bf(S[2 * s + (j >> 2)][j & 3]);
#pragma unroll
    for (int dt = 0; dt < 8; ++dt) {
      f32x4 o = (f32x4){0.f, 0.f, 0.f, 0.f};
      const u16* vrow = vtx + ((long)b * 512 + hh * 128 + dt * 16 + lr) * 256;
#pragma unroll
      for (int s = 0; s < 8; ++s) {
        const u32x2 v0 = *(const u32x2*)(vrow + s * 32 + g * 4);
        const u32x2 v1 = *(const u32x2*)(vrow + s * 32 + 16 + g * 4);
        bf16x8 a; u32x4 tmp; tmp[0] = v0[0]; tmp[1] = v0[1]; tmp[2] = v1[0]; tmp[3] = v1[1]; a = __builtin_bit_cast(bf16x8, tmp);
        o = mfma16(a, pb[s], o);
      }
      u32x2 w; w[0] = pack2(o[0] * inv, o[1] * inv); w[1] = pack2(o[2] * inv, o[3] * inv);
      *(u32x2*)(ox + (long)(t0 + lr) * 512 + hh * 128 + dt * 16 + g * 4) = w;
    }
  }
}

__device__ __forceinline__ void g6_phase(const Params& P, char* smem, int bid, int nblk) {
  const int tidx = otid();
  const u16* A = (const u16*)(P.ws + OFF_H); const u16* Bt = (const u16*)(P.ws + OFF_WEFFT);
  unsigned* plist = (unsigned*)(P.ws + OFF_PLIST);
  const int tid = tidx;
  for (int t = bid; t < 128 * 16; t += nblk) {
    const int mp = t >> 4, np = t & 15;
    gemm_tile<133>(A + (long)mp * 256 * DM, DM, Bt + (long)np * 128 * DM, DM, DM, smem);
    const float* sC = (const float*)smem;
    const int row = tid >> 1, half = tid & 1;
    unsigned tk[16];
#pragma unroll
    for (int i = 0; i < 16; ++i) tk[i] = 0u;
    for (int i = 0; i < 64; ++i) {
      const int c = half * 64 + ((i + half * 16) & 63);
      const unsigned key = (fkey(sC[row * 133 + c]) & ~127u) | (unsigned)(127 - c);
#pragma unroll
      for (int s = 15; s >= 1; --s) tk[s] = umed3(tk[s - 1], tk[s], key);
      tk[0] = tk[0] > key ? tk[0] : key;
    }
#pragma unroll
    for (int i = 0; i < 16; ++i) {
      const unsigned key = __shfl_xor(tk[i], 1);
      if (half == 0) {
#pragma unroll
        for (int s = 15; s >= 1; --s) tk[s] = umed3(tk[s - 1], tk[s], key);
        tk[0] = tk[0] > key ? tk[0] : key;
      }
    }
    if (half == 0) {
      unsigned* dst = plist + ((long)(mp * 256 + row) * 16 + np) * 16;
#pragma unroll
      for (int i = 0; i < 4; ++i) { u32x4 o; o[0] = tk[4 * i]; o[1] = tk[4 * i + 1]; o[2] = tk[4 * i + 2]; o[3] = tk[4 * i + 3]; *(u32x4*)(dst + 4 * i) = o; }
    }
  }
}

__device__ __forceinline__ void peer_phase(const Params& P, char* smem, int bid, int nblk) {
  const int tidx = otid();
  const int tid = tidx, lane = tid & 63, wv = tid >> 6;
  const unsigned* plist = (const unsigned*)(P.ws + OFF_PLIST);
  const u16* h3 = (const u16*)(P.ws + OFF_H);
  const u16* ue = (const u16*)(P.ws + OFF_UEMB); const u16* ve = (const u16*)(P.ws + OFF_VEMB);
  unsigned* skeys = (unsigned*)smem + wv * 256;
  unsigned* sidx = (unsigned*)(smem + 8192) + wv * 128;
  float* sgate = (float*)(smem + 12288) + wv * 128;
  for (int t = bid * 8 + wv; t < T_TOK; t += nblk * 8) {
    __builtin_amdgcn_wave_barrier();
    *(u32x4*)(skeys + lane * 4) = *(const u32x4*)(plist + (long)t * 256 + lane * 4);
    __builtin_amdgcn_wave_barrier();
    if (lane < 8) {
      const unsigned* k1 = skeys + lane * 32; const unsigned* k2 = k1 + 16;
      float s1[16], s2[16];
#pragma unroll
      for (int i = 0; i < 16; ++i) { s1[i] = keyf(k1[i] & ~127u); s2[i] = keyf(k2[i] & ~127u); }
      unsigned tk[16];
#pragma unroll
      for (int i = 0; i < 16; ++i) tk[i] = 0u;
#pragma unroll
      for (int i = 0; i < 16; ++i)
#pragma unroll
        for (int j = 0; j < 16; ++j)
          if ((i + 1) * (j + 1) <= 16) {
            const unsigned key = (fkey(s1[i] + s2[j]) & ~255u) | (unsigned)(255 - (i * 16 + j));
#pragma unroll
            for (int s = 15; s >= 1; --s) tk[s] = umed3(tk[s - 1], tk[s], key);
            tk[0] = tk[0] > key ? tk[0] : key;
          }
      float best[16]; float mx = -3.0e38f;
#pragma unroll
      for (int k = 0; k < 16; ++k) {
        const int cid = 255 - (int)(tk[k] & 255u); const int i = cid >> 4, j = cid & 15;
        const unsigned ka = k1[i], kb2 = k2[j];
        best[k] = keyf(ka & ~127u) + keyf(kb2 & ~127u);
        sidx[lane * 16 + k] = (unsigned)((127 - (int)(ka & 127u)) * 128 + (127 - (int)(kb2 & 127u)));
        mx = fmaxf(mx, best[k]);
      }
      float sm = 0.f;
#pragma unroll
      for (int k = 0; k < 16; ++k) { best[k] = __expf(best[k] - mx); sm += best[k]; }
      const float inv = 1.f / sm;
#pragma unroll
      for (int k = 0; k < 16; ++k) sgate[lane * 16 + k] = best[k] * inv;
    }
    __builtin_amdgcn_wave_barrier();
    float xa[16];
    {
      const u32x4 v0 = *(const u32x4*)(h3 + (long)t * DM + lane * 8), v1 = *(const u32x4*)(h3 + (long)t * DM + 512 + lane * 8);
#pragma unroll
      for (int e = 0; e < 4; ++e) { xa[2 * e] = lo2f(v0[e]); xa[2 * e + 1] = hi2f(v0[e]); xa[8 + 2 * e] = lo2f(v1[e]); xa[8 + 2 * e + 1] = hi2f(v1[e]); }
    }
    float acc[16];
#pragma unroll
    for (int e = 0; e < 16; ++e) acc[e] = 0.f;
    for (int bt = 0; bt < 16; ++bt) {
      u32x4 uu[8][2], vv[8][2];
#pragma unroll
      for (int k = 0; k < 8; ++k) {
        const long e = (long)sidx[bt * 8 + k];
        uu[k][0] = *(const u32x4*)(ue + e * DM + lane * 8); uu[k][1] = *(const u32x4*)(ue + e * DM + 512 + lane * 8);
        vv[k][0] = *(const u32x4*)(ve + e * DM + lane * 8); vv[k][1] = *(const u32x4*)(ve + e * DM + 512 + lane * 8);
      }
      float pd[8];
#pragma unroll
      for (int k = 0; k < 8; ++k) {
        float s = 0.f;
#pragma unroll
        for (int e = 0; e < 4; ++e) {
          s = fmaf(lo2f(uu[k][0][e]), xa[2 * e], s); s = fmaf(hi2f(uu[k][0][e]), xa[2 * e + 1], s);
          s = fmaf(lo2f(uu[k][1][e]), xa[8 + 2 * e], s); s = fmaf(hi2f(uu[k][1][e]), xa[8 + 2 * e + 1], s);
        }
        pd[k] = s;
      }
      float r4[4], r2[2], r1;
      {
        const bool up = (lane & 32) != 0;
#pragma unroll
        for (int k = 0; k < 4; ++k) { const float mine = up ? pd[k + 4] : pd[k]; const float oth = up ? pd[k] : pd[k + 4]; r4[k] = mine + __shfl_xor(oth, 32); }
        const bool up2 = (lane & 16) != 0;
#pragma unroll
        for (int k = 0; k < 2; ++k) { const float mine = up2 ? r4[k + 2] : r4[k]; const float oth = up2 ? r4[k] : r4[k + 2]; r2[k] = mine + __shfl_xor(oth, 16); }
        const bool up3 = (lane & 8) != 0;
        { const float mine = up3 ? r2[1] : r2[0]; const float oth = up3 ? r2[0] : r2[1]; r1 = mine + __shfl_xor(oth, 8); }
        r1 += __shfl_xor(r1, 4); r1 += __shfl_xor(r1, 2); r1 += __shfl_xor(r1, 1);
      }
      const int myk = ((lane >> 5) & 1) * 4 + ((lane >> 4) & 1) * 2 + ((lane >> 3) & 1);
      const float act = 0.5f * r1 * (1.f + erff(r1 * 0.7071067811865475f));
      const float coef = sgate[bt * 8 + myk] * act;
#pragma unroll
      for (int k = 0; k < 8; ++k) {
        const int srcl = ((k >> 2) & 1) * 32 + ((k >> 1) & 1) * 16 + (k & 1) * 8;
        const float ck = __shfl(coef, srcl);
#pragma unroll
        for (int e = 0; e < 4; ++e) {
          acc[2 * e] = fmaf(ck, lo2f(vv[k][0][e]), acc[2 * e]); acc[2 * e + 1] = fmaf(ck, hi2f(vv[k][0][e]), acc[2 * e + 1]);
          acc[8 + 2 * e] = fmaf(ck, lo2f(vv[k][1][e]), acc[8 + 2 * e]); acc[8 + 2 * e + 1] = fmaf(ck, hi2f(vv[k][1][e]), acc[8 + 2 * e + 1]);
        }
      }
    }
    float* orow = P.out + (long)t * DM;
    float xr[16]; float ss = 0.f;
#pragma unroll
    for (int hf = 0; hf < 2; ++hf)
#pragma unroll
      for (int q = 0; q < 2; ++q) {
        const float4 v = *(const float4*)(orow + hf * 512 + lane * 8 + q * 4);
        xr[hf * 8 + q * 4 + 0] = v.x + acc[hf * 8 + q * 4 + 0]; xr[hf * 8 + q * 4 + 1] = v.y + acc[hf * 8 + q * 4 + 1];
        xr[hf * 8 + q * 4 + 2] = v.z + acc[hf * 8 + q * 4 + 2]; xr[hf * 8 + q * 4 + 3] = v.w + acc[hf * 8 + q * 4 + 3];
      }
#pragma unroll
    for (int e = 0; e < 16; ++e) ss += xr[e] * xr[e];
    ss = wave_sum(ss);
    const float rs = rsqrtf(ss * (1.f / DM) + EPSV);
#pragma unroll
    for (int hf = 0; hf < 2; ++hf)
#pragma unroll
      for (int q = 0; q < 2; ++q) {
        const float4 gf = *(const float4*)(P.g_final + hf * 512 + lane * 8 + q * 4);
        float4 o; o.x = xr[hf * 8 + q * 4 + 0] * rs * gf.x; o.y = xr[hf * 8 + q * 4 + 1] * rs * gf.y; o.z = xr[hf * 8 + q * 4 + 2] * rs * gf.z; o.w = xr[hf * 8 + q * 4 + 3] * rs * gf.w;
        *(float4*)(orow + hf * 512 + lane * 8 + q * 4) = o;
      }
  }
}

#define XB_TMO      128
#define XB_XCNT(j)  (256  + 64 * (j))
#define XB_XSUB(j)  (1280 + 64 * (j))
#define XB_XGEN(j)  (2304 + 64 * (j))
#define XB_TOP      3328
#define XB_TOPGEN   3392
#define XCD_BAR_WORDS 3456
#define XB_SPIN_CAP (1u << 18)

__device__ __forceinline__ unsigned xb_ld(unsigned* p)              { return __hip_atomic_load(p, __ATOMIC_RELAXED, __HIP_MEMORY_SCOPE_AGENT); }
__device__ __forceinline__ unsigned xb_add(unsigned* p, unsigned v) { return __hip_atomic_fetch_add(p, v, __ATOMIC_RELAXED, __HIP_MEMORY_SCOPE_AGENT); }
__device__ __forceinline__ unsigned xb_xcc_id() { return (unsigned)__builtin_amdgcn_s_getreg((3 << 11) | 20) & 0xFu; }
#define XB_SPIN(cond, bar) do { unsigned _sp = 0; while (cond) { __builtin_amdgcn_s_sleep(1); \
    if ((++_sp & 255u) == 0u) { if (xb_ld(&(bar)[XB_TMO])) break; if (_sp > XB_SPIN_CAP) { atomicAdd(&(bar)[XB_TMO], 1u); break; } } } } while (0)

struct XcdBarrier {
    unsigned* bar; unsigned x;
    volatile LAS unsigned* st;
};

__device__ __forceinline__ XcdBarrier xcd_barrier_post(unsigned* bar, volatile LAS unsigned* st) {
    XcdBarrier b; b.bar = bar; b.x = xb_xcc_id(); b.st = st;
    if (threadIdx.x == 0) (void)xb_add(&bar[XB_XCNT(b.x)], 1u);
    return b;
}
__device__ __forceinline__ void xcd_barrier_complete(unsigned* bar, unsigned x, unsigned& nloc, unsigned& nx) {
    const unsigned G = gridDim.x * gridDim.y * gridDim.z;
    unsigned sum, cnt, mine, sp = 0u;
    for (;;) {
        sum = 0u; cnt = 0u; mine = 0u;
#pragma unroll
        for (unsigned j = 0; j < 16; ++j) { const unsigned c = xb_ld(&bar[XB_XCNT(j)]); sum += c; cnt += (c > 0u) ? 1u : 0u; mine = (j == x) ? c : mine; }
        if (sum == G) break;
        __builtin_amdgcn_s_sleep(1);
        if ((++sp & 255u) == 0u) { if (xb_ld(&bar[XB_TMO])) break; if (sp > XB_SPIN_CAP) { atomicAdd(&bar[XB_TMO], 1u); break; } }
    }
    nloc = mine > 0u ? mine : 1u; nx = cnt > 0u ? cnt : 1u;
}

__device__ __forceinline__ void xcd_barrier(const XcdBarrier& b) {
    asm volatile("s_waitcnt vmcnt(0)" ::: "memory");
    __syncthreads();
    if (threadIdx.x == 0) {
        unsigned* bar = b.bar;
        __builtin_amdgcn_s_waitcnt(0);
        unsigned nloc = b.st[0], nx = b.st[1];
        if (nloc == 0u) { xcd_barrier_complete(bar, b.x, nloc, nx); b.st[0] = nloc; b.st[1] = nx; }
        const unsigned old = xb_add(&bar[XB_XSUB(b.x)], 1u);
        const unsigned gen = old / nloc;
        if (old + 1u == (gen + 1u) * nloc) {
            __builtin_amdgcn_fence(__ATOMIC_RELEASE, "agent");
            asm volatile("s_waitcnt vmcnt(0)" ::: "memory");
            const unsigned og = xb_add(&bar[XB_TOP], 1u);
            const unsigned tg = og / nx;
            if (og + 1u == (tg + 1u) * nx) xb_add(&bar[XB_TOPGEN], 1u);
            else XB_SPIN(xb_ld(&bar[XB_TOPGEN]) == tg, bar);
            __builtin_amdgcn_fence(__ATOMIC_ACQUIRE, "agent");
            xb_add(&bar[XB_XGEN(b.x)], 1u);
            asm volatile("s_waitcnt vmcnt(0)" ::: "memory");
        } else {
            XB_SPIN(xb_ld(&bar[XB_XGEN(b.x)]) == gen, bar);
            __builtin_amdgcn_fence(__ATOMIC_ACQUIRE, "agent");
            asm volatile("s_waitcnt vmcnt(0)" ::: "memory");
        }
    }
    __syncthreads();
}

__device__ __forceinline__ GemmP mk_gemm(const u16* A, long lda, long a_bs, const u16* Bt, long ldb, long b_bs, u16* C, long ldc, long c_bs, int M, int N, int K, int nbatch, float scale, int ncols, int tstore) {
  GemmP g; g.A = A; g.lda = lda; g.a_bs = a_bs; g.Bt = Bt; g.ldb = ldb; g.b_bs = b_bs; g.C = C; g.ldc = ldc; g.c_bs = c_bs; g.M = M; g.N = N; g.K = K; g.nbatch = nbatch; g.scale = scale; g.ncols = ncols; g.tstore = tstore;
  return g;
}
#define QCTR_WORD (XCD_BAR_WORDS + 64)

__global__ void __launch_bounds__(NTHR, 2) mega(Params P, CvtJobs J1, CvtJobs J2) {
  extern __shared__ __attribute__((aligned(16))) char smem[];
  const int bid = blockIdx.x, nblk = gridDim.x, rbid = nblk - 1 - bid;
  char* ws = P.ws;
  unsigned* barw = (unsigned*)(ws + OFF_BAR);
  if (threadIdx.x == 0) *(uint4*)(smem + LDS_XB) = make_uint4(0u, 0u, 0u, 0u);
  __syncthreads();
  XcdBarrier bar = xcd_barrier_post(barw, (volatile LAS unsigned*)(smem + LDS_XB));

  cvt_run(J1, smem, bid, nblk);
  rmsnorm_rows(P.x, P.g_mix, (u16*)(ws + OFF_H), T_TOK, bid, nblk);
  rmsnorm_rows(P.mem, P.g_mem, (u16*)(ws + OFF_MEMN), 1024, rbid, nblk);
  xcd_barrier(bar);

  {
    const GemmP g = mk_gemm((u16*)(ws + OFF_WUK), 512, 64, (u16*)(ws + OFF_WUQ), 512, 64, (u16*)(ws + OFF_WG2T) + 512l * 256, 256, 256l * 256, 256, 256, 64, 8, 0.125f, 128, 0);
    gemm_bf16_phase(g, smem, rbid, nblk);
  }
  {
    const GemmP g = mk_gemm((u16*)(ws + OFF_WPQ), 2048, 128, (u16*)(ws + OFF_SUBK), 128, 128l * 128, (u16*)(ws + OFF_WEFFT), 1024, 128l * 1024, 1024, 128, 128, 16, 1.f, 128, 1);
    gemm_bf16_phase(g, smem, rbid - 16 < 0 ? rbid - 16 + nblk : rbid - 16, nblk);
  }
  {
    const GemmP g = mk_gemm((u16*)(ws + OFF_MEMN), 1024, 0, (u16*)(ws + OFF_WKT), 1024, 0, (u16*)(ws + OFF_KX), 512, 0, 1024, 512, 1024, 1, 1.f, 128, 0);
    gemm_bf16_phase(g, smem, rbid - 80 < 0 ? rbid - 80 + nblk : rbid - 80, nblk);
  }
  {
    const GemmP g = mk_gemm((u16*)(ws + OFF_WVT), 1024, 0, (u16*)(ws + OFF_MEMN), 1024, 256l * 1024, (u16*)(ws + OFF_VTX), 256, 512l * 256, 512, 256, 1024, 4, 1.f, 128, 0);
    gemm_bf16_phase(g, smem, rbid - 96 < 0 ? rbid - 96 + nblk : rbid - 96, nblk);
  }
  g1_phase(P, smem, bid, nblk);
  xcd_barrier(bar);

  dsa_prep_phase(P, bid, nblk);
  dn_prep_phase(P, bid, nblk);
  xcd_barrier(bar);

  dn_intra_phase(P, smem, bid, nblk);
  g2_phase(P, smem, bid, nblk);
  xcd_barrier(bar);

  if (bid < 16) dn_scan_phase(P, smem, bid, 16);
  dsa_queue_phase(P, smem, bid, barw + QCTR_WORD);
  xcd_barrier(bar);

  dn_gate_phase(P, bid, nblk);
  {
    const GemmP g = mk_gemm((u16*)P.out, 2048, 256, (u16*)(ws + OFF_WUVT), 256, 128l * 256, (u16*)(ws + OFF_MIX), 1024, 64, T_TOK, 128, 256, 8, 1.f, 64, 0);
    gemm_bf16_phase(g, smem, bid, nblk);
  }
  cvt_run(J2, smem, bid, nblk);
  xcd_barrier(bar);

  {
    GemmR g; g.A = (u16*)(ws + OFF_MIX); g.lda = 1024; g.Bt = (u16*)(ws + OFF_WOUTT); g.ldb = 1024; g.R = P.x; g.C = P.out; g.K = 1024;
    gemm_resid_phase(g, smem, bid, nblk);
  }
  xcd_barrier(bar);
  rmsnorm_rows(P.out, P.g_cross, (u16*)(ws + OFF_H), T_TOK, bid, nblk);
  xcd_barrier(bar);
  {
    const GemmP g = mk_gemm((u16*)(ws + OFF_H), 1024, 0, (u16*)(ws + OFF_WQT), 1024, 0, (u16*)(ws + OFF_QX), 512, 0, T_TOK, 512, 1024, 1, 1.f, 128, 0);
    gemm_bf16_phase(g, smem, bid, nblk);
  }
  xcd_barrier(bar);
  xattn_phase(P, bid, nblk);
  xcd_barrier(bar);
  {
    GemmR g; g.A = (u16*)(ws + OFF_OX); g.lda = 512; g.Bt = (u16*)(ws + OFF_WOT); g.ldb = 512; g.R = P.out; g.C = P.out; g.K = 512;
    gemm_resid_phase(g, smem, bid, nblk);
  }
  xcd_barrier(bar);
  rmsnorm_rows(P.out, P.g_ffn, (u16*)(ws + OFF_H), T_TOK, bid, nblk);
  xcd_barrier(bar);
  g6_phase(P, smem, bid, nblk);
  xcd_barrier(bar);
  peer_phase(P, smem, bid, nblk);
}

static void add_job(CvtJobs& J, const float* src, u16* dst, int R, int C, long sld, long dld, float scale, int tr) {
  CvtJob& j = J.j[J.n++]; j.src = src; j.dst = dst; j.R = R; j.C = C; j.sld = sld; j.dld = dld; j.scale = scale; j.transpose = tr;
}

extern "C" void kernel_launch(void* const* d_in, const int* in_sizes, int n_in, void* d_out, int out_size, void* d_ws, size_t ws_size, hipStream_t stream) {
  if (ws_size < WS_NEED) { fprintf(stderr, "workspace too small: %zu < %llu\n", ws_size, (unsigned long long)WS_NEED); return; }
  Params P; memset(&P, 0, sizeof(P));
  const float** pp = (const float**)&P;
  for (int i = 0; i < 29; ++i) pp[i] = (const float*)d_in[i];
  P.out = (float*)d_out; P.ws = (char*)d_ws;
  char* ws = (char*)d_ws;
  static int grid = 0;
  if (!grid) {
    int dev = 0, cus = 0, per_cu = 0;
    (void)hipGetDevice(&dev);
    (void)hipDeviceGetAttribute(&cus, hipDeviceAttributeMultiprocessorCount, dev);
    (void)hipFuncSetAttribute((const void*)mega, hipFuncAttributeMaxDynamicSharedMemorySize, LDS_TOTAL);
    (void)hipOccupancyMaxActiveBlocksPerMultiprocessor(&per_cu, (const void*)mega, NTHR, LDS_TOTAL);
    grid = cus * (per_cu < 1 ? per_cu : 1);
    if (grid <= 0) { fprintf(stderr, "mega kernel not launchable (cus %d, per_cu %d)\n", cus, per_cu); grid = 0; return; }
  }
  (void)hipMemsetAsync(ws + OFF_BAR, 0, 16384, stream);
  (void)hipMemsetAsync(ws + OFF_WINT, 0, 2688ull * 1024 * 2, stream);
  (void)hipMemsetAsync(ws + OFF_WUVT, 0, 8ull * 128 * 256 * 2, stream);
  CvtJobs J1; memset(&J1, 0, sizeof(J1));
  CvtJobs J2; memset(&J2, 0, sizeof(J2));
  {
    u16* winT = (u16*)(ws + OFF_WINT);
    add_job(J1, P.w_in, winT, 1024, 584, 2640, 1024, 1.f, 1);
    add_job(J1, P.w_in + 2632, winT + 584l * 1024, 1024, 8, 2640, 1024, 1.f, 1);
    add_job(J1, P.w_in + 584, winT + 640l * 1024, 1024, 1536, 2640, 1024, 1.f, 1);
    add_job(J1, P.w_in + 2120, winT + 2176l * 1024, 1024, 512, 2640, 1024, 1.f, 1);
    add_job(J1, P.w_iq, (u16*)(ws + OFF_WG2T), 256, 512, 512, 256, 1.f, 1);
    add_job(J1, P.w_uq, (u16*)(ws + OFF_WUQ), 256, 512, 512, 512, 1.f, 0);
    add_job(J1, P.w_uk, (u16*)(ws + OFF_WUK), 256, 512, 512, 512, 1.f, 0);
    for (int h = 0; h < 8; ++h) add_job(J1, P.w_uv + h * 64, (u16*)(ws + OFF_WUVT) + h * 128l * 256, 256, 64, 512, 256, 1.f, 1);
    add_job(J1, P.w_out, (u16*)(ws + OFF_WOUTT), 1024, 1024, 1024, 1024, 1.f, 1);
    add_job(J1, P.wq_x, (u16*)(ws + OFF_WQT), 1024, 512, 512, 1024, 0.08838834764831845f, 1);
    add_job(J1, P.wk_x, (u16*)(ws + OFF_WKT), 1024, 512, 512, 1024, 1.f, 1);
    add_job(J1, P.wv_x, (u16*)(ws + OFF_WVT), 1024, 512, 512, 1024, 1.f, 1);
    add_job(J1, P.wo_x, (u16*)(ws + OFF_WOT), 512, 1024, 1024, 512, 1.f, 1);
    add_job(J1, P.w_pq, (u16*)(ws + OFF_WPQ), 1024, 2048, 2048, 2048, 1.f, 0);
    add_job(J1, P.sub_keys, (u16*)(ws + OFF_SUBK), 2048, 128, 128, 128, 1.f, 0);
    add_job(J2, P.u_emb, (u16*)(ws + OFF_UEMB), 16384, 1024, 1024, 1024, 1.f, 0);
    add_job(J2, P.v_emb, (u16*)(ws + OFF_VEMB), 16384, 1024, 1024, 1024, 1.f, 0);
  }
  hipLaunchKernelGGL(mega, dim3(grid), dim3(NTHR), LDS_TOTAL, stream, P, J1, J2);
}
```

```cpp
#include <hip/hip_runtime.h>
#include <stdint.h>
#include <stdio.h>
#include <string.h>

typedef unsigned short u16;
typedef __attribute__((ext_vector_type(8))) short bf16x8;
typedef __attribute__((ext_vector_type(4))) short s16x4;
typedef __attribute__((ext_vector_type(4))) float f32x4;
typedef __attribute__((ext_vector_type(4))) unsigned u32x4;
typedef __attribute__((ext_vector_type(2))) unsigned u32x2;
typedef __attribute__((ext_vector_type(2))) float f32x2;
#define LAS __attribute__((address_space(3)))

#define T_TOK 32768
#define SEQ 8192
#define NB 4
#define DM 1024
#define NTHR 512
#define EPSV 1e-6f

__device__ __forceinline__ u16 f2bf(float f) { __bf16 b = (__bf16)f; return __builtin_bit_cast(u16, b); }
__device__ __forceinline__ float bf2f(u16 h) { return __uint_as_float(((unsigned)h) << 16); }
__device__ __forceinline__ unsigned pack2(float a, float b) { return (unsigned)f2bf(a) | ((unsigned)f2bf(b) << 16); }
__device__ __forceinline__ float lo2f(unsigned v) { return __uint_as_float(v << 16); }
__device__ __forceinline__ float hi2f(unsigned v) { return __uint_as_float(v & 0xffff0000u); }
__device__ __forceinline__ int otid() { int t = threadIdx.x; asm volatile("" : "+v"(t)); return t; }
__device__ __forceinline__ float wave_sum(float v) {
#pragma unroll
  for (int o = 32; o >= 1; o >>= 1) v += __shfl_xor(v, o);
  return v;
}
template <int CTRL> __device__ __forceinline__ float dpp_f(float v) { return __int_as_float(__builtin_amdgcn_update_dpp(0, __float_as_int(v), CTRL, 0xf, 0xf, true)); }
__device__ __forceinline__ float wave_max_u(float v) {
#pragma unroll
  for (int o = 32; o >= 1; o >>= 1) v = fmaxf(v, __shfl_xor(v, o));
  return v;
}
__device__ __forceinline__ float wave_min_u(float v) { return -wave_max_u(-v); }
__device__ __forceinline__ f32x4 mfma16(bf16x8 a, bf16x8 b, f32x4 c) { return __builtin_amdgcn_mfma_f32_16x16x32_bf16(a, b, c, 0, 0, 0); }
__device__ __forceinline__ unsigned umed3(unsigned a, unsigned b, unsigned c) { unsigned r; asm("v_med3_u32 %0, %1, %2, %3" : "=v"(r) : "v"(a), "v"(b), "v"(c)); return r; }
__device__ __forceinline__ unsigned fkey(float f) { unsigned u = __float_as_uint(f); return u ^ ((u >> 31) ? 0xffffffffu : 0x80000000u); }
__device__ __forceinline__ float keyf(unsigned m) { unsigned u = (m & 0x80000000u) ? (m ^ 0x80000000u) : ~m; return __uint_as_float(u); }

#define MB (1024ull * 1024ull)
#define OFF_BAR      0ull
#define OFF_WINT     (1 * MB)
#define OFF_WG2T     (7 * MB)
#define OFF_WUQ      (9 * MB)
#define OFF_WUK      (9 * MB + 512 * 1024)
#define OFF_WUVT     (10 * MB)
#define OFF_WOUTT    (11 * MB)
#define OFF_WQT      (13 * MB)
#define OFF_WKT      (14 * MB)
#define OFF_WVT      (15 * MB)
#define OFF_WOT      (16 * MB)
#define OFF_WPQ      (17 * MB)
#define OFF_SUBK     (21 * MB)
#define OFF_WEFFT    (22 * MB)
#define OFF_MEMN     (26 * MB)
#define OFF_KX       (28 * MB)
#define OFF_VTX      (29 * MB)
#define OFF_KIDXN    (30 * MB)
#define OFF_WIDX     (34 * MB)
#define OFF_GB       (35 * MB)
#define OFF_INTRA    (37 * MB)
#define OFF_WDN      (53 * MB)
#define OFF_SEL      (85 * MB)
#define OFF_H        (101 * MB)
#define OFF_QI       (OFF_H)
#define OFF_CQN      (OFF_H + 32 * MB)
#define OFF_CKVN     (OFF_H + 48 * MB)
#define OFF_PA       (165 * MB)
#define OFF_PB       (205 * MB)
#define OFF_SCORES   (OFF_PA)
#define OFF_UEMB     (OFF_PA)
#define OFF_VEMB     (OFF_PA + 16 * MB)
#define OFF_USCL     (OFF_PA + 32 * MB)
#define OFF_VSCL     (OFF_PA + 33 * MB)
#define OFF_BZ       (301 * MB)
#define OFF_QKV      (333 * MB)
#define OFF_QX       (OFF_QKV)
#define OFF_OX       (OFF_QKV + 32 * MB)
#define OFF_PLIST    (OFF_QKV + 64 * MB)
#define OFF_MIX      (429 * MB)
#define WS_NEED      (493 * MB)

struct CvtJob { const float* src; u16* dst; int R, C; long sld, dld; float scale; int transpose; };
#define MAXJOBS 24
struct CvtJobs { CvtJob j[MAXJOBS]; int n; int pad; };

__device__ __forceinline__ void cvt_run(const CvtJobs& J, char* smem, int bid, int nblk) {
  const int tidx = otid();
  float* tile = (float*)smem;
  for (int ji = 0; ji < J.n; ++ji) {
    const CvtJob jb = J.j[ji];
    if (!jb.transpose) {
      const long nvec = (long)jb.R * (jb.C >> 2);
      const int cv = jb.C >> 2;
      for (long i = (long)bid * NTHR + tidx; i < nvec; i += (long)nblk * NTHR) {
        const long r = i / cv; const int c = (int)(i - r * cv) * 4;
        const float4 v = *(const float4*)(jb.src + r * jb.sld + c);
        u32x2 o; o[0] = pack2(v.x * jb.scale, v.y * jb.scale); o[1] = pack2(v.z * jb.scale, v.w * jb.scale);
        *(u32x2*)(jb.dst + r * jb.dld + c) = o;
      }
    } else {
      const int tr = (jb.R + 63) >> 6, tc = (jb.C + 63) >> 6;
      for (int t = bid; t < tr * tc; t += nblk) {
        const int r0 = (t / tc) * 64, c0 = (t % tc) * 64;
        __syncthreads();
        for (int i = tidx; i < 4096; i += NTHR) {
          const int r = i >> 6, c = i & 63;
          float v = 0.f;
          if (r0 + r < jb.R && c0 + c < jb.C) v = jb.src[(long)(r0 + r) * jb.sld + c0 + c];
          tile[r * 65 + c] = v;
        }
        __syncthreads();
        for (int i = tidx; i < 4096; i += NTHR) {
          const int c = i >> 6, r = i & 63;
          if (r0 + r < jb.R && c0 + c < jb.C) jb.dst[(long)(c0 + c) * jb.dld + r0 + r] = f2bf(tile[r * 65 + c] * jb.scale);
        }
      }
    }
  }
}

__device__ __forceinline__ void cvt_fp8_rows(const float* src, unsigned char* dst, float* scl, int nrows, int bid, int nblk) {
  const int tidx = otid();
  const int lane = tidx & 63, wv = tidx >> 6;
  for (int r = bid * 8 + wv; r < nrows; r += nblk * 8) {
    const float* p = src + (long)r * DM + lane * 16;
    float4 v[4]; float am = 0.f;
#pragma unroll
    for (int i = 0; i < 4; ++i) { v[i] = *(const float4*)(p + i * 4); am = fmaxf(am, fmaxf(fmaxf(fabsf(v[i].x), fabsf(v[i].y)), fmaxf(fabsf(v[i].z), fabsf(v[i].w)))); }
#pragma unroll
    for (int o = 32; o >= 1; o >>= 1) am = fmaxf(am, __shfl_xor(am, o));
    const float sc = am > 0.f ? am * (1.f / 440.f) : 1.f;
    const float inv = 1.f / sc;
    u32x4 o;
#pragma unroll
    for (int i = 0; i < 4; ++i) {
      int w = 0;
      w = __builtin_amdgcn_cvt_pk_fp8_f32(v[i].x * inv, v[i].y * inv, w, false);
      w = __builtin_amdgcn_cvt_pk_fp8_f32(v[i].z * inv, v[i].w * inv, w, true);
      o[i] = (unsigned)w;
    }
    *(u32x4*)(dst + (long)r * DM + lane * 16) = o;
    if (lane == 0) scl[r] = sc;
  }
}

__device__ __forceinline__ void rmsnorm_rows(const float* src, const float* g, u16* dst, int nrows, int bid, int nblk) {
  const int tidx = otid();
  const int lane = tidx & 63, wv = tidx >> 6;
  for (int r = bid * 8 + wv; r < nrows; r += nblk * 8) {
    const float* p = src + (long)r * DM;
    float4 v[4]; float ss = 0.f;
#pragma unroll
    for (int i = 0; i < 4; ++i) { v[i] = *(const float4*)(p + i * 256 + lane * 4); ss += v[i].x * v[i].x + v[i].y * v[i].y + v[i].z * v[i].z + v[i].w * v[i].w; }
    ss = wave_sum(ss);
    const float rs = rsqrtf(ss * (1.f / DM) + EPSV);
#pragma unroll
    for (int i = 0; i < 4; ++i) {
      const float4 gg = *(const float4*)(g + i * 256 + lane * 4);
      u32x2 o; o[0] = pack2(v[i].x * rs * gg.x, v[i].y * rs * gg.y); o[1] = pack2(v[i].z * rs * gg.z, v[i].w * rs * gg.w);
      *(u32x2*)(dst + (long)r * DM + i * 256 + lane * 4) = o;
    }
  }
}

template <int LDC>
__device__ __forceinline__ void gemm_tile(const u16* __restrict__ A, long lda, const u16* __restrict__ Bt, long ldb, int K, char* smem) {
  const int tidx = otid();
  const int tid = tidx, lane = tid & 63, wv = tid >> 6, lr = lane & 15, g = lane >> 4;
  const int wm = wv >> 1, wn = wv & 1;
  f32x4 acc[4][4];
#pragma unroll
  for (int i = 0; i < 4; ++i)
#pragma unroll
    for (int j = 0; j < 4; ++j) acc[i][j] = (f32x4){0.f, 0.f, 0.f, 0.f};
  u32x4 ra[4], rb[2];
  const int nk = K >> 6;
  const int srow = tid >> 3, sch = tid & 7;
  const u16* pa = A + (long)srow * lda + sch * 8;
  const u16* pb = Bt + (long)srow * ldb + sch * 8;
  const unsigned lds_off = (unsigned)(srow * 128 + ((sch ^ (srow & 7)) << 4));
#pragma unroll
  for (int i = 0; i < 4; ++i) ra[i] = *(const u32x4*)(pa + (long)(i * 64) * lda);
#pragma unroll
  for (int i = 0; i < 2; ++i) rb[i] = *(const u32x4*)(pb + (long)(i * 64) * ldb);
  __syncthreads();
#pragma unroll
  for (int i = 0; i < 4; ++i) *(u32x4*)(smem + lds_off + i * 8192) = ra[i];
#pragma unroll
  for (int i = 0; i < 2; ++i) *(u32x4*)(smem + 32768 + lds_off + i * 8192) = rb[i];
  __syncthreads();
  for (int kt = 0; kt < nk; ++kt) {
    const char* sA = smem + (kt & 1) * 49152;
    const char* sB = sA + 32768;
    if (kt + 1 < nk) {
#pragma unroll
      for (int i = 0; i < 4; ++i) ra[i] = *(const u32x4*)(pa + (long)(i * 64) * lda + (kt + 1) * 64);
#pragma unroll
      for (int i = 0; i < 2; ++i) rb[i] = *(const u32x4*)(pb + (long)(i * 64) * ldb + (kt + 1) * 64);
    }
#pragma unroll
    for (int ks = 0; ks < 2; ++ks) {
      bf16x8 a[4], b[4];
#pragma unroll
      for (int mi = 0; mi < 4; ++mi) { const int row = wm * 64 + mi * 16 + lr; a[mi] = *(const bf16x8*)(sA + row * 128 + (((ks * 4 + g) ^ (row & 7)) << 4)); }
#pragma unroll
      for (int ni = 0; ni < 4; ++ni) { const int row = wn * 64 + ni * 16 + lr; b[ni] = *(const bf16x8*)(sB + row * 128 + (((ks * 4 + g) ^ (row & 7)) << 4)); }
#pragma unroll
      for (int mi = 0; mi < 4; ++mi)
#pragma unroll
        for (int ni = 0; ni < 4; ++ni) acc[mi][ni] = mfma16(a[mi], b[ni], acc[mi][ni]);
    }
    if (kt + 1 < nk) {
      char* dA = smem + ((kt + 1) & 1) * 49152;
#pragma unroll
      for (int i = 0; i < 4; ++i) *(u32x4*)(dA + lds_off + i * 8192) = ra[i];
#pragma unroll
      for (int i = 0; i < 2; ++i) *(u32x4*)(dA + 32768 + lds_off + i * 8192) = rb[i];
    }
    __syncthreads();
  }
  float* sC = (float*)smem;
#pragma unroll
  for (int mi = 0; mi < 4; ++mi)
#pragma unroll
    for (int ni = 0; ni < 4; ++ni)
#pragma unroll
      for (int r = 0; r < 4; ++r) sC[(wm * 64 + mi * 16 + g * 4 + r) * LDC + wn * 64 + ni * 16 + lr] = acc[mi][ni][r];
  __syncthreads();
}

__device__ __forceinline__ void epi_store_bf16(const char* smem, u16* C, long ldc, float scale, int ncols) {
  const int tidx = otid();
  const float* sC = (const float*)smem;
  const int cv = ncols >> 2;
  for (int i = tidx; i < 256 * cv; i += NTHR) {
    const int r = i / cv, c = (i - r * cv) * 4;
    const float4 v = *(const float4*)(sC + r * 132 + c);
    u32x2 o; o[0] = pack2(v.x * scale, v.y * scale); o[1] = pack2(v.z * scale, v.w * scale);
    *(u32x2*)(C + (long)r * ldc + c) = o;
  }
}
__device__ __forceinline__ void epi_resid_f32(const char* smem, const float* R, float* C, long ldc) {
  const int tidx = otid();
  const float* sC = (const float*)smem;
  for (int i = tidx; i < 256 * 32; i += NTHR) {
    const int r = i >> 5, c = (i & 31) * 4;
    const float4 v = *(const float4*)(sC + r * 132 + c);
    const float4 x = *(const float4*)(R + (long)r * ldc + c);
    float4 o; o.x = v.x + x.x; o.y = v.y + x.y; o.z = v.z + x.z; o.w = v.w + x.w;
    *(float4*)(C + (long)r * ldc + c) = o;
  }
}

struct Params {
  const float *x, *mem, *g_mix, *w_in, *g_cq, *g_ckv, *g_kidx, *w_uq, *w_iq, *w_uk, *w_uv, *rel_bias, *conv_w, *A_log, *dt_bias, *g_onorm,
      *w_out, *g_cross, *g_mem, *wq_x, *wk_x, *wv_x, *wo_x, *g_ffn, *w_pq, *sub_keys, *u_emb, *v_emb, *g_final;
  float* out;
  char* ws;
};


struct GemmP { const u16* A; long lda, a_bs; const u16* Bt; long ldb, b_bs; u16* C; long ldc, c_bs; int M, N, K, nbatch; float scale; int ncols; int tstore; };
__device__ __forceinline__ void gemm_bf16_phase(const GemmP& p, char* smem, int bid, int nblk) {
  const int tidx = otid();
  const int nm = p.M >> 8, nn = p.N >> 7, per = nm * nn;
  for (int t = bid; t < per * p.nbatch; t += nblk) {
    const int b = t / per, r = t - b * per, mp = r / nn, np = r - mp * nn;
    gemm_tile<132>(p.A + b * p.a_bs + (long)mp * 256 * p.lda, p.lda, p.Bt + b * p.b_bs + (long)np * 128 * p.ldb, p.ldb, p.K, smem);
    if (!p.tstore) epi_store_bf16(smem, p.C + b * p.c_bs + (long)mp * 256 * p.ldc + np * 128, p.ldc, p.scale, p.ncols);
    else {
      const float* sC = (const float*)smem;
      u16* C = p.C + b * p.c_bs + (long)np * 128 * p.ldc + mp * 256;
      for (int i = tidx; i < 256 * 128; i += NTHR) { const int n = i >> 8, m = i & 255; C[(long)n * p.ldc + m] = f2bf(sC[m * 132 + n] * p.scale); }
    }
  }
}

__device__ __forceinline__ void g1_phase(const Params& P, char* smem, int bid, int nblk) {
  const u16* A = (const u16*)(P.ws + OFF_H); const u16* Bt = (const u16*)(P.ws + OFF_WINT);
  for (int t = bid; t < 128 * 21; t += nblk) {
    const int mp = t / 21, np = t - mp * 21;
    gemm_tile<132>(A + (long)mp * 256 * DM, DM, Bt + (long)np * 128 * DM, DM, DM, smem);
    u16* C; long ldc;
    if (np < 5) { C = (u16*)(P.ws + OFF_PA) + np * 128; ldc = 640; }
    else if (np < 17) { C = (u16*)(P.ws + OFF_PB) + (np - 5) * 128; ldc = 1536; }
    else { C = (u16*)(P.ws + OFF_BZ) + (np - 17) * 128; ldc = 512; }
    epi_store_bf16(smem, C + (long)mp * 256 * ldc, ldc, 1.f, 128);
  }
}

__device__ __forceinline__ void g2_phase(const Params& P, char* smem, int bid, int nblk) {
  const u16* A = (const u16*)(P.ws + OFF_CQN); const u16* Bt = (const u16*)(P.ws + OFF_WG2T);
  for (int t = bid; t < 128 * 20; t += nblk) {
    const int mp = t / 20, np = t - mp * 20;
    gemm_tile<132>(A + (long)mp * 256 * 256, 256, Bt + (long)np * 128 * 256, 256, 256, smem);
    if (np < 4) epi_store_bf16(smem, (u16*)(P.ws + OFF_QI) + (long)mp * 256 * 512 + np * 128, 512, 1.f, 128);
    else epi_store_bf16(smem, (u16*)P.out + (long)mp * 256 * 2048 + (np - 4) * 128, 2048, 1.f, 128);
  }
}

struct GemmR { const u16* A; long lda; const u16* Bt; long ldb; const float* R; float* C; int K; };
__device__ __forceinline__ void gemm_resid_phase(const GemmR& p, char* smem, int bid, int nblk) {
  for (int t = bid; t < 128 * 8; t += nblk) {
    const int mp = t >> 3, np = t & 7;
    gemm_tile<132>(p.A + (long)mp * 256 * p.lda, p.lda, p.Bt + (long)np * 128 * p.ldb, p.ldb, p.K, smem);
    epi_resid_f32(smem, p.R + (long)mp * 256 * DM + np * 128, p.C + (long)mp * 256 * DM + np * 128, DM);
  }
}

__device__ __forceinline__ void dsa_prep_phase(const Params& P, int bid, int nblk) {
  const int tidx = otid();
  const int lane = tidx & 63, wv = tidx >> 6;
  const u16* Pa = (const u16*)(P.ws + OFF_PA);
  u16* cqn = (u16*)(P.ws + OFF_CQN); u16* ckvn = (u16*)(P.ws + OFF_CKVN); u16* kidxn = (u16*)(P.ws + OFF_KIDXN); float* widx = (float*)(P.ws + OFF_WIDX);
  for (int t = bid * 8 + wv; t < T_TOK; t += nblk * 8) {
    const u16* row = Pa + (long)t * 640;
    const u32x2 a = *(const u32x2*)(row + lane * 4);
    const u32x2 c = *(const u32x2*)(row + 256 + lane * 4);
    const float k = bf2f(row[512 + lane]);
    float a0 = lo2f(a[0]), a1 = hi2f(a[0]), a2 = lo2f(a[1]), a3 = hi2f(a[1]);
    float c0 = lo2f(c[0]), c1 = hi2f(c[0]), c2 = lo2f(c[1]), c3 = hi2f(c[1]);
    const float sa = wave_sum(a0 * a0 + a1 * a1 + a2 * a2 + a3 * a3), sc = wave_sum(c0 * c0 + c1 * c1 + c2 * c2 + c3 * c3), sk = wave_sum(k * k);
    const float ra = rsqrtf(sa * (1.f / 256) + EPSV), rc = rsqrtf(sc * (1.f / 256) + EPSV), rk = rsqrtf(sk * (1.f / 64) + EPSV);
    const float4 ga = *(const float4*)(P.g_cq + lane * 4), gc = *(const float4*)(P.g_ckv + lane * 4);
    u32x2 o; o[0] = pack2(a0 * ra * ga.x, a1 * ra * ga.y); o[1] = pack2(a2 * ra * ga.z, a3 * ra * ga.w);
    *(u32x2*)(cqn + (long)t * 256 + lane * 4) = o;
    o[0] = pack2(c0 * rc * gc.x, c1 * rc * gc.y); o[1] = pack2(c2 * rc * gc.z, c3 * rc * gc.w);
    *(u32x2*)(ckvn + (long)t * 256 + lane * 4) = o;
    kidxn[(long)t * 64 + lane] = f2bf(k * rk * P.g_kidx[lane]);
    if (lane < 8) widx[(long)t * 8 + lane] = bf2f(row[576 + lane]) * 0.04419417382415922f;
  }
}

#define IX_CAP 1024
#define IX_CS 0
#define IX_CI 65536
#define IX_HIST 98304
#define IX_CV 131072
#define IX_CNT 135168
__device__ __forceinline__ void compact_query(char* smem, int q, int n, int lane, int wv) {
  float* cs = (float*)(smem + IX_CS) + q * IX_CAP; u16* ci = (u16*)(smem + IX_CI) + q * IX_CAP;
  unsigned* hist = (unsigned*)(smem + IX_HIST) + wv * 1024;
  float* cval = (float*)(smem + IX_CV) + wv * 128; int* cidx = (int*)cval + 64;
  float v[16]; int id[16];
#pragma unroll
  for (int i = 0; i < 16; ++i) { const int e = i * 64 + lane; const bool ok = e < n; v[i] = ok ? cs[e] : -3.0e38f; id[i] = ok ? (int)ci[e] : 0xffff; }
  float lo = 3.0e38f, hi = -3.0e38f;
#pragma unroll
  for (int i = 0; i < 16; ++i) { lo = fminf(lo, (i * 64 + lane < n) ? v[i] : 3.0e38f); hi = fmaxf(hi, v[i]); }
  lo = wave_min_u(lo); hi = wave_max_u(hi);
  int need = 256;
  float tauv = lo; int taui = 0xffff;
  for (int iter = 0; iter < 64; ++iter) {
    if (!(hi > lo)) {
      tauv = lo; int t = 0;
      for (int bit = 12; bit >= 0; --bit) {
        const int trial = t | (1 << bit); int c = 0;
#pragma unroll
        for (int i = 0; i < 16; ++i) c += __popcll(__ballot(v[i] == lo && id[i] < trial));
        if (c <= need - 1) t = trial;
      }
      taui = t; break;
    }
    for (int i = lane; i < 1024; i += 64) hist[i] = 0u;
    __builtin_amdgcn_wave_barrier();
    const float scale = 1024.f / (hi - lo);
#pragma unroll
    for (int i = 0; i < 16; ++i) {
      const float x = v[i];
      if (x >= lo && x <= hi) { int b = (int)((x - lo) * scale); b = b > 1023 ? 1023 : b; atomicAdd(&hist[b], 1u); }
    }
    __builtin_amdgcn_wave_barrier();
    unsigned c[16]; unsigned tot = 0;
#pragma unroll
    for (int j = 0; j < 16; ++j) { c[j] = hist[1023 - 16 * lane - j]; tot += c[j]; }
    unsigned incl = tot;
#pragma unroll
    for (int o = 1; o < 64; o <<= 1) { const unsigned t = __shfl_up(incl, o); if (lane >= o) incl += t; }
    const unsigned excl = incl - tot;
    const bool mine = (excl < (unsigned)need) && (incl >= (unsigned)need);
    int bsel = 0; unsigned above = 0, nstar = 0;
    if (mine) {
      unsigned run = excl;
#pragma unroll
      for (int j = 0; j < 16; ++j) { if (run < (unsigned)need && run + c[j] >= (unsigned)need) { bsel = 1023 - 16 * lane - j; above = run; nstar = c[j]; } run += c[j]; }
    }
    const unsigned long long mk = __ballot(mine);
    const int src = __ffsll((long long)mk) - 1;
    bsel = __shfl(bsel, src); above = __shfl(above, src); nstar = __shfl(nstar, src);
    need -= (int)above;
    float nlo = 3.0e38f, nhi = -3.0e38f; int cnt = 0;
#pragma unroll
    for (int i = 0; i < 16; ++i) {
      const float x = v[i];
      bool in = false;
      if (x >= lo && x <= hi) { int b = (int)((x - lo) * scale); b = b > 1023 ? 1023 : b; in = (b == bsel); }
      if (in) { nlo = fminf(nlo, x); nhi = fmaxf(nhi, x); }
      if (nstar <= 64u) {
        const unsigned long long m = __ballot(in);
        if (in) { const int pos = cnt + __builtin_amdgcn_mbcnt_hi((unsigned)(m >> 32), __builtin_amdgcn_mbcnt_lo((unsigned)m, 0u)); cval[pos] = x; cidx[pos] = id[i]; }
        cnt += __popcll(m);
      }
    }
    nlo = wave_min_u(nlo); nhi = wave_max_u(nhi);
    if (nstar <= 64u) {
      __builtin_amdgcn_wave_barrier();
      const bool act = lane < (int)nstar;
      const float mv = act ? cval[lane] : -3.0e38f; const int mi = act ? cidx[lane] : 0xffff;
      int rank = 0;
      for (int j = 0; j < (int)nstar; ++j) { const float o = cval[j]; const int oi = cidx[j]; rank += (o > mv || (o == mv && oi < mi)) ? 1 : 0; }
      const unsigned long long mm = __ballot(act && rank == need - 1);
      const int s2 = __ffsll((long long)mm) - 1;
      tauv = __shfl(mv, s2 < 0 ? 0 : s2); taui = __shfl(mi, s2 < 0 ? 0 : s2);
      break;
    }
    lo = nlo; hi = nhi;
  }
  int pos = 0;
#pragma unroll
  for (int i = 0; i < 16; ++i) {
    const bool keep = (v[i] > tauv) || (v[i] == tauv && id[i] <= taui);
    const unsigned long long m = __ballot(keep);
    if (keep) { const int p = pos + __builtin_amdgcn_mbcnt_hi((unsigned)(m >> 32), __builtin_amdgcn_mbcnt_lo((unsigned)m, 0u)); if (p < IX_CAP) { cs[p] = v[i]; ci[p] = (u16)id[i]; } }
    pos += __popcll(m);
  }
  if (lane == 0) { ((unsigned*)(smem + IX_CNT))[q] = 256u; ((float*)(smem + IX_CNT))[16 + q] = tauv; }
}
__device__ __forceinline__ bool quick_compact(char* smem, int q, int n, int lane) {
  float* cs = (float*)(smem + IX_CS) + q * IX_CAP; u16* ci = (u16*)(smem + IX_CI) + q * IX_CAP;
  float v[16]; int id[16];
#pragma unroll
  for (int i = 0; i < 16; ++i) { const int e = i * 64 + lane; const bool ok = e < n; v[i] = ok ? cs[e] : -3.0e38f; id[i] = ok ? (int)ci[e] : 0xffff; }
  float lo = 3.0e38f, hi = -3.0e38f;
#pragma unroll
  for (int i = 0; i < 16; ++i) { lo = fminf(lo, (i * 64 + lane < n) ? v[i] : 3.0e38f); hi = fmaxf(hi, v[i]); }
  lo = wave_min_u(lo); hi = wave_max_u(hi);
  float thr = -3.0e38f; int kept = n;
  float a = lo, b = hi;
  for (int it = 0; it < 14 && kept > 448; ++it) {
    const float mid = 0.5f * (a + b);
    if (!(mid > a) || !(mid < b)) break;
    int c = 0;
#pragma unroll
    for (int i = 0; i < 16; ++i) c += __popcll(__ballot(v[i] > mid));
    if (c >= 256) { a = mid; thr = mid; kept = c; } else b = mid;
  }
  if (kept > 512) return false;
  int pos = 0;
#pragma unroll
  for (int i = 0; i < 16; ++i) {
    const bool keep = v[i] > thr;
    const unsigned long long m = __ballot(keep);
    if (keep) { const int p = pos + __builtin_amdgcn_mbcnt_hi((unsigned)(m >> 32), __builtin_amdgcn_mbcnt_lo((unsigned)m, 0u)); cs[p] = v[i]; ci[p] = (u16)id[i]; }
    pos += __popcll(m);
  }
  if (lane == 0) { ((unsigned*)(smem + IX_CNT))[q] = (unsigned)kept; ((float*)(smem + IX_CNT))[16 + q] = thr; }
  return true;
}
__device__ __forceinline__ void emit_sorted(char* smem, int q, u16* sel, int lane, int wv) {
  const u16* ci = (const u16*)(smem + IX_CI) + q * IX_CAP;
  unsigned* bm = (unsigned*)(smem + IX_HIST) + wv * 1024;
  for (int i = lane; i < 256; i += 64) bm[i] = 0u;
  __builtin_amdgcn_wave_barrier();
#pragma unroll
  for (int k = 0; k < 4; ++k) { const unsigned idx = ci[k * 64 + lane]; atomicOr(&bm[idx >> 5], 1u << (idx & 31)); }
  __builtin_amdgcn_wave_barrier();
  unsigned w[4]; unsigned tot = 0;
#pragma unroll
  for (int j = 0; j < 4; ++j) { w[j] = bm[4 * lane + j]; tot += __popc(w[j]); }
  unsigned incl = tot;
#pragma unroll
  for (int o = 1; o < 64; o <<= 1) { const unsigned t = __shfl_up(incl, o); if (lane >= o) incl += t; }
  unsigned p = incl - tot;
#pragma unroll
  for (int j = 0; j < 4; ++j) {
    unsigned x = w[j];
    while (x) { const int b = __ffs((int)x) - 1; if (p < 256u) sel[p] = (u16)(lane * 128 + j * 32 + b); ++p; x &= x - 1; }
  }
}

#define ATT_ROWB 544
__device__ __forceinline__ int t5_bucket(int rel) {
  const int n = rel < 0 ? -rel : rel;
  const int lg = 8 + (n >= 12) + (n >= 16) + (n >= 23) + (n >= 32) + (n >= 46) + (n >= 64) + (n >= 91);
  return (rel > 0 ? 16 : 0) + (n < 8 ? n : lg);
}
#define DSA_SBIAS 139264
#define DSA_SSEL 140288
#define LDS_XB 148480
#define LDS_UNIT 148496
#define LDS_TOTAL 148512
__device__ __forceinline__ void attn_query(const Params& P, int t, const u16* ssel, char* rows, const float* sbias, int lane) {
  const int lr = lane & 15, g = lane >> 4;
  const u16* ckv = (const u16*)(P.ws + OFF_CKVN);
  u16* qlat = (u16*)P.out;
  const int b = t >> 13, pos = t & 8191, L = ((pos >> 6) + 1) * 64, n = L < 256 ? L : 256;
  const u16* kb = ckv + (long)(b * SEQ) * 256;
  bf16x8 bq[8];
#pragma unroll
  for (int ks = 0; ks < 8; ++ks) {
    bf16x8 v = (bf16x8){0, 0, 0, 0, 0, 0, 0, 0};
    if (lr < 8) v = *(const bf16x8*)(qlat + (long)t * 2048 + lr * 256 + ks * 32 + g * 8);
    bq[ks] = v;
  }
  float m_run = -3.0e38f, l_run = 0.f;
  f32x4 O[16];
#pragma unroll
  for (int i = 0; i < 16; ++i) O[i] = (f32x4){0.f, 0.f, 0.f, 0.f};
  for (int kbk = 0; kbk < (n >> 5); ++kbk) {
#pragma unroll
    for (int hh = 0; hh < 2; ++hh) {
      u32x4 gr[8];
#pragma unroll
      for (int i = 0; i < 8; ++i) {
        const int r = hh * 16 + i * 2 + (lane >> 5);
        const int idx = ssel[kbk * 32 + r];
        gr[i] = *(const u32x4*)(kb + (long)idx * 256 + (lane & 31) * 8);
      }
#pragma unroll
      for (int i = 0; i < 8; ++i) { const int r = hh * 16 + i * 2 + (lane >> 5); *(u32x4*)(rows + r * ATT_ROWB + (lane & 31) * 16) = gr[i]; }
    }
    __builtin_amdgcn_wave_barrier();
    f32x4 S[2];
#pragma unroll
    for (int mt = 0; mt < 2; ++mt) {
      f32x4 d = (f32x4){0.f, 0.f, 0.f, 0.f};
#pragma unroll
      for (int ks = 0; ks < 8; ++ks) { const bf16x8 a = *(const bf16x8*)(rows + (mt * 16 + lr) * ATT_ROWB + (ks * 4 + g) * 16); d = mfma16(a, bq[ks], d); }
      S[mt] = d;
    }
    float mx = -3.0e38f;
#pragma unroll
    for (int mt = 0; mt < 2; ++mt)
#pragma unroll
      for (int r = 0; r < 4; ++r) {
        const int idx = ssel[kbk * 32 + mt * 16 + g * 4 + r];
        const float bs = sbias[t5_bucket(idx - pos) * 8 + (lr & 7)];
        S[mt][r] += bs; mx = fmaxf(mx, S[mt][r]);
      }
    mx = fmaxf(mx, __shfl_xor(mx, 16)); mx = fmaxf(mx, __shfl_xor(mx, 32));
    const float m_new = fmaxf(m_run, mx);
    const float alpha = __expf(m_run - m_new);
    float ps = 0.f; float p[8];
#pragma unroll
    for (int mt = 0; mt < 2; ++mt)
#pragma unroll
      for (int r = 0; r < 4; ++r) { p[mt * 4 + r] = __expf(S[mt][r] - m_new); ps += p[mt * 4 + r]; }
    l_run = l_run * alpha + ps; m_run = m_new;
    bf16x8 ap;
#pragma unroll
    for (int j = 0; j < 8; ++j) ap[j] = (short)f2bf(p[j]);
    float al[4];
#pragma unroll
    for (int r = 0; r < 4; ++r) al[r] = __shfl(alpha, g * 4 + r);
    const int q = lr >> 2, pp = lr & 3;
    const char* tb0 = rows + (4 * g + q) * ATT_ROWB + pp * 8;
    const char* tb1 = rows + (16 + 4 * g + q) * ATT_ROWB + pp * 8;
#pragma unroll
    for (int ct = 0; ct < 16; ++ct) {
      const s16x4 v0 = __builtin_amdgcn_ds_read_tr16_b64_v4i16((LAS s16x4*)(tb0 + ct * 32));
      const s16x4 v1 = __builtin_amdgcn_ds_read_tr16_b64_v4i16((LAS s16x4*)(tb1 + ct * 32));
      bf16x8 bb; bb[0] = v0[0]; bb[1] = v0[1]; bb[2] = v0[2]; bb[3] = v0[3]; bb[4] = v1[0]; bb[5] = v1[1]; bb[6] = v1[2]; bb[7] = v1[3];
      f32x4 o = O[ct];
#pragma unroll
      for (int r = 0; r < 4; ++r) o[r] *= al[r];
      O[ct] = mfma16(ap, bb, o);
    }
    __builtin_amdgcn_wave_barrier();
  }
  float lt = l_run; lt += __shfl_xor(lt, 16); lt += __shfl_xor(lt, 32);
  const float inv = 1.f / lt;
  float iv[4];
#pragma unroll
  for (int r = 0; r < 4; ++r) iv[r] = __shfl(inv, g * 4 + r);
  if (g < 2) {
#pragma unroll
    for (int ct = 0; ct < 16; ++ct)
#pragma unroll
      for (int r = 0; r < 4; ++r) qlat[(long)t * 2048 + (g * 4 + r) * 256 + ct * 16 + lr] = f2bf(O[ct][r] * iv[r]);
  }
}

__device__ __forceinline__ void dsa_unit(const Params& P, char* smem, int unit, int bid) {
  const int tidx = otid();
  const int tid = tidx, lane = tid & 63, wv = tid >> 6, lr = lane & 15, g = lane >> 4;
  const u16* qi = (const u16*)(P.ws + OFF_QI); const u16* kidx = (const u16*)(P.ws + OFF_KIDXN); const float* widx = (const float*)(P.ws + OFF_WIDX);
  u16* sselw = (u16*)(smem + DSA_SSEL) + wv * 512;
  const float* sbias = (const float*)(smem + DSA_SBIAS);
  unsigned* scnt = (unsigned*)(smem + IX_CNT); float* stau = (float*)(smem + IX_CNT) + 16;
  const int t0 = unit * 16, b = t0 >> 13, pos0 = t0 & 8191, L = ((pos0 >> 6) + 1) * 64;
  __syncthreads();
  if (L > 256) {
    if (tid < 16) { scnt[tid] = 0u; stau[tid] = -3.0e38f; }
    bf16x8 a[8][2];
#pragma unroll
    for (int h = 0; h < 8; ++h)
#pragma unroll
      for (int ks = 0; ks < 2; ++ks) a[h][ks] = *(const bf16x8*)(qi + (long)(t0 + lr) * 512 + h * 64 + ks * 32 + g * 8);
    if (tid < 128) ((float*)(smem + IX_CNT + 128))[tid] = widx[(long)t0 * 8 + tid];
    const float* sW = (const float*)(smem + IX_CNT + 128) + g * 32;
    float tq[4] = {-3.0e38f, -3.0e38f, -3.0e38f, -3.0e38f};
    const u16* kb = kidx + (long)(b * SEQ) * 64;
    const int nkt = L >> 4;
    __syncthreads();
    for (int base = 0; base < nkt; base += 32) {
      bf16x8 bb[4][2];
#pragma unroll
      for (int j = 0; j < 4; ++j) {
        int kt = base + j * 8 + wv; kt = kt < nkt ? kt : nkt - 1;
        bb[j][0] = *(const bf16x8*)(kb + (long)(kt * 16 + lr) * 64 + g * 8);
        bb[j][1] = *(const bf16x8*)(kb + (long)(kt * 16 + lr) * 64 + 32 + g * 8);
      }
      float wq[4][8];
#pragma unroll
      for (int r = 0; r < 4; ++r) {
        const float4 w0 = *(const float4*)(sW + r * 8), w1 = *(const float4*)(sW + r * 8 + 4);
        wq[r][0] = w0.x; wq[r][1] = w0.y; wq[r][2] = w0.z; wq[r][3] = w0.w; wq[r][4] = w1.x; wq[r][5] = w1.y; wq[r][6] = w1.z; wq[r][7] = w1.w;
      }
#pragma unroll
      for (int j = 0; j < 4; ++j) {
        const int kt = base + j * 8 + wv;
        if (kt < nkt) {
          float s[4] = {0.f, 0.f, 0.f, 0.f};
#pragma unroll
          for (int h = 0; h < 8; ++h) {
            f32x4 d = (f32x4){0.f, 0.f, 0.f, 0.f};
            d = mfma16(a[h][0], bb[j][0], d); d = mfma16(a[h][1], bb[j][1], d);
#pragma unroll
            for (int r = 0; r < 4; ++r) s[r] = fmaf(fmaxf(d[r], 0.f), wq[r][h], s[r]);
          }
#pragma unroll
          for (int r = 0; r < 4; ++r) {
            if (s[r] > tq[r]) {
              const unsigned slot = atomicAdd(&scnt[g * 4 + r], 1u);
              if (slot < (unsigned)IX_CAP) { ((float*)(smem + IX_CS))[(g * 4 + r) * IX_CAP + slot] = s[r]; ((u16*)(smem + IX_CI))[(g * 4 + r) * IX_CAP + slot] = (u16)(kt * 16 + lr); }
            }
          }
        }
      }
      __syncthreads();
      const bool last = (base + 32 >= nkt);
#pragma unroll 1
      for (int qq = 0; qq < 2; ++qq) {
        const int q = wv * 2 + qq; const int n = (int)scnt[q];
        const int nn = n > IX_CAP ? IX_CAP : n;
        if (last) { if (n > 256) compact_query(smem, q, nn, lane, wv); }
        else if (n > 512) { if (!quick_compact(smem, q, nn, lane)) compact_query(smem, q, nn, lane, wv); }
      }
      __syncthreads();
#pragma unroll
      for (int r = 0; r < 4; ++r) tq[r] = stau[g * 4 + r];
    }
#pragma unroll 1
    for (int qq = 0; qq < 2; ++qq) emit_sorted(smem, wv * 2 + qq, sselw + qq * 256, lane, wv);
  } else {
#pragma unroll 1
    for (int qq = 0; qq < 2; ++qq) { u16* sel = sselw + qq * 256; for (int j = lane; j < 256; j += 64) sel[j] = (u16)(j < L ? j : 0); }
  }
  __syncthreads();
#pragma unroll 1
  for (int qq = 0; qq < 2; ++qq) attn_query(P, t0 + wv * 2 + qq, sselw + qq * 256, smem + wv * (32 * ATT_ROWB), sbias, lane);
}
__device__ __forceinline__ void dsa_queue_phase(const Params& P, char* smem, int bid, unsigned* qctr) {
  const int tidx = otid();
  const int tid = tidx;
  float* sbias = (float*)(smem + DSA_SBIAS);
  volatile int* sunit = (volatile int*)(smem + LDS_UNIT);
  __syncthreads();
  for (int i = tid; i < 256; i += NTHR) sbias[i] = P.rel_bias[i];
  for (;;) {
    __syncthreads();
    if (tid == 0) *sunit = (int)atomicAdd(qctr, 1u);
    __syncthreads();
    const int v = *sunit;
    if (v >= 2048) break;
    const int unit = (v & 3) * 512 + (511 - (v >> 2));
    dsa_unit(P, smem, unit, bid);
  }
}
__device__ __forceinline__ void dn_prep_phase(const Params& P, int bid, int nblk) {
  const int tidx = otid();
  const int lane = tidx & 63, wv = tidx >> 6, hh = lane >> 4, cg = lane & 15;
  const u16* Pb = (const u16*)(P.ws + OFF_PB); const u16* Pa = (const u16*)(P.ws + OFF_PA);
  u16* qkv = (u16*)(P.ws + OFF_QKV);
  float* gg = (float*)(P.ws + OFF_GB); float* bt = gg + 16 * 8192;
  for (int t = bid * 8 + wv; t < T_TOK; t += nblk * 8) {
    const int b = t >> 13, pos = t & 8191;
#pragma unroll
    for (int sec = 0; sec < 3; ++sec) {
      const int col = sec * 512 + hh * 128 + cg * 8;
      float y[8];
#pragma unroll
      for (int e = 0; e < 8; ++e) y[e] = 0.f;
#pragma unroll
      for (int j = 0; j < 4; ++j) {
        if (pos - 3 + j >= 0) {
          const u32x4 xv = *(const u32x4*)(Pb + (long)(t - 3 + j) * 1536 + col);
          const float4 w0 = *(const float4*)(P.conv_w + j * 1536 + col), w1 = *(const float4*)(P.conv_w + j * 1536 + col + 4);
          y[0] += w0.x * lo2f(xv[0]); y[1] += w0.y * hi2f(xv[0]); y[2] += w0.z * lo2f(xv[1]); y[3] += w0.w * hi2f(xv[1]);
          y[4] += w1.x * lo2f(xv[2]); y[5] += w1.y * hi2f(xv[2]); y[6] += w1.z * lo2f(xv[3]); y[7] += w1.w * hi2f(xv[3]);
        }
      }
      float ss = 0.f;
#pragma unroll
      for (int e = 0; e < 8; ++e) { y[e] = y[e] / (1.f + __expf(-y[e])); ss += y[e] * y[e]; }
      ss += __shfl_xor(ss, 1); ss += __shfl_xor(ss, 2); ss += __shfl_xor(ss, 4); ss += __shfl_xor(ss, 8);
      float sc = 1.f;
      if (sec == 0) sc = rsqrtf(ss + EPSV) * 0.08838834764831845f;
      else if (sec == 1) sc = rsqrtf(ss + EPSV);
      u32x4 o;
#pragma unroll
      for (int e = 0; e < 4; ++e) o[e] = pack2(y[2 * e] * sc, y[2 * e + 1] * sc);
      *(u32x4*)(qkv + (long)sec * (16l * 8192 * 128) + ((long)(b * 4 + hh) * 8192 + pos) * 128 + cg * 8) = o;
    }
    if (cg == 0) {
      const float a = bf2f(Pa[(long)t * 640 + 584 + hh]), bb = bf2f(Pa[(long)t * 640 + 588 + hh]);
      const float z = a + P.dt_bias[hh];
      const float sp = z > 20.f ? z : log1pf(__expf(z));
      gg[(long)(b * 4 + hh) * 8192 + pos] = -__expf(P.A_log[hh]) * sp;
      bt[(long)(b * 4 + hh) * 8192 + pos] = 1.f / (1.f + __expf(-bb));
    }
  }
}

__device__ __forceinline__ int perm32_pos(int c) {
  const int blk = c & ~31, w = c & 31;
  const int hi = w >> 4, gq = (w >> 2) & 3, lo = w & 3;
  return blk + gq * 8 + hi * 4 + lo;
}
__device__ __forceinline__ void dn_intra_phase(const Params& P, char* smem, int bid, int nblk) {
  const int tidx = otid();
  const int tid = tidx, lane = tid & 63, wv = tid >> 6, lr = lane & 15, g = lane >> 4;
  u16* qkv = (u16*)(P.ws + OFF_QKV);
  const float* gg = (const float*)(P.ws + OFF_GB); const float* bt = gg + 16 * 8192; float* cdec = (float*)(P.ws + OFF_GB) + 32 * 8192;
  u16* wdn = (u16*)(P.ws + OFF_WDN); u16* intra = (u16*)(P.ws + OFF_INTRA);
  char* sQ = smem;
  char* sK = smem + 16384;
  char* sV = smem + 32768;
  float* sMT = (float*)(smem + 49152);
  float* sG = (float*)(smem + 66560);
  float* sX = (float*)(smem + 67584);
  for (int u = bid; u < 2048; u += nblk) {
    const int bh = u >> 7, ch = u & 127;
    const long tbase = ((long)bh * 8192 + ch * 64) * 128;
    u16* tq = qkv + tbase; u16* tk = qkv + 16l * 8192 * 128 + tbase; u16* tv = qkv + 32l * 8192 * 128 + tbase;
    __syncthreads();
    for (int i = tid; i < 3072; i += NTHR) {
      const int which = i >> 10, q = i & 1023, row = q >> 4, chk = q & 15;
      const u16* src = (which == 0 ? tq : which == 1 ? tk : tv) + row * 128 + chk * 8;
      *(u32x4*)(smem + which * 16384 + row * 256 + ((chk ^ (row & 15)) << 4)) = *(const u32x4*)src;
    }
    if (tid < 64) {
      float s = 0.f;
      for (int j = 0; j <= tid; ++j) s += gg[(long)bh * 8192 + ch * 64 + j];
      sG[tid] = s; sG[64 + tid] = bt[(long)bh * 8192 + ch * 64 + tid];
    }
    __syncthreads();
    {
      const int mi = wv & 3; const char* sAop = (wv < 4) ? sK : sQ;
      bf16x8 a[4];
#pragma unroll
      for (int ks = 0; ks < 4; ++ks) { const int row = mi * 16 + lr; a[ks] = *(const bf16x8*)(sAop + row * 256 + (((ks * 4 + g) ^ (row & 15)) << 4)); }
#pragma unroll
      for (int ni = 0; ni < 4; ++ni) {
        f32x4 d = (f32x4){0.f, 0.f, 0.f, 0.f};
#pragma unroll
        for (int ks = 0; ks < 4; ++ks) { const int row = ni * 16 + lr; const bf16x8 bb = *(const bf16x8*)(sK + row * 256 + (((ks * 4 + g) ^ (row & 15)) << 4)); d = mfma16(a[ks], bb, d); }
        const int j = ni * 16 + lr; const float gj = sG[j];
#pragma unroll
        for (int r = 0; r < 4; ++r) {
          const int i = mi * 16 + g * 4 + r; const float gi = sG[i];
          if (wv < 4) { sMT[j * 68 + i] = (j < i) ? sG[64 + i] * d[r] * __expf(gi - gj) : 0.f; }
          else { const float v = (j <= i) ? d[r] * __expf(gi - gj) : 0.f; intra[(long)u * 4096 + i * 64 + perm32_pos(j)] = f2bf(v); }
        }
      }
    }
    __syncthreads();
    if (wv < 4) {
      const int c = tid;
      const char* sSrc = (c < 128) ? sV : sK; const int cc = c & 127;
      const int pc = perm32_pos(cc);
#pragma unroll 1
      for (int bi = 0; bi < 4; ++bi) {
        float acc[16];
#pragma unroll
        for (int r = 0; r < 16; ++r) {
          const int i = bi * 16 + r;
          const float raw = bf2f(*(const u16*)(sSrc + i * 256 + (((cc >> 3) ^ (i & 15)) << 4) + (cc & 7) * 2));
          acc[r] = raw * sG[64 + i] * ((c < 128) ? 1.f : __expf(sG[i]));
        }
        for (int j = 0; j < bi * 16; ++j) {
          const float xj = sX[j * 256 + c];
          const float* mrow = sMT + j * 68 + bi * 16;
#pragma unroll
          for (int q4 = 0; q4 < 4; ++q4) {
            const float4 m = *(const float4*)(mrow + q4 * 4);
            acc[q4 * 4 + 0] = fmaf(-m.x, xj, acc[q4 * 4 + 0]); acc[q4 * 4 + 1] = fmaf(-m.y, xj, acc[q4 * 4 + 1]);
            acc[q4 * 4 + 2] = fmaf(-m.z, xj, acc[q4 * 4 + 2]); acc[q4 * 4 + 3] = fmaf(-m.w, xj, acc[q4 * 4 + 3]);
          }
        }
#pragma unroll
        for (int r = 1; r < 16; ++r)
#pragma unroll
          for (int q = 0; q < r; ++q) acc[r] = fmaf(-sMT[(bi * 16 + q) * 68 + bi * 16 + r], acc[q], acc[r]);
#pragma unroll
        for (int r = 0; r < 16; ++r) sX[(bi * 16 + r) * 256 + c] = acc[r];
        if (c < 128) {
#pragma unroll
          for (int h8 = 0; h8 < 2; ++h8) {
            u32x4 o;
#pragma unroll
            for (int e = 0; e < 4; ++e) o[e] = pack2(acc[h8 * 8 + 2 * e], acc[h8 * 8 + 2 * e + 1]);
            *(u32x4*)(tv + c * 64 + bi * 16 + h8 * 8) = o;
          }
        } else {
#pragma unroll
          for (int r = 0; r < 16; ++r) wdn[tbase + (bi * 16 + r) * 128 + pc] = f2bf(acc[r]);
        }
      }
    } else {
      const int t2 = tid - 256;
      const float glast = sG[63];
      for (int i = t2; i < 64 * 128; i += 256) {
        const int row = i >> 7, c = i & 127;
        const float v = bf2f(*(const u16*)(sQ + row * 256 + (((c >> 3) ^ (row & 15)) << 4) + (c & 7) * 2)) * __expf(sG[row]);
        tq[row * 128 + perm32_pos(c)] = f2bf(v);
      }
      for (int i = t2; i < 64 * 128; i += 256) {
        const int dk = i >> 6, row = i & 63;
        const float v = bf2f(*(const u16*)(sK + row * 256 + (((dk >> 3) ^ (row & 15)) << 4) + (dk & 7) * 2)) * __expf(glast - sG[row]);
        tk[dk * 64 + perm32_pos(row)] = f2bf(v);
      }
      if (t2 == 0) cdec[u] = __expf(glast);
    }
  }
}

#define SCAN_BUF 73728
__device__ __forceinline__ void dn_scan_phase(const Params& P, char* smem, int bid, int nblk) {
  const int tidx = otid();
  const int tid = tidx, lane = tid & 63, wv = tid >> 6, lr = lane & 15, g = lane >> 4;
  const u16* qkv = (const u16*)(P.ws + OFF_QKV);
  const u16* wdn = (const u16*)(P.ws + OFF_WDN); const u16* intra = (const u16*)(P.ws + OFF_INTRA);
  const float* cdec = (const float*)(P.ws + OFF_GB) + 32 * 8192;
  u16* mix = (u16*)(P.ws + OFF_MIX);
  for (int bh = bid; bh < 16; bh += nblk) {
    const int b = bh >> 2, hh = bh & 3;
    f32x4 S[8];
#pragma unroll
    for (int i = 0; i < 8; ++i) S[i] = (f32x4){0.f, 0.f, 0.f, 0.f};
    u32x4 st[9];
    unsigned lofs[9];
#pragma unroll
    for (int i = 0; i < 9; ++i) {
      const int q = tid + i * NTHR;
      unsigned o;
      if (q < 1024) o = (unsigned)OFF_WDN + (unsigned)bh * (8192u * 256u) + q * 16;
      else if (q < 4096) o = (unsigned)OFF_QKV + (unsigned)((q >> 10) - 1) * (16u * 8192u * 256u) + (unsigned)bh * (8192u * 256u) + (q & 1023) * 16;
      else o = (unsigned)OFF_INTRA + (unsigned)bh * (128u * 8192u) + (q - 4096) * 16;
      lofs[i] = o;
    }
    const char* wsb = P.ws;
    auto load_chunk = [&](int n) {
#pragma unroll
      for (int i = 0; i < 9; ++i) {
        const unsigned stride = (i < 8) ? 16384u : 8192u;
        st[i] = *(const u32x4*)(wsb + (size_t)(lofs[i] + (unsigned)n * stride));
      }
    };
    auto store_chunk = [&](int bufi) {
      char* base = smem + bufi * SCAN_BUF;
#pragma unroll
      for (int i = 0; i < 9; ++i) {
        const int q = tid + i * NTHR;
        unsigned off;
        if (q < 2048) { const int qq = q & 1023, row = qq >> 4, chk = qq & 15; off = (q >> 10) * 16384 + row * 256 + ((chk ^ (row & 15)) << 4); }
        else if (q < 4096) { const int qq = q & 1023, row = qq >> 3, chk = qq & 7; off = (q >> 10) * 16384 + row * 128 + ((chk ^ (row & 7)) << 4); }
        else { const int qq = q - 4096, row = qq >> 3, chk = qq & 7; off = 65536 + row * 128 + ((chk ^ (row & 7)) << 4); }
        *(u32x4*)(base + off) = st[i];
      }
    };
    __syncthreads();
    load_chunk(0); store_chunk(0); load_chunk(1);
    __syncthreads();
    for (int n = 0; n < 128; ++n) {
      const char* base = smem + (n & 1) * SCAN_BUF;
      const char* sW = base; const char* sQd = base + 16384; const char* sKT = base + 32768; const char* sUT = base + 49152; const char* sA = base + 65536;
      if (n + 1 < 128) { store_chunk((n + 1) & 1); if (n + 2 < 128) load_chunk(n + 2); }
      const float dcy = cdec[bh * 128 + n];
      bf16x8 sb[4];
#pragma unroll
      for (int s = 0; s < 4; ++s)
#pragma unroll
        for (int j = 0; j < 8; ++j) sb[s][j] = (short)f2bf(S[2 * s + (j >> 2)][j & 3]);
      f32x4 vn[4], o[4];
#pragma unroll
      for (int mi = 0; mi < 4; ++mi) {
        f32x4 dw = (f32x4){0.f, 0.f, 0.f, 0.f}, dq = (f32x4){0.f, 0.f, 0.f, 0.f};
        const int row = mi * 16 + lr;
#pragma unroll
        for (int s = 0; s < 4; ++s) {
          const unsigned off = row * 256 + (((s * 4 + g) ^ (row & 15)) << 4);
          dw = mfma16(*(const bf16x8*)(sW + off), sb[s], dw);
          dq = mfma16(*(const bf16x8*)(sQd + off), sb[s], dq);
        }
        const int urow = wv * 16 + lr;
        const int ucol = mi * 16 + g * 4;
        const u32x2 uv = *(const u32x2*)(sUT + urow * 128 + ((((ucol >> 3)) ^ (urow & 7)) << 4) + (ucol & 7) * 2);
        vn[mi][0] = lo2f(uv[0]) - dw[0]; vn[mi][1] = hi2f(uv[0]) - dw[1]; vn[mi][2] = lo2f(uv[1]) - dw[2]; vn[mi][3] = hi2f(uv[1]) - dw[3];
        o[mi] = dq;
      }
      bf16x8 vb[2];
#pragma unroll
      for (int s = 0; s < 2; ++s)
#pragma unroll
        for (int j = 0; j < 8; ++j) vb[s][j] = (short)f2bf(vn[2 * s + (j >> 2)][j & 3]);
#pragma unroll
      for (int mi = 0; mi < 4; ++mi) {
        const int row = mi * 16 + lr;
#pragma unroll
        for (int s = 0; s < 2; ++s) o[mi] = mfma16(*(const bf16x8*)(sA + row * 128 + (((s * 4 + g) ^ (row & 7)) << 4)), vb[s], o[mi]);
      }
#pragma unroll
      for (int m2 = 0; m2 < 8; ++m2) {
        f32x4 d = S[m2];
#pragma unroll
        for (int r = 0; r < 4; ++r) d[r] *= dcy;
        const int row = m2 * 16 + lr;
#pragma unroll
        for (int s = 0; s < 2; ++s) d = mfma16(*(const bf16x8*)(sKT + row * 128 + (((s * 4 + g) ^ (row & 7)) << 4)), vb[s], d);
        S[m2] = d;
      }
#pragma unroll
      for (int mi = 0; mi < 4; ++mi)
#pragma unroll
        for (int r = 0; r < 4; ++r) {
          const long t = (long)b * 8192 + n * 64 + mi * 16 + g * 4 + r;
          mix[t * 1024 + 512 + hh * 128 + wv * 16 + lr] = f2bf(o[mi][r]);
        }
      __syncthreads();
    }
  }
}

__device__ __forceinline__ void dn_gate_phase(const Params& P, int bid, int nblk) {
  const int tidx = otid();
  const int lane = tidx & 63, wv = tidx >> 6, hh = lane >> 4, cg = lane & 15;
  u16* mix = (u16*)(P.ws + OFF_MIX); const u16* bz = (const u16*)(P.ws + OFF_BZ);
  for (int t = bid * 8 + wv; t < T_TOK; t += nblk * 8) {
    u16* p = mix + (long)t * 1024 + 512 + hh * 128 + cg * 8;
    const u32x4 ov = *(const u32x4*)p; const u32x4 zv = *(const u32x4*)(bz + (long)t * 512 + hh * 128 + cg * 8);
    float o[8], z[8];
#pragma unroll
    for (int e = 0; e < 4; ++e) { o[2 * e] = lo2f(ov[e]); o[2 * e + 1] = hi2f(ov[e]); z[2 * e] = lo2f(zv[e]); z[2 * e + 1] = hi2f(zv[e]); }
    float ss = 0.f;
#pragma unroll
    for (int e = 0; e < 8; ++e) ss += o[e] * o[e];
    ss += __shfl_xor(ss, 1); ss += __shfl_xor(ss, 2); ss += __shfl_xor(ss, 4); ss += __shfl_xor(ss, 8);
    const float rs = rsqrtf(ss * (1.f / 128) + EPSV);
    u32x4 r;
#pragma unroll
    for (int e = 0; e < 4; ++e) {
      const float a = o[2 * e] * rs * P.g_onorm[cg * 8 + 2 * e] * (z[2 * e] / (1.f + __expf(-z[2 * e])));
      const float bq = o[2 * e + 1] * rs * P.g_onorm[cg * 8 + 2 * e + 1] * (z[2 * e + 1] / (1.f + __expf(-z[2 * e + 1])));
      r[e] = pack2(a, bq);
    }
    *(u32x4*)p = r;
  }
}

__device__ __forceinline__ void xattn_phase(const Params& P, int bid, int nblk) {
  const int tidx = otid();
  const int tid = tidx, lane = tid & 63, wv = tid >> 6, lr = lane & 15, g = lane >> 4;
  const u16* qx = (const u16*)(P.ws + OFF_QX); const u16* kx = (const u16*)(P.ws + OFF_KX); const u16* vtx = (const u16*)(P.ws + OFF_VTX);
  u16* ox = (u16*)(P.ws + OFF_OX);
  for (int u = bid * 8 + wv; u < 2048 * 4; u += nblk * 8) {
    const int qt = u >> 2, hh = u & 3, t0 = qt * 16, b = t0 >> 13;
    bf16x8 bq[4];
#pragma unroll
    for (int ks = 0; ks < 4; ++ks) bq[ks] = *(const bf16x8*)(qx + (long)(t0 + lr) * 512 + hh * 128 + ks * 32 + g * 8);
    f32x4 S[16];
    float mx = -3.0e38f;
#pragma unroll
    for (int m = 0; m < 16; ++m) {
      f32x4 d = (f32x4){0.f, 0.f, 0.f, 0.f};
#pragma unroll
      for (int ks = 0; ks < 4; ++ks) { const bf16x8 a = *(const bf16x8*)(kx + (long)(b * 256 + m * 16 + lr) * 512 + hh * 128 + ks * 32 + g * 8); d = mfma16(a, bq[ks], d); }
      S[m] = d;
#pragma unroll
      for (int r = 0; r < 4; ++r) mx = fmaxf(mx, d[r]);
    }
    mx = fmaxf(mx, __shfl_xor(mx, 16)); mx = fmaxf(mx, __shfl_xor(mx, 32));
    float sum = 0.f;
#pragma unroll
    for (int m = 0; m < 16; ++m)
#pragma unroll
      for (int r = 0; r < 4; ++r) { S[m][r] = __expf(S[m][r] - mx); sum += S[m][r]; }
    sum += __shfl_xor(sum, 16); sum += __shfl_xor(sum, 32);
    const float inv = 1.f / sum;
    bf16x8 pb[8];
#pragma unroll
    for (int s = 0; s < 8; ++s)
#pragma unroll
      for (int j = 0; j < 8; ++j) pb[s][j] = (short)f2bf(S[2 * s + (j >> 2)][j & 3]);
#pragma unroll
    for (int dt = 0; dt < 8; ++dt) {
      f32x4 o = (f32x4){0.f, 0.f, 0.f, 0.f};
      const u16* vrow = vtx + ((long)b * 512 + hh * 128 + dt * 16 + lr) * 256;
#pragma unroll
      for (int s = 0; s < 8; ++s) {
        const u32x2 v0 = *(const u32x2*)(vrow + s * 32 + g * 4);
        const u32x2 v1 = *(const u32x2*)(vrow + s * 32 + 16 + g * 4);
        bf16x8 a; u32x4 tmp; tmp[0] = v0[0]; tmp[1] = v0[1]; tmp[2] = v1[0]; tmp[3] = v1[1]; a = __builtin_bit_cast(bf16x8, tmp);
        o = mfma16(a, pb[s], o);
      }
      u32x2 w; w[0] = pack2(o[0] * inv, o[1] * inv); w[1] = pack2(o[2] * inv, o[3] * inv);
      *(u32x2*)(ox + (long)(t0 + lr) * 512 + hh * 128 + dt * 16 + g * 4) = w;
    }
  }
}

__device__ __forceinline__ void g6_phase(const Params& P, char* smem, int bid, int nblk) {
  const int tidx = otid();
  const u16* A = (const u16*)(P.ws + OFF_H); const u16* Bt = (const u16*)(P.ws + OFF_WEFFT);
  unsigned* plist = (unsigned*)(P.ws + OFF_PLIST);
  const int tid = tidx;
  for (int t = bid; t < 128 * 16; t += nblk) {
    const int mp = t >> 4, np = t & 15;
    gemm_tile<133>(A + (long)mp * 256 * DM, DM, Bt + (long)np * 128 * DM, DM, DM, smem);
    const float* sC = (const float*)smem;
    const int row = tid >> 1, half = tid & 1;
    unsigned tk[16];
#pragma unroll
    for (int i = 0; i < 16; ++i) tk[i] = 0u;
    for (int i = 0; i < 64; ++i) {
      const int c = half * 64 + ((i + half * 16) & 63);
      const unsigned key = (fkey(sC[row * 133 + c]) & ~127u) | (unsigned)(127 - c);
#pragma unroll
      for (int s = 15; s >= 1; --s) tk[s] = umed3(tk[s - 1], tk[s], key);
      tk[0] = tk[0] > key ? tk[0] : key;
    }
#pragma unroll
    for (int i = 0; i < 16; ++i) {
      const unsigned key = __shfl_xor(tk[i], 1);
      if (half == 0) {
#pragma unroll
        for (int s = 15; s >= 1; --s) tk[s] = umed3(tk[s - 1], tk[s], key);
        tk[0] = tk[0] > key ? tk[0] : key;
      }
    }
    if (half == 0) {
      unsigned* dst = plist + ((long)(mp * 256 + row) * 16 + np) * 16;
#pragma unroll
      for (int i = 0; i < 4; ++i) { u32x4 o; o[0] = tk[4 * i]; o[1] = tk[4 * i + 1]; o[2] = tk[4 * i + 2]; o[3] = tk[4 * i + 3]; *(u32x4*)(dst + 4 * i) = o; }
    }
  }
}

__device__ __forceinline__ void peer_phase(const Params& P, char* smem, int bid, int nblk) {
  const int tidx = otid();
  const int tid = tidx, lane = tid & 63, wv = tid >> 6;
  const unsigned* plist = (const unsigned*)(P.ws + OFF_PLIST);
  const u16* h3 = (const u16*)(P.ws + OFF_H);
  const unsigned char* ue = (const unsigned char*)(P.ws + OFF_UEMB); const unsigned char* ve = (const unsigned char*)(P.ws + OFF_VEMB);
  const float* uscl = (const float*)(P.ws + OFF_USCL); const float* vscl = (const float*)(P.ws + OFF_VSCL);
  unsigned* skeys = (unsigned*)smem + wv * 256;
  unsigned* sidx = (unsigned*)(smem + 8192) + wv * 128;
  float* sgate = (float*)(smem + 12288) + wv * 128;
  for (int t = bid * 8 + wv; t < T_TOK; t += nblk * 8) {
    __builtin_amdgcn_wave_barrier();
    *(u32x4*)(skeys + lane * 4) = *(const u32x4*)(plist + (long)t * 256 + lane * 4);
    __builtin_amdgcn_wave_barrier();
    if (lane < 8) {
      const unsigned* k1 = skeys + lane * 32; const unsigned* k2 = k1 + 16;
      float s1[16], s2[16];
#pragma unroll
      for (int i = 0; i < 16; ++i) { s1[i] = keyf(k1[i] & ~127u); s2[i] = keyf(k2[i] & ~127u); }
      unsigned tk[16];
#pragma unroll
      for (int i = 0; i < 16; ++i) tk[i] = 0u;
#pragma unroll
      for (int i = 0; i < 16; ++i)
#pragma unroll
        for (int j = 0; j < 16; ++j)
          if ((i + 1) * (j + 1) <= 16) {
            const unsigned key = (fkey(s1[i] + s2[j]) & ~255u) | (unsigned)(255 - (i * 16 + j));
#pragma unroll
            for (int s = 15; s >= 1; --s) tk[s] = umed3(tk[s - 1], tk[s], key);
            tk[0] = tk[0] > key ? tk[0] : key;
          }
      float best[16]; float mx = -3.0e38f;
#pragma unroll
      for (int k = 0; k < 16; ++k) {
        const int cid = 255 - (int)(tk[k] & 255u); const int i = cid >> 4, j = cid & 15;
        const unsigned ka = k1[i], kb2 = k2[j];
        best[k] = keyf(ka & ~127u) + keyf(kb2 & ~127u);
        sidx[lane * 16 + k] = (unsigned)((127 - (int)(ka & 127u)) * 128 + (127 - (int)(kb2 & 127u)));
        mx = fmaxf(mx, best[k]);
      }
      float sm = 0.f;
#pragma unroll
      for (int k = 0; k < 16; ++k) { best[k] = __expf(best[k] - mx); sm += best[k]; }
      const float inv = 1.f / sm;
#pragma unroll
      for (int k = 0; k < 16; ++k) sgate[lane * 16 + k] = best[k] * inv;
    }
    __builtin_amdgcn_wave_barrier();
    float xa[16];
    {
      const u32x4 v0 = *(const u32x4*)(h3 + (long)t * DM + lane * 16), v1 = *(const u32x4*)(h3 + (long)t * DM + lane * 16 + 8);
#pragma unroll
      for (int e = 0; e < 4; ++e) { xa[2 * e] = lo2f(v0[e]); xa[2 * e + 1] = hi2f(v0[e]); xa[8 + 2 * e] = lo2f(v1[e]); xa[8 + 2 * e + 1] = hi2f(v1[e]); }
    }
    float acc[16];
#pragma unroll
    for (int e = 0; e < 16; ++e) acc[e] = 0.f;
    const int myk = ((lane >> 5) & 1) * 8 + ((lane >> 4) & 1) * 4 + ((lane >> 3) & 1) * 2 + ((lane >> 2) & 1);
    for (int bt = 0; bt < 8; ++bt) {
      u32x4 uu[16], vv[16];
#pragma unroll
      for (int k = 0; k < 16; ++k) {
        const long e = (long)sidx[bt * 16 + k];
        uu[k] = *(const u32x4*)(ue + e * DM + lane * 16);
        vv[k] = *(const u32x4*)(ve + e * DM + lane * 16);
      }
      const unsigned emy = sidx[bt * 16 + myk];
      const float su = uscl[emy], sv = vscl[emy];
      float pd[16];
#pragma unroll
      for (int k = 0; k < 16; ++k) {
        float s = 0.f;
#pragma unroll
        for (int e = 0; e < 4; ++e) {
          const f32x2 lo = __builtin_amdgcn_cvt_pk_f32_fp8((int)uu[k][e], false), hi = __builtin_amdgcn_cvt_pk_f32_fp8((int)uu[k][e], true);
          s = fmaf(lo[0], xa[4 * e], s); s = fmaf(lo[1], xa[4 * e + 1], s); s = fmaf(hi[0], xa[4 * e + 2], s); s = fmaf(hi[1], xa[4 * e + 3], s);
        }
        pd[k] = s;
      }
      float r8[8], r4[4], r2[2], r1;
      {
        const bool u5 = (lane & 32) != 0, u4 = (lane & 16) != 0, u3 = (lane & 8) != 0, u2 = (lane & 4) != 0;
#pragma unroll
        for (int k = 0; k < 8; ++k) { const float mine = u5 ? pd[k + 8] : pd[k]; const float oth = u5 ? pd[k] : pd[k + 8]; r8[k] = mine + __shfl_xor(oth, 32); }
#pragma unroll
        for (int k = 0; k < 4; ++k) { const float mine = u4 ? r8[k + 4] : r8[k]; const float oth = u4 ? r8[k] : r8[k + 4]; r4[k] = mine + __shfl_xor(oth, 16); }
#pragma unroll
        for (int k = 0; k < 2; ++k) { const float mine = u3 ? r4[k + 2] : r4[k]; const float oth = u3 ? r4[k] : r4[k + 2]; r2[k] = mine + __shfl_xor(oth, 8); }
        { const float mine = u2 ? r2[1] : r2[0]; const float oth = u2 ? r2[0] : r2[1]; r1 = mine + __shfl_xor(oth, 4); }
        r1 += __shfl_xor(r1, 2); r1 += __shfl_xor(r1, 1);
      }
      const float dot = r1 * su;
      const float act = 0.5f * dot * (1.f + erff(dot * 0.7071067811865475f));
      const float coef = sgate[bt * 16 + myk] * act * sv;
#pragma unroll
      for (int k = 0; k < 16; ++k) {
        const int srcl = ((k >> 3) & 1) * 32 + ((k >> 2) & 1) * 16 + ((k >> 1) & 1) * 8 + (k & 1) * 4;
        const float ck = __shfl(coef, srcl);
#pragma unroll
        for (int e = 0; e < 4; ++e) {
          const f32x2 lo = __builtin_amdgcn_cvt_pk_f32_fp8((int)vv[k][e], false), hi = __builtin_amdgcn_cvt_pk_f32_fp8((int)vv[k][e], true);
          acc[4 * e] = fmaf(ck, lo[0], acc[4 * e]); acc[4 * e + 1] = fmaf(ck, lo[1], acc[4 * e + 1]);
          acc[4 * e + 2] = fmaf(ck, hi[0], acc[4 * e + 2]); acc[4 * e + 3] = fmaf(ck, hi[1], acc[4 * e + 3]);
        }
      }
    }
    float* orow = P.out + (long)t * DM + lane * 16;
    float xr[16]; float ss = 0.f;
#pragma unroll
    for (int q = 0; q < 4; ++q) {
      const float4 v = *(const float4*)(orow + q * 4);
      xr[q * 4 + 0] = v.x + acc[q * 4 + 0]; xr[q * 4 + 1] = v.y + acc[q * 4 + 1]; xr[q * 4 + 2] = v.z + acc[q * 4 + 2]; xr[q * 4 + 3] = v.w + acc[q * 4 + 3];
    }
#pragma unroll
    for (int e = 0; e < 16; ++e) ss += xr[e] * xr[e];
    ss = wave_sum(ss);
    const float rs = rsqrtf(ss * (1.f / DM) + EPSV);
#pragma unroll
    for (int q = 0; q < 4; ++q) {
      const float4 gf = *(const float4*)(P.g_final + lane * 16 + q * 4);
      float4 o; o.x = xr[q * 4 + 0] * rs * gf.x; o.y = xr[q * 4 + 1] * rs * gf.y; o.z = xr[q * 4 + 2] * rs * gf.z; o.w = xr[q * 4 + 3] * rs * gf.w;
      *(float4*)(orow + q * 4) = o;
    }
  }
}

#define XB_TMO      128
#define XB_XCNT(j)  (256  + 64 * (j))
#define XB_XSUB(j)  (1280 + 64 * (j))
#define XB_XGEN(j)  (2304 + 64 * (j))
#define XB_TOP      3328
#define XB_TOPGEN   3392
#define XCD_BAR_WORDS 3456
#define XB_SPIN_CAP (1u << 18)

__device__ __forceinline__ unsigned xb_ld(unsigned* p)              { return __hip_atomic_load(p, __ATOMIC_RELAXED, __HIP_MEMORY_SCOPE_AGENT); }
__device__ __forceinline__ unsigned xb_add(unsigned* p, unsigned v) { return __hip_atomic_fetch_add(p, v, __ATOMIC_RELAXED, __HIP_MEMORY_SCOPE_AGENT); }
__device__ __forceinline__ unsigned xb_xcc_id() { return (unsigned)__builtin_amdgcn_s_getreg((3 << 11) | 20) & 0xFu; }
#define XB_SPIN(cond, bar) do { unsigned _sp = 0; while (cond) { __builtin_amdgcn_s_sleep(1); \
    if ((++_sp & 255u) == 0u) { if (xb_ld(&(bar)[XB_TMO])) break; if (_sp > XB_SPIN_CAP) { atomicAdd(&(bar)[XB_TMO], 1u); break; } } } } while (0)

struct XcdBarrier {
    unsigned* bar; unsigned x;
    volatile LAS unsigned* st;
};

__device__ __forceinline__ XcdBarrier xcd_barrier_post(unsigned* bar, volatile LAS unsigned* st) {
    XcdBarrier b; b.bar = bar; b.x = xb_xcc_id(); b.st = st;
    if (threadIdx.x == 0) (void)xb_add(&bar[XB_XCNT(b.x)], 1u);
    return b;
}
__device__ __forceinline__ void xcd_barrier_complete(unsigned* bar, unsigned x, unsigned& nloc, unsigned& nx) {
    const unsigned G = gridDim.x * gridDim.y * gridDim.z;
    unsigned sum, cnt, mine, sp = 0u;
    for (;;) {
        sum = 0u; cnt = 0u; mine = 0u;
#pragma unroll
        for (unsigned j = 0; j < 16; ++j) { const unsigned c = xb_ld(&bar[XB_XCNT(j)]); sum += c; cnt += (c > 0u) ? 1u : 0u; mine = (j == x) ? c : mine; }
        if (sum == G) break;
        __builtin_amdgcn_s_sleep(1);
        if ((++sp & 255u) == 0u) { if (xb_ld(&bar[XB_TMO])) break; if (sp > XB_SPIN_CAP) { atomicAdd(&bar[XB_TMO], 1u); break; } }
    }
    nloc = mine > 0u ? mine : 1u; nx = cnt > 0u ? cnt : 1u;
}

__device__ __forceinline__ void xcd_barrier(const XcdBarrier& b) {
    asm volatile("s_waitcnt vmcnt(0)" ::: "memory");
    __syncthreads();
    if (threadIdx.x == 0) {
        unsigned* bar = b.bar;
        __builtin_amdgcn_s_waitcnt(0);
        unsigned nloc = b.st[0], nx = b.st[1];
        if (nloc == 0u) { xcd_barrier_complete(bar, b.x, nloc, nx); b.st[0] = nloc; b.st[1] = nx; }
        const unsigned old = xb_add(&bar[XB_XSUB(b.x)], 1u);
        const unsigned gen = old / nloc;
        if (old + 1u == (gen + 1u) * nloc) {
            __builtin_amdgcn_fence(__ATOMIC_RELEASE, "agent");
            asm volatile("s_waitcnt vmcnt(0)" ::: "memory");
            const unsigned og = xb_add(&bar[XB_TOP], 1u);
            const unsigned tg = og / nx;
            if (og + 1u == (tg + 1u) * nx) xb_add(&bar[XB_TOPGEN], 1u);
            else XB_SPIN(xb_ld(&bar[XB_TOPGEN]) == tg, bar);
            __builtin_amdgcn_fence(__ATOMIC_ACQUIRE, "agent");
            xb_add(&bar[XB_XGEN(b.x)], 1u);
            asm volatile("s_waitcnt vmcnt(0)" ::: "memory");
        } else {
            XB_SPIN(xb_ld(&bar[XB_XGEN(b.x)]) == gen, bar);
            __builtin_amdgcn_fence(__ATOMIC_ACQUIRE, "agent");
            asm volatile("s_waitcnt vmcnt(0)" ::: "memory");
        }
    }
    __syncthreads();
}

__device__ __forceinline__ GemmP mk_gemm(const u16* A, long lda, long a_bs, const u16* Bt, long ldb, long b_bs, u16* C, long ldc, long c_bs, int M, int N, int K, int nbatch, float scale, int ncols, int tstore) {
  GemmP g; g.A = A; g.lda = lda; g.a_bs = a_bs; g.Bt = Bt; g.ldb = ldb; g.b_bs = b_bs; g.C = C; g.ldc = ldc; g.c_bs = c_bs; g.M = M; g.N = N; g.K = K; g.nbatch = nbatch; g.scale = scale; g.ncols = ncols; g.tstore = tstore;
  return g;
}
#define QCTR_WORD (XCD_BAR_WORDS + 64)

__global__ void __launch_bounds__(NTHR, 2) mega(Params P, CvtJobs J1, CvtJobs J2) {
  extern __shared__ __attribute__((aligned(16))) char smem[];
  const int bid = blockIdx.x, nblk = gridDim.x, rbid = nblk - 1 - bid;
  char* ws = P.ws;
  unsigned* barw = (unsigned*)(ws + OFF_BAR);
  if (threadIdx.x == 0) *(uint4*)(smem + LDS_XB) = make_uint4(0u, 0u, 0u, 0u);
  __syncthreads();
  (void)xcd_barrier_post(barw, (volatile LAS unsigned*)(smem + LDS_XB));
#define GRID_SYNC() do { XcdBarrier bar_; bar_.bar = (unsigned*)(P.ws + OFF_BAR); bar_.x = xb_xcc_id(); bar_.st = (volatile LAS unsigned*)(smem + LDS_XB); xcd_barrier(bar_); } while (0)

  cvt_run(J1, smem, bid, nblk);
  rmsnorm_rows(P.x, P.g_mix, (u16*)(ws + OFF_H), T_TOK, bid, nblk);
  rmsnorm_rows(P.mem, P.g_mem, (u16*)(ws + OFF_MEMN), 1024, rbid, nblk);
  GRID_SYNC();

  {
    const GemmP g = mk_gemm((u16*)(ws + OFF_WUK), 512, 64, (u16*)(ws + OFF_WUQ), 512, 64, (u16*)(ws + OFF_WG2T) + 512l * 256, 256, 256l * 256, 256, 256, 64, 8, 0.125f, 128, 0);
    gemm_bf16_phase(g, smem, rbid, nblk);
  }
  {
    const GemmP g = mk_gemm((u16*)(ws + OFF_WPQ), 2048, 128, (u16*)(ws + OFF_SUBK), 128, 128l * 128, (u16*)(ws + OFF_WEFFT), 1024, 128l * 1024, 1024, 128, 128, 16, 1.f, 128, 1);
    gemm_bf16_phase(g, smem, rbid - 16 < 0 ? rbid - 16 + nblk : rbid - 16, nblk);
  }
  {
    const GemmP g = mk_gemm((u16*)(ws + OFF_MEMN), 1024, 0, (u16*)(ws + OFF_WKT), 1024, 0, (u16*)(ws + OFF_KX), 512, 0, 1024, 512, 1024, 1, 1.f, 128, 0);
    gemm_bf16_phase(g, smem, rbid - 80 < 0 ? rbid - 80 + nblk : rbid - 80, nblk);
  }
  {
    const GemmP g = mk_gemm((u16*)(ws + OFF_WVT), 1024, 0, (u16*)(ws + OFF_MEMN), 1024, 256l * 1024, (u16*)(ws + OFF_VTX), 256, 512l * 256, 512, 256, 1024, 4, 1.f, 128, 0);
    gemm_bf16_phase(g, smem, rbid - 96 < 0 ? rbid - 96 + nblk : rbid - 96, nblk);
  }
  g1_phase(P, smem, bid, nblk);
  GRID_SYNC();

  dsa_prep_phase(P, bid, nblk);
  dn_prep_phase(P, bid, nblk);
  GRID_SYNC();

  dn_intra_phase(P, smem, bid, nblk);
  g2_phase(P, smem, bid, nblk);
  GRID_SYNC();

  if (bid < 16) dn_scan_phase(P, smem, bid, 16);
  dsa_queue_phase(P, smem, bid, (unsigned*)(P.ws + OFF_BAR) + QCTR_WORD);
  GRID_SYNC();

  dn_gate_phase(P, bid, nblk);
  {
    const GemmP g = mk_gemm((u16*)P.out, 2048, 256, (u16*)(ws + OFF_WUVT), 256, 128l * 256, (u16*)(ws + OFF_MIX), 1024, 64, T_TOK, 128, 256, 8, 1.f, 64, 0);
    gemm_bf16_phase(g, smem, bid, nblk);
  }
  cvt_fp8_rows(P.u_emb, (unsigned char*)(ws + OFF_UEMB), (float*)(ws + OFF_USCL), 16384, bid, nblk);
  cvt_fp8_rows(P.v_emb, (unsigned char*)(ws + OFF_VEMB), (float*)(ws + OFF_VSCL), 16384, bid, nblk);
  GRID_SYNC();

  {
    GemmR g; g.A = (u16*)(ws + OFF_MIX); g.lda = 1024; g.Bt = (u16*)(ws + OFF_WOUTT); g.ldb = 1024; g.R = P.x; g.C = P.out; g.K = 1024;
    gemm_resid_phase(g, smem, bid, nblk);
  }
  GRID_SYNC();
  rmsnorm_rows(P.out, P.g_cross, (u16*)(ws + OFF_H), T_TOK, bid, nblk);
  GRID_SYNC();
  {
    const GemmP g = mk_gemm((u16*)(ws + OFF_H), 1024, 0, (u16*)(ws + OFF_WQT), 1024, 0, (u16*)(ws + OFF_QX), 512, 0, T_TOK, 512, 1024, 1, 1.f, 128, 0);
    gemm_bf16_phase(g, smem, bid, nblk);
  }
  GRID_SYNC();
  xattn_phase(P, bid, nblk);
  GRID_SYNC();
  {
    GemmR g; g.A = (u16*)(ws + OFF_OX); g.lda = 512; g.Bt = (u16*)(ws + OFF_WOT); g.ldb = 512; g.R = P.out; g.C = P.out; g.K = 512;
    gemm_resid_phase(g, smem, bid, nblk);
  }
  GRID_SYNC();
  rmsnorm_rows(P.out, P.g_ffn, (u16*)(ws + OFF_H), T_TOK, bid, nblk);
  GRID_SYNC();
  g6_phase(P, smem, bid, nblk);
  GRID_SYNC();
  peer_phase(P, smem, bid, nblk);
}

static void add_job(CvtJobs& J, const float* src, u16* dst, int R, int C, long sld, long dld, float scale, int tr) {
  CvtJob& j = J.j[J.n++]; j.src = src; j.dst = dst; j.R = R; j.C = C; j.sld = sld; j.dld = dld; j.scale = scale; j.transpose = tr;
}

extern "C" void kernel_launch(void* const* d_in, const int* in_sizes, int n_in, void* d_out, int out_size, void* d_ws, size_t ws_size, hipStream_t stream) {
  if (ws_size < WS_NEED) { fprintf(stderr, "workspace too small: %zu < %llu\n", ws_size, (unsigned long long)WS_NEED); return; }
  Params P; memset(&P, 0, sizeof(P));
  const float** pp = (const float**)&P;
  for (int i = 0; i < 29; ++i) pp[i] = (const float*)d_in[i];
  P.out = (float*)d_out; P.ws = (char*)d_ws;
  char* ws = (char*)d_ws;
  static int grid = 0;
  if (!grid) {
    int dev = 0, cus = 0, per_cu = 0;
    (void)hipGetDevice(&dev);
    (void)hipDeviceGetAttribute(&cus, hipDeviceAttributeMultiprocessorCount, dev);
    (void)hipFuncSetAttribute((const void*)mega, hipFuncAttributeMaxDynamicSharedMemorySize, LDS_TOTAL);
    (void)hipOccupancyMaxActiveBlocksPerMultiprocessor(&per_cu, (const void*)mega, NTHR, LDS_TOTAL);
    grid = cus * (per_cu < 1 ? per_cu : 1);
    if (grid <= 0) { fprintf(stderr, "mega kernel not launchable (cus %d, per_cu %d)\n", cus, per_cu); grid = 0; return; }
  }
  (void)hipMemsetAsync(ws + OFF_BAR, 0, 16384, stream);
  (void)hipMemsetAsync(ws + OFF_WINT, 0, 2688ull * 1024 * 2, stream);
  (void)hipMemsetAsync(ws + OFF_WUVT, 0, 8ull * 128 * 256 * 2, stream);
  CvtJobs J1; memset(&J1, 0, sizeof(J1));
  CvtJobs J2; memset(&J2, 0, sizeof(J2));
  {
    u16* winT = (u16*)(ws + OFF_WINT);
    add_job(J1, P.w_in, winT, 1024, 584, 2640, 1024, 1.f, 1);
    add_job(J1, P.w_in + 2632, winT + 584l * 1024, 1024, 8, 2640, 1024, 1.f, 1);
    add_job(J1, P.w_in + 584, winT + 640l * 1024, 1024, 1536, 2640, 1024, 1.f, 1);
    add_job(J1, P.w_in + 2120, winT + 2176l * 1024, 1024, 512, 2640, 1024, 1.f, 1);
    add_job(J1, P.w_iq, (u16*)(ws + OFF_WG2T), 256, 512, 512, 256, 1.f, 1);
    add_job(J1, P.w_uq, (u16*)(ws + OFF_WUQ), 256, 512, 512, 512, 1.f, 0);
    add_job(J1, P.w_uk, (u16*)(ws + OFF_WUK), 256, 512, 512, 512, 1.f, 0);
    for (int h = 0; h < 8; ++h) add_job(J1, P.w_uv + h * 64, (u16*)(ws + OFF_WUVT) + h * 128l * 256, 256, 64, 512, 256, 1.f, 1);
    add_job(J1, P.w_out, (u16*)(ws + OFF_WOUTT), 1024, 1024, 1024, 1024, 1.f, 1);
    add_job(J1, P.wq_x, (u16*)(ws + OFF_WQT), 1024, 512, 512, 1024, 0.08838834764831845f, 1);
    add_job(J1, P.wk_x, (u16*)(ws + OFF_WKT), 1024, 512, 512, 1024, 1.f, 1);
    add_job(J1, P.wv_x, (u16*)(ws + OFF_WVT), 1024, 512, 512, 1024, 1.f, 1);
    add_job(J1, P.wo_x, (u16*)(ws + OFF_WOT), 512, 1024, 1024, 512, 1.f, 1);
    add_job(J1, P.w_pq, (u16*)(ws + OFF_WPQ), 1024, 2048, 2048, 2048, 1.f, 0);
    add_job(J1, P.sub_keys, (u16*)(ws + OFF_SUBK), 2048, 128, 128, 128, 1.f, 0);
    add_job(J2, P.u_emb, (u16*)(ws + OFF_UEMB), 16384, 1024, 1024, 1024, 1.f, 0);
    add_job(J2, P.v_emb, (u16*)(ws + OFF_VEMB), 16384, 1024, 1024, 1024, 1.f, 0);
  }
  hipLaunchKernelGGL(mega, dim3(grid), dim3(NTHR), LDS_TOTAL, stream, P, J1, J2);
}
```

```cpp
#include <hip/hip_runtime.h>
#include <stdint.h>
#include <stdio.h>
#include <string.h>

typedef unsigned short u16;
typedef __attribute__((ext_vector_type(8))) short bf16x8;
typedef __attribute__((ext_vector_type(4))) short s16x4;
typedef __attribute__((ext_vector_type(4))) float f32x4;
typedef __attribute__((ext_vector_type(4))) unsigned u32x4;
typedef __attribute__((ext_vector_type(2))) unsigned u32x2;
typedef __attribute__((ext_vector_type(2))) float f32x2;
#define LAS __attribute__((address_space(3)))

#define T_TOK 32768
#define SEQ 8192
#define NB 4
#define DM 1024
#define NTHR 512
#define EPSV 1e-6f

__device__ __forceinline__ u16 f2bf(float f) { __bf16 b = (__bf16)f; return __builtin_bit_cast(u16, b); }
__device__ __forceinline__ float bf2f(u16 h) { return __uint_as_float(((unsigned)h) << 16); }
__device__ __forceinline__ unsigned pack2(float a, float b) { return (unsigned)f2bf(a) | ((unsigned)f2bf(b) << 16); }
__device__ __forceinline__ float lo2f(unsigned v) { return __uint_as_float(v << 16); }
__device__ __forceinline__ float hi2f(unsigned v) { return __uint_as_float(v & 0xffff0000u); }
__device__ __forceinline__ int otid() { int t = threadIdx.x; asm volatile("" : "+v"(t)); return t; }
__device__ __forceinline__ int lane_id() { return (int)__builtin_amdgcn_mbcnt_hi(~0u, __builtin_amdgcn_mbcnt_lo(~0u, 0u)); }
template <class T> __device__ __forceinline__ T sx(T v, int m) { return __builtin_bit_cast(T, __builtin_amdgcn_ds_bpermute((lane_id() ^ m) << 2, __builtin_bit_cast(int, v))); }
template <class T> __device__ __forceinline__ T sh(T v, int src) { return __builtin_bit_cast(T, __builtin_amdgcn_ds_bpermute(src << 2, __builtin_bit_cast(int, v))); }
template <class T> __device__ __forceinline__ T su(T v, int d) { const int l = lane_id(); const int src = l - d < 0 ? l : l - d; return __builtin_bit_cast(T, __builtin_amdgcn_ds_bpermute(src << 2, __builtin_bit_cast(int, v))); }
__device__ __forceinline__ float wave_sum(float v) {
#pragma unroll
  for (int o = 32; o >= 1; o >>= 1) v += sx(v, o);
  return v;
}
template <int CTRL> __device__ __forceinline__ float dpp_f(float v) { return __int_as_float(__builtin_amdgcn_update_dpp(0, __float_as_int(v), CTRL, 0xf, 0xf, true)); }
__device__ __forceinline__ float wave_max_u(float v) {
  v = fmaxf(v, dpp_f<0xB1>(v)); v = fmaxf(v, dpp_f<0x4E>(v)); v = fmaxf(v, dpp_f<0x141>(v)); v = fmaxf(v, dpp_f<0x140>(v));
  const int vi = __float_as_int(v);
  const float a = __int_as_float(__builtin_amdgcn_readlane(vi, 0)), b = __int_as_float(__builtin_amdgcn_readlane(vi, 16));
  const float c = __int_as_float(__builtin_amdgcn_readlane(vi, 32)), d = __int_as_float(__builtin_amdgcn_readlane(vi, 48));
  return fmaxf(fmaxf(a, b), fmaxf(c, d));
}
__device__ __forceinline__ float wave_min_u(float v) { return -wave_max_u(-v); }
__device__ __forceinline__ float relu_raw(float x) { return __builtin_amdgcn_fmed3f(x, 0.f, 3.0e38f); }
__device__ __forceinline__ f32x4 mfma16(bf16x8 a, bf16x8 b, f32x4 c) { return __builtin_amdgcn_mfma_f32_16x16x32_bf16(a, b, c, 0, 0, 0); }
__device__ __forceinline__ unsigned umed3(unsigned a, unsigned b, unsigned c) { unsigned r; asm("v_med3_u32 %0, %1, %2, %3" : "=v"(r) : "v"(a), "v"(b), "v"(c)); return r; }
__device__ __forceinline__ unsigned fkey(float f) { unsigned u = __float_as_uint(f); return u ^ ((u >> 31) ? 0xffffffffu : 0x80000000u); }
__device__ __forceinline__ float keyf(unsigned m) { unsigned u = (m & 0x80000000u) ? (m ^ 0x80000000u) : ~m; return __uint_as_float(u); }

#define MB (1024ull * 1024ull)
#define OFF_BAR      0ull
#define OFF_WINT     (1 * MB)
#define OFF_WG2T     (7 * MB)
#define OFF_WUQ      (9 * MB)
#define OFF_WUK      (9 * MB + 512 * 1024)
#define OFF_WUVT     (10 * MB)
#define OFF_WOUTT    (11 * MB)
#define OFF_WQT      (13 * MB)
#define OFF_WKT      (14 * MB)
#define OFF_WVT      (15 * MB)
#define OFF_WOT      (16 * MB)
#define OFF_WPQ      (17 * MB)
#define OFF_SUBK     (21 * MB)
#define OFF_WEFFT    (22 * MB)
#define OFF_MEMN     (26 * MB)
#define OFF_KX       (28 * MB)
#define OFF_VTX      (29 * MB)
#define OFF_KIDXN    (30 * MB)
#define OFF_WIDX     (34 * MB)
#define OFF_GB       (35 * MB)
#define OFF_SSQ1     (36 * MB + 256 * 1024)
#define OFF_SSQ2     (36 * MB + 512 * 1024)
#define OFF_INTRA    (37 * MB)
#define OFF_WDN      (53 * MB)
#define OFF_SEL      (85 * MB)
#define OFF_H        (101 * MB)
#define OFF_QI       (OFF_H)
#define OFF_CQN      (OFF_H + 32 * MB)
#define OFF_CKVN     (OFF_H + 48 * MB)
#define OFF_PA       (165 * MB)
#define OFF_PB       (213 * MB)
#define OFF_SCORES   (OFF_PA)
#define OFF_UEMB     (OFF_PA)
#define OFF_VEMB     (OFF_PA + 16 * MB)
#define OFF_USCL     (OFF_PA + 32 * MB)
#define OFF_VSCL     (OFF_PA + 33 * MB)
#define OFF_PSC      (OFF_PB)
#define OFF_BZ       (309 * MB)
#define OFF_QKV      (341 * MB)
#define OFF_QX       (OFF_QKV)
#define OFF_OX       (OFF_QKV + 32 * MB)
#define OFF_PEIDX    (OFF_QKV)
#define OFF_PGATE    (OFF_QKV + 8 * MB)
#define OFF_PLIST    (OFF_QKV + 64 * MB)
#define OFF_MIX      (437 * MB)
#define WS_NEED      (501 * MB)

struct CvtJob { const float* src; u16* dst; const float* rowscale; int R, C; long sld, dld; float scale; int transpose; };
#define MAXJOBS 24
struct CvtJobs { CvtJob j[MAXJOBS]; int n; int pad; };

__device__ __forceinline__ void cvt_run(const CvtJobs& J, char* smem, int bid, int nblk) {
  const int tidx = otid();
  float* tile = (float*)smem;
  for (int ji = 0; ji < J.n; ++ji) {
    const CvtJob jb = J.j[ji];
    if (jb.transpose) continue;
    const long nvec = (long)jb.R * (jb.C >> 2);
    const int cv = jb.C >> 2;
    for (long i = (long)bid * NTHR + tidx; i < nvec; i += (long)nblk * NTHR) {
      const long r = i / cv; const int c = (int)(i - r * cv) * 4;
      const float4 v = *(const float4*)(jb.src + r * jb.sld + c);
      const float sc = jb.rowscale ? jb.scale * jb.rowscale[r] : jb.scale;
      u32x2 o; o[0] = pack2(v.x * sc, v.y * sc); o[1] = pack2(v.z * sc, v.w * sc);
      *(u32x2*)(jb.dst + r * jb.dld + c) = o;
    }
  }
  int total = 0;
  for (int ji = 0; ji < J.n; ++ji) if (J.j[ji].transpose) total += ((J.j[ji].R + 63) >> 6) * ((J.j[ji].C + 63) >> 6);
  for (int tg = bid; tg < total; tg += nblk) {
    int ji = 0, t = tg;
    for (;; ++ji) {
      if (!J.j[ji].transpose) continue;
      const int nt = ((J.j[ji].R + 63) >> 6) * ((J.j[ji].C + 63) >> 6);
      if (t < nt) break;
      t -= nt;
    }
    const CvtJob jb = J.j[ji];
    const int tc = (jb.C + 63) >> 6;
    const int r0 = (t / tc) * 64, c0 = (t % tc) * 64;
    __syncthreads();
    for (int i = tidx; i < 4096; i += NTHR) {
      const int r = i >> 6, c = i & 63;
      float v = 0.f;
      if (r0 + r < jb.R && c0 + c < jb.C) v = jb.src[(long)(r0 + r) * jb.sld + c0 + c];
      tile[r * 65 + c] = v;
    }
    __syncthreads();
    for (int i = tidx; i < 4096; i += NTHR) {
      const int c = i >> 6, r = i & 63;
      if (r0 + r < jb.R && c0 + c < jb.C) jb.dst[(long)(c0 + c) * jb.dld + r0 + r] = f2bf(tile[r * 65 + c] * (jb.rowscale ? jb.scale * jb.rowscale[r0 + r] : jb.scale));
    }
  }
}

__device__ __forceinline__ void cvt_fp8_rows(const float* src, unsigned char* dst, float* scl, int nrows, int bid, int nblk) {
  const int tidx = otid();
  const int lane = tidx & 63, wv = tidx >> 6;
  for (int r = bid * 8 + wv; r < nrows; r += nblk * 8) {
    const float* p = src + (long)r * DM + lane * 16;
    float4 v[4]; float am = 0.f;
#pragma unroll
    for (int i = 0; i < 4; ++i) { v[i] = *(const float4*)(p + i * 4); am = fmaxf(am, fmaxf(fmaxf(fabsf(v[i].x), fabsf(v[i].y)), fmaxf(fabsf(v[i].z), fabsf(v[i].w)))); }
#pragma unroll
    for (int o = 32; o >= 1; o >>= 1) am = fmaxf(am, sx(am, o));
    const float sc = am > 0.f ? am * (1.f / 440.f) : 1.f;
    const float inv = 1.f / sc;
    u32x4 o;
#pragma unroll
    for (int i = 0; i < 4; ++i) {
      int w = 0;
      w = __builtin_amdgcn_cvt_pk_fp8_f32(v[i].x * inv, v[i].y * inv, w, false);
      w = __builtin_amdgcn_cvt_pk_fp8_f32(v[i].z * inv, v[i].w * inv, w, true);
      o[i] = (unsigned)w;
    }
    *(u32x4*)(dst + (long)r * DM + lane * 16) = o;
    if (lane == 0) scl[r] = sc;
  }
}

__device__ __forceinline__ void cvt_fp4_rows(const float* src, const float* colscale, unsigned char* dst, float* scl, int nrows, int bid, int nblk) {
  const int tidx = otid();
  const int lane = tidx & 63, wv = tidx >> 6;
  float4 cs[4];
#pragma unroll
  for (int i = 0; i < 4; ++i) cs[i] = colscale ? *(const float4*)(colscale + lane * 16 + i * 4) : make_float4(1.f, 1.f, 1.f, 1.f);
  for (int r = bid * 8 + wv; r < nrows; r += nblk * 8) {
    const float* p = src + (long)r * DM + lane * 16;
    float4 v[4]; float am = 0.f;
#pragma unroll
    for (int i = 0; i < 4; ++i) { v[i] = *(const float4*)(p + i * 4); v[i].x *= cs[i].x; v[i].y *= cs[i].y; v[i].z *= cs[i].z; v[i].w *= cs[i].w; am = fmaxf(am, fmaxf(fmaxf(fabsf(v[i].x), fabsf(v[i].y)), fmaxf(fabsf(v[i].z), fabsf(v[i].w)))); }
#pragma unroll
    for (int o = 32; o >= 1; o >>= 1) am = fmaxf(am, sx(am, o));
    const float sc = am > 0.f ? am * (1.f / 6.f) : 1.f;
    const float inv = 1.f / sc;
    u32x2 o;
#pragma unroll
    for (int d = 0; d < 2; ++d) {
      unsigned w = 0u;
      w = __builtin_amdgcn_cvt_scalef32_pk_fp4_f32(w, v[2 * d].x * inv, v[2 * d].y * inv, 1.0f, 0);
      w = __builtin_amdgcn_cvt_scalef32_pk_fp4_f32(w, v[2 * d].z * inv, v[2 * d].w * inv, 1.0f, 1);
      w = __builtin_amdgcn_cvt_scalef32_pk_fp4_f32(w, v[2 * d + 1].x * inv, v[2 * d + 1].y * inv, 1.0f, 2);
      w = __builtin_amdgcn_cvt_scalef32_pk_fp4_f32(w, v[2 * d + 1].z * inv, v[2 * d + 1].w * inv, 1.0f, 3);
      o[d] = w;
    }
    *(u32x2*)(dst + (long)r * 512 + lane * 8) = o;
    if (lane == 0) scl[r] = sc;
  }
}

__device__ __forceinline__ void cvt_i4_rows(const float* src, const float* colscale, unsigned char* dst, float* scl, int nrows, int bid, int nblk) {
  const int tidx = otid();
  const int lane = tidx & 63, wv = tidx >> 6;
  float4 cs[4];
#pragma unroll
  for (int i = 0; i < 4; ++i) cs[i] = colscale ? *(const float4*)(colscale + lane * 16 + i * 4) : make_float4(1.f, 1.f, 1.f, 1.f);
  for (int r = bid * 8 + wv; r < nrows; r += nblk * 8) {
    const float* p = src + (long)r * DM + lane * 16;
    float x[16]; float am = 0.f, ss = 0.f;
#pragma unroll
    for (int i = 0; i < 4; ++i) {
      const float4 v = *(const float4*)(p + i * 4);
      x[4 * i] = v.x * cs[i].x; x[4 * i + 1] = v.y * cs[i].y; x[4 * i + 2] = v.z * cs[i].z; x[4 * i + 3] = v.w * cs[i].w;
    }
#pragma unroll
    for (int e = 0; e < 16; ++e) { am = fmaxf(am, fabsf(x[e])); ss += x[e] * x[e]; }
#pragma unroll
    for (int o = 32; o >= 1; o >>= 1) { am = fmaxf(am, sx(am, o)); ss += sx(ss, o); }
    const float lim = fminf(am, 2.6f * sqrtf(ss * (1.f / DM)));
    const float sc = lim > 0.f ? lim * (1.f / 7.f) : 1.f;
    const float inv = 1.f / sc;
    u32x2 o;
#pragma unroll
    for (int d = 0; d < 2; ++d) {
      unsigned w = 0u;
#pragma unroll
      for (int i = 0; i < 8; ++i) {
        float qf = rintf(x[8 * d + i] * inv); qf = fminf(fmaxf(qf, -7.f), 7.f);
        w |= ((unsigned)(int)qf & 15u) << (4 * i);
      }
      o[d] = w;
    }
    *(u32x2*)(dst + (long)r * 512 + lane * 8) = o;
    if (lane == 0) scl[r] = sc;
  }
}

__device__ __forceinline__ void rmsnorm_rows(const float* src, const float* g, u16* dst, int nrows, int bid, int nblk) {
  const int tidx = otid();
  const int lane = tidx & 63, wv = tidx >> 6;
  float4 gg[4];
#pragma unroll
  for (int i = 0; i < 4; ++i) gg[i] = *(const float4*)(g + i * 256 + lane * 4);
  for (int r = (bid * 8 + wv) * 2; r < nrows; r += nblk * 16) {
    float4 v[2][4]; float ss[2] = {0.f, 0.f};
#pragma unroll
    for (int k = 0; k < 2; ++k)
#pragma unroll
      for (int i = 0; i < 4; ++i) v[k][i] = *(const float4*)(src + (long)(r + k) * DM + i * 256 + lane * 4);
#pragma unroll
    for (int k = 0; k < 2; ++k) {
#pragma unroll
      for (int i = 0; i < 4; ++i) ss[k] += v[k][i].x * v[k][i].x + v[k][i].y * v[k][i].y + v[k][i].z * v[k][i].z + v[k][i].w * v[k][i].w;
      ss[k] = wave_sum(ss[k]);
      const float rs = rsqrtf(ss[k] * (1.f / DM) + EPSV);
#pragma unroll
      for (int i = 0; i < 4; ++i) {
        u32x2 o; o[0] = pack2(v[k][i].x * rs * gg[i].x, v[k][i].y * rs * gg[i].y); o[1] = pack2(v[k][i].z * rs * gg[i].z, v[k][i].w * rs * gg[i].w);
        *(u32x2*)(dst + (long)(r + k) * DM + i * 256 + lane * 4) = o;
      }
    }
  }
}

template <int LDC>
__device__ __forceinline__ void gemm_tile(const u16* __restrict__ A, long lda, const u16* __restrict__ Bt, long ldb, int K, char* smem) {
  const int tidx = otid();
  const int tid = tidx, lane = tid & 63, wv = tid >> 6, lr = lane & 15, g = lane >> 4;
  const int wm = wv >> 1, wn = wv & 1;
  f32x4 acc[4][4];
#pragma unroll
  for (int i = 0; i < 4; ++i)
#pragma unroll
    for (int j = 0; j < 4; ++j) acc[i][j] = (f32x4){0.f, 0.f, 0.f, 0.f};
  u32x4 ra[4], rb[2];
  const int nk = K >> 6;
  const int srow = tid >> 3, sch = tid & 7;
  const u16* pa = A + (long)srow * lda + sch * 8;
  const u16* pb = Bt + (long)srow * ldb + sch * 8;
  const unsigned lds_off = (unsigned)(srow * 128 + ((sch ^ (srow & 7)) << 4));
#pragma unroll
  for (int i = 0; i < 4; ++i) ra[i] = *(const u32x4*)(pa + (long)(i * 64) * lda);
#pragma unroll
  for (int i = 0; i < 2; ++i) rb[i] = *(const u32x4*)(pb + (long)(i * 64) * ldb);
  __syncthreads();
#pragma unroll
  for (int i = 0; i < 4; ++i) *(u32x4*)(smem + lds_off + i * 8192) = ra[i];
#pragma unroll
  for (int i = 0; i < 2; ++i) *(u32x4*)(smem + 32768 + lds_off + i * 8192) = rb[i];
  __syncthreads();
  for (int kt = 0; kt < nk; ++kt) {
    const char* sA = smem + (kt & 1) * 49152;
    const char* sB = sA + 32768;
    if (kt + 1 < nk) {
#pragma unroll
      for (int i = 0; i < 4; ++i) ra[i] = *(const u32x4*)(pa + (long)(i * 64) * lda + (kt + 1) * 64);
#pragma unroll
      for (int i = 0; i < 2; ++i) rb[i] = *(const u32x4*)(pb + (long)(i * 64) * ldb + (kt + 1) * 64);
    }
#pragma unroll
    for (int ks = 0; ks < 2; ++ks) {
      bf16x8 a[4], b[4];
#pragma unroll
      for (int mi = 0; mi < 4; ++mi) { const int row = wm * 64 + mi * 16 + lr; a[mi] = *(const bf16x8*)(sA + row * 128 + (((ks * 4 + g) ^ (row & 7)) << 4)); }
#pragma unroll
      for (int ni = 0; ni < 4; ++ni) { const int row = wn * 64 + ni * 16 + lr; b[ni] = *(const bf16x8*)(sB + row * 128 + (((ks * 4 + g) ^ (row & 7)) << 4)); }
#pragma unroll
      for (int mi = 0; mi < 4; ++mi)
#pragma unroll
        for (int ni = 0; ni < 4; ++ni) acc[mi][ni] = mfma16(a[mi], b[ni], acc[mi][ni]);
    }
    if (kt + 1 < nk) {
      char* dA = smem + ((kt + 1) & 1) * 49152;
#pragma unroll
      for (int i = 0; i < 4; ++i) *(u32x4*)(dA + lds_off + i * 8192) = ra[i];
#pragma unroll
      for (int i = 0; i < 2; ++i) *(u32x4*)(dA + 32768 + lds_off + i * 8192) = rb[i];
    }
    __syncthreads();
  }
  float* sC = (float*)smem;
#pragma unroll
  for (int mi = 0; mi < 4; ++mi)
#pragma unroll
    for (int ni = 0; ni < 4; ++ni)
#pragma unroll
      for (int r = 0; r < 4; ++r) sC[(wm * 64 + mi * 16 + g * 4 + r) * LDC + wn * 64 + ni * 16 + lr] = acc[mi][ni][r];
  __syncthreads();
}

__device__ __forceinline__ void epi_store_bf16(const char* smem, u16* C, long ldc, float scale, int ncols) {
  const int tidx = otid();
  const float* sC = (const float*)smem;
  const int cv = ncols >> 2;
  for (int i = tidx; i < 256 * cv; i += NTHR) {
    const int r = i / cv, c = (i - r * cv) * 4;
    const float4 v = *(const float4*)(sC + r * 132 + c);
    u32x2 o; o[0] = pack2(v.x * scale, v.y * scale); o[1] = pack2(v.z * scale, v.w * scale);
    *(u32x2*)(C + (long)r * ldc + c) = o;
  }
}
__device__ __forceinline__ void epi_resid_f32(const char* smem, const float* R, float* C, long ldc) {
  const int tidx = otid();
  const float* sC = (const float*)smem;
  for (int i = tidx; i < 256 * 32; i += NTHR) {
    const int r = i >> 5, c = (i & 31) * 4;
    const float4 v = *(const float4*)(sC + r * 132 + c);
    const float4 x = *(const float4*)(R + (long)r * ldc + c);
    float4 o; o.x = v.x + x.x; o.y = v.y + x.y; o.z = v.z + x.z; o.w = v.w + x.w;
    *(float4*)(C + (long)r * ldc + c) = o;
  }
}

namespace pg8 {
#define PG8_LAS __attribute__((address_space(3)))
typedef unsigned short bf16_t;
typedef short bf16x8 __attribute__((ext_vector_type(8)));
typedef float f32x4 __attribute__((ext_vector_type(4)));
typedef unsigned u32x4 __attribute__((ext_vector_type(4)));
constexpr int BM = 256, BK = 64, HALF = 128, HTB = HALF * BK * 2  , STAGE_BYTES = 8 * HTB, NXCD = 8, WGM = 8;

__host__ __device__ __forceinline__ int lds_byte(int r, int c) { const int st = (r >> 4) * 2 + (c >> 5), rr = r & 15, cc = c & 31, ob = rr * 64 + cc * 2; return st * 1024 + (ob ^ (((ob >> 9) & 1) << 5)); }
__host__ __device__ __forceinline__ void stage_rc(int b, int& R, int& C) { const int st = b / 1024, sb = b % 1024, swz = sb ^ (((sb >> 9) & 1) << 5); R = (st >> 1) * 16 + swz / 64; C = (st & 1) * 32 + (swz % 64) / 2; }
__host__ __device__ __forceinline__ int perm32(int rho) { const int n = rho >> 4, i = rho & 15; return 8 * (i >> 2) + 4 * n + (i & 3); }

struct Unit { int pm, pn; };
struct Gemm { const bf16_t* A; const bf16_t* Bt; int M, N, K; };
struct StaticOrder {
    int nM, nN, nwg, G, c;
    __host__ __device__ void init(int M, int N, int G_, int c_) { nM = M / BM; nN = N / BM; nwg = nM * nN; G = G_; c = c_; }
    __host__ __device__ bool next(int i, Unit& u) const {
        const long L = (long)i * G + c; if (L >= nwg) return false;
        int wgid = (int)L; { const int q = nwg / NXCD, r = nwg % NXCD, xcd = wgid % NXCD, off = wgid / NXCD; wgid = (xcd < r ? xcd * (q + 1) : r * (q + 1) + (xcd - r) * q) + off; }
        const int nig = WGM * nN, gid = wgid / nig, fm = gid * WGM, gsz = (nM - fm) < WGM ? (nM - fm) : WGM;
        u.pm = fm + ((wgid % nig) % gsz); u.pn = (wgid % nig) / gsz; return true;
    }
    __device__ __forceinline__ void a_ready(const Unit&) const {}
    __device__ __forceinline__ void done(const Unit&) const {}
};
__device__ __forceinline__ unsigned cvt_pk_bf16(float lo, float hi) { unsigned r; asm volatile("v_cvt_pk_bf16_f32 %0, %1, %2" : "=v"(r) : "v"(lo), "v"(hi)); return r; }
template <class Epi, class Sched, bool STAMP = false>
__device__ __forceinline__ void gemm_phase(PG8_LAS unsigned char* lds, const Gemm g, const Sched& S, const Epi& E, unsigned long long* stamps) {
    const int tid = otid(), wid = __builtin_amdgcn_readfirstlane(tid >> 6), lane = tid & 63, wr = wid >> 2, wc = wid & 3, fr = lane & 15, fq = lane >> 4;
    const int K = g.K, nt = K / BK;
    int ts_lo = 0, ts_hi = 0, nts = 0; const unsigned long long rt_entry = STAMP ? (unsigned long long)wall_clock64() : 0ull;
#define PG8_STAMP() do { if (STAMP && wid == 0 && nts < 64) { const unsigned long long _c = (unsigned long long)clock64(); \
        ts_lo = (lane == nts) ? (int)(unsigned)_c : ts_lo; ts_hi = (lane == nts) ? (int)(unsigned)(_c >> 32) : ts_hi; ++nts; } } while (0)
    PG8_STAMP();
    unsigned voffA[2], voffB[2];
#pragma unroll
    for (int i = 0; i < 2; ++i) { int R, C; stage_rc(tid * 16 + i * 8192, R, C); const int Rb = Epi::PERM ? ((R & ~31) + perm32(R & 31)) : R;
        voffA[i] = (unsigned)(R * K + C) * 2u; voffB[i] = (unsigned)(Rb * K + C) * 2u; }
    const size_t kstep = (size_t)(BK * 2);
    const size_t hstep = (size_t)HALF * K * 2;
    const size_t tstep = 2 * hstep;
    const unsigned ldsw = (unsigned)wid * 1024u;
    const int aoff = lds_byte(wr * 64 + fr, fq * 8), boff = lds_byte(wc * 32 + fr, fq * 8);
#define PG8_SA(b, h) (((b) * 2 + (h)) * HTB)
#define PG8_SB(b, h) ((4 + (b) * 2 + (h)) * HTB)
#define PG8_STAGE(bufoff, gbase, voff) do { _Pragma("unroll") for (int _i = 0; _i < 2; ++_i) \
        __builtin_amdgcn_global_load_lds((const unsigned*)((const char*)(gbase) + (voff)[_i]), (PG8_LAS unsigned*)(lds + (bufoff) + ldsw + _i * 8192), 16, 0, 0); } while (0)
#define PG8_LDA(dst, b, h) do { _Pragma("unroll") for (int m = 0; m < 4; ++m) _Pragma("unroll") for (int k = 0; k < 2; ++k) dst[m][k] = *(const PG8_LAS bf16x8*)(lds + PG8_SA(b, h) + aoff + m * 2048 + k * 1024); } while (0)
#define PG8_LDB(dst, b, h) do { _Pragma("unroll") for (int n = 0; n < 2; ++n) _Pragma("unroll") for (int k = 0; k < 2; ++k) dst[n][k] = *(const PG8_LAS bf16x8*)(lds + PG8_SB(b, h) + boff + n * 2048 + k * 1024); } while (0)
#define PG8_MMA(ai, bj, At, Bt) do { __builtin_amdgcn_s_setprio(1); _Pragma("unroll") for (int m = 0; m < 4; ++m) _Pragma("unroll") for (int n = 0; n < 2; ++n) _Pragma("unroll") for (int k = 0; k < 2; ++k) \
        acc[ai][bj][m][n] = __builtin_amdgcn_mfma_f32_16x16x32_bf16(Bt[n][k], At[m][k], acc[ai][bj][m][n], 0, 0, 0); __builtin_amdgcn_s_setprio(0); } while (0)
#define PG8_WAIT_V(n) asm volatile("s_waitcnt vmcnt(" #n ")" ::: "memory")
#define PG8_WAIT_L(n) asm volatile("s_waitcnt lgkmcnt(" #n ")" ::: "memory")
#define PG8_BAR __builtin_amdgcn_s_barrier()
#define PG8_SCHED __builtin_amdgcn_sched_barrier(0)
    Unit cur, nxt; int ui = 0;
    if (!S.next(0, cur)) return;
    f32x4 acc[2][2][4][2];
#pragma unroll
    for (int a = 0; a < 2; ++a)
#pragma unroll
        for (int b = 0; b < 2; ++b)
#pragma unroll
            for (int m = 0; m < 4; ++m)
#pragma unroll
                for (int n = 0; n < 2; ++n) acc[a][b][m][n] = (f32x4){0.f, 0.f, 0.f, 0.f};
    bf16x8 At[4][2], B0[2][2], B1[2][2];
    const char* cA = (const char*)g.A + (size_t)cur.pm * tstep; const char* cB = (const char*)g.Bt + (size_t)cur.pn * tstep;
    S.a_ready(cur);
    PG8_STAGE(PG8_SB(0, 0), cB, voffB); PG8_STAGE(PG8_SA(0, 0), cA, voffA); PG8_STAGE(PG8_SB(0, 1), cB + hstep, voffB); PG8_STAGE(PG8_SA(0, 1), cA + hstep, voffA);
    if (wr == 1) PG8_BAR;
    PG8_WAIT_V(4); PG8_BAR;
    PG8_STAGE(PG8_SB(1, 0), cB + kstep, voffB); PG8_STAGE(PG8_SA(1, 0), cA + kstep, voffA); PG8_STAGE(PG8_SB(1, 1), cB + hstep + kstep, voffB);
    PG8_WAIT_V(6); PG8_BAR;
    PG8_STAMP();
    for (;;) {
        const bool has_next = S.next(ui + 1, nxt);
        const char* nA = has_next ? (const char*)g.A + (size_t)nxt.pm * tstep : cA; const char* nB = has_next ? (const char*)g.Bt + (size_t)nxt.pn * tstep : cB;
        for (int t = 0; t < nt; t += 2) {
            const bool last = (t == nt - 2);
            const char* a1 = cA + (size_t)(t + 1) * kstep;
            const char* a2 = last ? nA : cA + (size_t)(t + 2) * kstep; const char* b2 = last ? nB : cB + (size_t)(t + 2) * kstep;
            const char* a3 = a2 + kstep; const char* b3 = b2 + kstep;
            if (last && has_next) S.a_ready(nxt);
            PG8_LDB(B0, 0, 0); PG8_SCHED; PG8_LDA(At, 0, 0); PG8_STAGE(PG8_SA(1, 1), a1 + hstep, voffA);
            PG8_WAIT_L(8); PG8_BAR; PG8_WAIT_L(0); PG8_MMA(0, 0, At, B0); PG8_BAR; PG8_SCHED;
            PG8_LDB(B1, 0, 1); PG8_STAGE(PG8_SB(0, 0), b2, voffB);
            PG8_BAR; PG8_WAIT_L(0); PG8_MMA(0, 1, At, B1); PG8_BAR;
            PG8_LDA(At, 0, 1); PG8_STAGE(PG8_SA(0, 0), a2, voffA);
            PG8_BAR; PG8_WAIT_L(0); PG8_MMA(1, 0, At, B0); PG8_BAR; PG8_SCHED;
            PG8_STAGE(PG8_SB(0, 1), b2 + hstep, voffB);
            PG8_WAIT_V(6); PG8_BAR; PG8_MMA(1, 1, At, B1); PG8_BAR;
            PG8_LDB(B0, 1, 0); PG8_SCHED; PG8_LDA(At, 1, 0); PG8_STAGE(PG8_SA(0, 1), a2 + hstep, voffA);
            PG8_WAIT_L(8); PG8_BAR; PG8_WAIT_L(0); PG8_MMA(0, 0, At, B0); PG8_BAR; PG8_SCHED;
            PG8_LDB(B1, 1, 1); PG8_STAGE(PG8_SB(1, 0), b3, voffB);
            PG8_BAR; PG8_WAIT_L(0); PG8_MMA(0, 1, At, B1); PG8_BAR;
            PG8_LDA(At, 1, 1); PG8_STAGE(PG8_SA(1, 0), a3, voffA);
            PG8_BAR; PG8_WAIT_L(0); PG8_MMA(1, 0, At, B0); PG8_BAR; PG8_SCHED;
            PG8_STAGE(PG8_SB(1, 1), b3 + hstep, voffB);
            PG8_WAIT_V(6); PG8_BAR; PG8_MMA(1, 1, At, B1); PG8_BAR;
        }
        PG8_STAMP();
        if constexpr (!Epi::AFTER_DRAIN) { E(acc, cur, wr, wc, fr, fq); S.done(cur); }
        PG8_STAMP();
        if (!has_next) break;
#pragma unroll
        for (int a = 0; a < 2; ++a)
#pragma unroll
            for (int b = 0; b < 2; ++b)
#pragma unroll
                for (int m = 0; m < 4; ++m)
#pragma unroll
                    for (int n = 0; n < 2; ++n) acc[a][b][m][n] = (f32x4){0.f, 0.f, 0.f, 0.f};
        cur = nxt; cA = nA; cB = nB; ++ui;
    }
    PG8_WAIT_V(0);
    if (wr == 0) PG8_BAR;
    PG8_BAR;
    if constexpr (Epi::AFTER_DRAIN) { E.fused(acc, cur, wr, wc, fr, fq, lds, wid, lane); S.done(cur); }
    PG8_STAMP();
    if (STAMP && wid == 0) { stamps[lane] = lane < nts ? (((unsigned long long)(unsigned)ts_hi << 32) | (unsigned)ts_lo) : 0ull;
        if (lane == 62) stamps[62] = rt_entry; if (lane == 63) stamps[63] = (unsigned long long)wall_clock64(); }
#undef PG8_STAMP
#undef PG8_SA
#undef PG8_SB
#undef PG8_STAGE
#undef PG8_LDA
#undef PG8_LDB
#undef PG8_MMA
#undef PG8_WAIT_V
#undef PG8_WAIT_L
#undef PG8_BAR
#undef PG8_SCHED
}
}

__device__ __forceinline__ void pg_store_bf16(const pg8::f32x4 (&acc)[2][2][4][2], u16* base, long ldc, int row0, int col0) {
#pragma unroll
  for (int ai = 0; ai < 2; ++ai)
#pragma unroll
    for (int m = 0; m < 4; ++m) {
      u16* rowp = base + (size_t)(row0 + ai * 128 + m * 16) * ldc + col0;
#pragma unroll
      for (int bj = 0; bj < 2; ++bj) {
        const pg8::f32x4 v0 = acc[ai][bj][m][0], v1 = acc[ai][bj][m][1];
        u32x4 w; w[0] = pg8::cvt_pk_bf16(v0[0], v0[1]); w[1] = pg8::cvt_pk_bf16(v0[2], v0[3]); w[2] = pg8::cvt_pk_bf16(v1[0], v1[1]); w[3] = pg8::cvt_pk_bf16(v1[2], v1[3]);
        *(u32x4*)(rowp + bj * 128) = w;
      }
    }
}
struct EpiG1 {
  static constexpr bool PERM = true, AFTER_DRAIN = false; char* ws;
  __device__ __forceinline__ void operator()(const pg8::f32x4 (&acc)[2][2][4][2], const pg8::Unit& u, int wr, int wc, int fr, int fq) const {
    u16* base; long ldc; int colt;
    if (u.pn < 3) { base = (u16*)(ws + OFF_PA); ldc = 768; colt = u.pn * 256; }
    else if (u.pn < 9) { base = (u16*)(ws + OFF_PB); ldc = 1536; colt = (u.pn - 3) * 256; }
    else { base = (u16*)(ws + OFF_BZ); ldc = 512; colt = (u.pn - 9) * 256; }
    pg_store_bf16(acc, base, ldc, u.pm * 256 + wr * 64 + fr, colt + wc * 32 + 8 * fq);
  }
};
struct EpiG2 {
  static constexpr bool PERM = true, AFTER_DRAIN = false; u16* qi; u16* qlat;
  __device__ __forceinline__ void operator()(const pg8::f32x4 (&acc)[2][2][4][2], const pg8::Unit& u, int wr, int wc, int fr, int fq) const {
    u16* base; long ldc; int colt;
    if (u.pn < 2) { base = qi; ldc = 512; colt = u.pn * 256; } else { base = qlat; ldc = 2048; colt = (u.pn - 2) * 256; }
    pg_store_bf16(acc, base, ldc, u.pm * 256 + wr * 64 + fr, colt + wc * 32 + 8 * fq);
  }
};
struct EpiB16 {
  static constexpr bool PERM = true, AFTER_DRAIN = false; u16* O; long ldc; const float* ssq;
  __device__ __forceinline__ void operator()(const pg8::f32x4 (&acc)[2][2][4][2], const pg8::Unit& u, int wr, int wc, int fr, int fq) const {
    const int row0 = u.pm * 256 + wr * 64 + fr, col0 = u.pn * 256 + wc * 32 + 8 * fq;
#pragma unroll
    for (int ai = 0; ai < 2; ++ai)
#pragma unroll
      for (int m = 0; m < 4; ++m) {
        const int row = row0 + ai * 128 + m * 16;
        const float rs = rsqrtf(ssq[row] * (1.f / DM) + EPSV);
        u16* rowp = O + (size_t)row * ldc + col0;
#pragma unroll
        for (int bj = 0; bj < 2; ++bj) {
          const pg8::f32x4 v0 = acc[ai][bj][m][0] * rs, v1 = acc[ai][bj][m][1] * rs;
          u32x4 w; w[0] = pg8::cvt_pk_bf16(v0[0], v0[1]); w[1] = pg8::cvt_pk_bf16(v0[2], v0[3]); w[2] = pg8::cvt_pk_bf16(v1[0], v1[1]); w[3] = pg8::cvt_pk_bf16(v1[2], v1[3]);
          *(u32x4*)(rowp + bj * 128) = w;
        }
      }
  }
};
struct EpiResid {
  static constexpr bool PERM = false, AFTER_DRAIN = false; const float* R; float* C; u16* hb; float* ssq;
  __device__ __forceinline__ void operator()(const pg8::f32x4 (&acc)[2][2][4][2], const pg8::Unit& u, int wr, int wc, int fr, int fq) const {
    const int row0 = u.pm * 256 + wr * 64 + fr, col0 = u.pn * 256 + wc * 32 + 4 * fq;
#pragma unroll
    for (int ai = 0; ai < 2; ++ai)
#pragma unroll
      for (int m = 0; m < 4; ++m) {
        const int row = row0 + ai * 128 + m * 16;
        const size_t ro = (size_t)row * DM + col0;
        float sq = 0.f;
#pragma unroll
        for (int bj = 0; bj < 2; ++bj)
#pragma unroll
          for (int n = 0; n < 2; ++n) {
            const pg8::f32x4 x = *(const pg8::f32x4*)(R + ro + bj * 128 + n * 16);
            const pg8::f32x4 y = x + acc[ai][bj][m][n];
            *(pg8::f32x4*)(C + ro + bj * 128 + n * 16) = y;
            u32x2 hw; hw[0] = pg8::cvt_pk_bf16(y[0], y[1]); hw[1] = pg8::cvt_pk_bf16(y[2], y[3]);
            *(u32x2*)(hb + ro + bj * 128 + n * 16) = hw;
            sq += y[0] * y[0] + y[1] * y[1] + y[2] * y[2] + y[3] * y[3];
          }
        sq += sx(sq, 16); sq += sx(sq, 32);
        if (fq == 0) atomicAdd(ssq + row, sq);
      }
  }
};
template <class Epi>
__device__ __forceinline__ void pg_phase(const u16* A, const u16* Bt, int M, int N, int K, const Epi& E, char* smem, int bid, int nblk) {
  pg8::Gemm g; g.A = A; g.Bt = Bt; g.M = M; g.N = N; g.K = K;
  pg8::StaticOrder S; S.init(M, N, nblk, bid);
  __syncthreads();
  pg8::gemm_phase<Epi, pg8::StaticOrder, false>((PG8_LAS unsigned char*)smem, g, S, E, nullptr);
  __syncthreads();
}

struct Params {
  const float *x, *mem, *g_mix, *w_in, *g_cq, *g_ckv, *g_kidx, *w_uq, *w_iq, *w_uk, *w_uv, *rel_bias, *conv_w, *A_log, *dt_bias, *g_onorm,
      *w_out, *g_cross, *g_mem, *wq_x, *wk_x, *wv_x, *wo_x, *g_ffn, *w_pq, *sub_keys, *u_emb, *v_emb, *g_final;
  float* out;
  char* ws;
};


__device__ __forceinline__ int perm32_pos(int c);
struct GemmP { const u16* A; long lda, a_bs; const u16* Bt; long ldb, b_bs; u16* C; long ldc, c_bs; int M, N, K, nbatch; float scale; int ncols; int tstore; };
__device__ __forceinline__ void gemm_bf16_phase(const GemmP& p, char* smem, int bid, int nblk) {
  const int tidx = otid();
  const int nm = p.M >> 8, nn = p.N >> 7, per = nm * nn;
  for (int t = bid; t < per * p.nbatch; t += nblk) {
    const int b = t / per, r = t - b * per, mp = r / nn, np = r - mp * nn;
    gemm_tile<132>(p.A + b * p.a_bs + (long)mp * 256 * p.lda, p.lda, p.Bt + b * p.b_bs + (long)np * 128 * p.ldb, p.ldb, p.K, smem);
    if (!p.tstore) epi_store_bf16(smem, p.C + b * p.c_bs + (long)mp * 256 * p.ldc + np * 128, p.ldc, p.scale, p.ncols);
    else if (p.tstore == 2) {
      const float* sC = (const float*)smem;
      u16* C = p.C + b * p.c_bs + (long)mp * 256 * p.ldc + np * 128;
      for (int i = tidx; i < 256 * 128; i += NTHR) { const int m = i >> 7, n = i & 127; C[(long)m * p.ldc + perm32_pos(n)] = f2bf(sC[m * 132 + n] * p.scale); }
    } else {
      const float* sC = (const float*)smem;
      u16* C = p.C + b * p.c_bs + (long)np * 128 * p.ldc + mp * 256;
      for (int i = tidx; i < 256 * 128; i += NTHR) { const int n = i >> 8, m = i & 255; C[(long)n * p.ldc + m] = f2bf(sC[m * 132 + n] * p.scale); }
    }
  }
}

__device__ __forceinline__ void g1_phase(const Params& P, char* smem, int bid, int nblk) {
  const u16* A = (const u16*)(P.ws + OFF_H); const u16* Bt = (const u16*)(P.ws + OFF_WINT);
  for (int t = bid; t < 128 * 21; t += nblk) {
    const int mp = t / 21, np = t - mp * 21;
    gemm_tile<132>(A + (long)mp * 256 * DM, DM, Bt + (long)np * 128 * DM, DM, DM, smem);
    u16* C; long ldc;
    if (np < 5) { C = (u16*)(P.ws + OFF_PA) + np * 128; ldc = 640; }
    else if (np < 17) { C = (u16*)(P.ws + OFF_PB) + (np - 5) * 128; ldc = 1536; }
    else { C = (u16*)(P.ws + OFF_BZ) + (np - 17) * 128; ldc = 512; }
    epi_store_bf16(smem, C + (long)mp * 256 * ldc, ldc, 1.f, 128);
  }
}

__device__ __forceinline__ void g2_phase(const Params& P, char* smem, int bid, int nblk) {
  const u16* A = (const u16*)(P.ws + OFF_CQN); const u16* Bt = (const u16*)(P.ws + OFF_WG2T);
  for (int t = bid; t < 128 * 20; t += nblk) {
    const int mp = t / 20, np = t - mp * 20;
    gemm_tile<132>(A + (long)mp * 256 * 256, 256, Bt + (long)np * 128 * 256, 256, 256, smem);
    if (np < 4) epi_store_bf16(smem, (u16*)(P.ws + OFF_QI) + (long)mp * 256 * 512 + np * 128, 512, 1.f, 128);
    else epi_store_bf16(smem, (u16*)P.out + (long)mp * 256 * 2048 + (np - 4) * 128, 2048, 1.f, 128);
  }
}

struct GemmR { const u16* A; long lda; const u16* Bt; long ldb; const float* R; float* C; int K; };
__device__ __forceinline__ void gemm_resid_phase(const GemmR& p, char* smem, int bid, int nblk) {
  for (int t = bid; t < 128 * 8; t += nblk) {
    const int mp = t >> 3, np = t & 7;
    gemm_tile<132>(p.A + (long)mp * 256 * p.lda, p.lda, p.Bt + (long)np * 128 * p.ldb, p.ldb, p.K, smem);
    epi_resid_f32(smem, p.R + (long)mp * 256 * DM + np * 128, p.C + (long)mp * 256 * DM + np * 128, DM);
  }
}

__device__ __forceinline__ void dsa_prep_phase(const Params& P, int bid, int nblk) {
  const int tidx = otid();
  const int lane = tidx & 63, wv = tidx >> 6;
  const u16* Pa = (const u16*)(P.ws + OFF_PA);
  u16* cqn = (u16*)(P.ws + OFF_CQN); u16* ckvn = (u16*)(P.ws + OFF_CKVN); u16* kidxn = (u16*)(P.ws + OFF_KIDXN); float* widx = (float*)(P.ws + OFF_WIDX);
  const float4 ga = *(const float4*)(P.g_cq + lane * 4), gc = *(const float4*)(P.g_ckv + lane * 4);
  const float gk = P.g_kidx[lane];
  for (int t0 = (bid * 8 + wv) * 4; t0 < T_TOK; t0 += nblk * 32) {
    u32x2 av[4], cv[4]; u16 kv[4], wvv[4];
#pragma unroll
    for (int k = 0; k < 4; ++k) {
      const u16* row = Pa + (long)(t0 + k) * 768;
      av[k] = *(const u32x2*)(row + lane * 4); cv[k] = *(const u32x2*)(row + 256 + lane * 4); kv[k] = row[512 + lane]; wvv[k] = row[576 + (lane & 7)];
    }
#pragma unroll
    for (int k = 0; k < 4; ++k) {
      const int t = t0 + k;
      const float kf = bf2f(kv[k]);
      const float a0 = lo2f(av[k][0]), a1 = hi2f(av[k][0]), a2 = lo2f(av[k][1]), a3 = hi2f(av[k][1]);
      const float c0 = lo2f(cv[k][0]), c1 = hi2f(cv[k][0]), c2 = lo2f(cv[k][1]), c3 = hi2f(cv[k][1]);
      const float sa = wave_sum(a0 * a0 + a1 * a1 + a2 * a2 + a3 * a3), sc = wave_sum(c0 * c0 + c1 * c1 + c2 * c2 + c3 * c3), sk = wave_sum(kf * kf);
      const float ra = rsqrtf(sa * (1.f / 256) + EPSV), rc = rsqrtf(sc * (1.f / 256) + EPSV), rk = rsqrtf(sk * (1.f / 64) + EPSV);
      u32x2 o; o[0] = pack2(a0 * ra * ga.x, a1 * ra * ga.y); o[1] = pack2(a2 * ra * ga.z, a3 * ra * ga.w);
      *(u32x2*)(cqn + (long)t * 256 + lane * 4) = o;
      o[0] = pack2(c0 * rc * gc.x, c1 * rc * gc.y); o[1] = pack2(c2 * rc * gc.z, c3 * rc * gc.w);
      *(u32x2*)(ckvn + (long)t * 256 + lane * 4) = o;
      kidxn[(long)t * 64 + lane] = f2bf(kf * rk * gk);
      if (lane < 8) widx[(long)t * 8 + lane] = bf2f(wvv[k]) * 0.04419417382415922f;
    }
  }
}

__device__ __forceinline__ unsigned xb_xcc_id();
#define IX_CAP 2048
#define IX_CK 0
#define IX_HIST 131072
#define IX_CV 152640
#define IX_CNT 154688
#define IX_NV (IX_CAP / 64)
__device__ __forceinline__ unsigned wave_umax_u(unsigned v) {
#pragma unroll
  for (int o = 32; o >= 1; o >>= 1) { const unsigned t = (unsigned)sx((int)v, o); v = v > t ? v : t; }
  return v;
}
__device__ __forceinline__ unsigned wave_umin_u(unsigned v) { return ~wave_umax_u(~v); }
template <int NV>
__device__ __forceinline__ void compact_query(char* smem, int q, int n, int lane, int wv) {
  unsigned* ck = (unsigned*)(smem + IX_CK) + q * IX_CAP;
  unsigned* hist = (unsigned*)(smem + IX_HIST) + wv * 256;
  unsigned* cval = (unsigned*)(smem + IX_CV) + wv * 64;
  unsigned v[NV];
#pragma unroll
  for (int i = 0; i < NV; ++i) { const int e = i * 64 + lane; v[i] = (e < n) ? ck[e] : 0u; }
  unsigned lo = 0xffffffffu, hi = 0u;
#pragma unroll
  for (int i = 0; i < NV; ++i) { const unsigned x = (i * 64 + lane < n) ? v[i] : 0xffffffffu; lo = lo < x ? lo : x; hi = hi > v[i] ? hi : v[i]; }
  lo = wave_umin_u(lo); hi = wave_umax_u(hi);
  int need = 256;
  unsigned tau = lo;
  for (int iter = 0; iter < 40; ++iter) {
    if (hi == lo) { tau = lo; break; }
    const unsigned range = hi - lo;
    const int nbits = 32 - __clz((int)range);
    const int shift = nbits > 8 ? nbits - 8 : 0;
    for (int i = lane; i < 256; i += 64) hist[i] = 0u;
    __builtin_amdgcn_wave_barrier();
#pragma unroll
    for (int i = 0; i < NV; ++i) { const unsigned x = v[i]; if (x >= lo && x <= hi) atomicAdd(&hist[(x - lo) >> shift], 1u); }
    __builtin_amdgcn_wave_barrier();
    unsigned c[4]; unsigned tot = 0;
#pragma unroll
    for (int j = 0; j < 4; ++j) { c[j] = hist[255 - 4 * lane - j]; tot += c[j]; }
    unsigned incl = tot;
#pragma unroll
    for (int o = 1; o < 64; o <<= 1) { const unsigned t = su(incl, o); if (lane >= o) incl += t; }
    const unsigned excl = incl - tot;
    const bool mine = (excl < (unsigned)need) && (incl >= (unsigned)need);
    int bsel = 0; unsigned above = 0, nstar = 0;
    if (mine) {
      unsigned run = excl;
#pragma unroll
      for (int j = 0; j < 4; ++j) { if (run < (unsigned)need && run + c[j] >= (unsigned)need) { bsel = 255 - 4 * lane - j; above = run; nstar = c[j]; } run += c[j]; }
    }
    const unsigned long long mk = __ballot(mine);
    const int src = __ffsll((long long)mk) - 1;
    bsel = sh(bsel, src); above = sh(above, src); nstar = sh(nstar, src);
    need -= (int)above;
    unsigned nlo = 0xffffffffu, nhi = 0u; int cnt = 0;
#pragma unroll
    for (int i = 0; i < NV; ++i) {
      const unsigned x = v[i];
      const bool in = (x >= lo && x <= hi) && ((int)((x - lo) >> shift) == bsel);
      if (in) { nlo = nlo < x ? nlo : x; nhi = nhi > x ? nhi : x; }
      if (nstar <= 64u) {
        const unsigned long long m = __ballot(in);
        if (in) { const int pos = cnt + __builtin_amdgcn_mbcnt_hi((unsigned)(m >> 32), __builtin_amdgcn_mbcnt_lo((unsigned)m, 0u)); cval[pos] = x; }
        cnt += __popcll(m);
      }
    }
    nlo = wave_umin_u(nlo); nhi = wave_umax_u(nhi);
    if (nstar <= 64u) {
      __builtin_amdgcn_wave_barrier();
      const bool act = lane < (int)nstar;
      const unsigned mv = act ? cval[lane] : 0u;
      int rank = 0;
      for (int j = 0; j < (int)nstar; ++j) rank += (cval[j] > mv) ? 1 : 0;
      const unsigned long long mm = __ballot(act && rank == need - 1);
      const int s2 = __ffsll((long long)mm) - 1;
      tau = (unsigned)sh((int)mv, s2 < 0 ? 0 : s2);
      break;
    }
    lo = nlo; hi = nhi;
  }
  int pos = 0;
#pragma unroll
  for (int i = 0; i < NV; ++i) {
    const bool keep = v[i] >= tau && v[i] != 0u;
    const unsigned long long m = __ballot(keep);
    if (keep) { const int p = pos + __builtin_amdgcn_mbcnt_hi((unsigned)(m >> 32), __builtin_amdgcn_mbcnt_lo((unsigned)m, 0u)); if (p < IX_CAP) ck[p] = v[i]; }
    pos += __popcll(m);
  }
  if (lane == 0) { ((unsigned*)(smem + IX_CNT))[q] = 256u; ((unsigned*)(smem + IX_CNT))[16 + q] = tau; }
}
__device__ __forceinline__ void quick_compact(char* smem, int q, int n, int lane) {
  unsigned* ck = (unsigned*)(smem + IX_CK) + q * IX_CAP;
  unsigned v[IX_NV];
#pragma unroll
  for (int i = 0; i < IX_NV; ++i) { const int e = i * 64 + lane; v[i] = (e < n) ? ck[e] : 0u; }
  const unsigned smp = v[0];
  int rank = 0;
#pragma unroll
  for (int m = 0; m < 64; ++m) rank += ((unsigned)__builtin_amdgcn_readlane((int)smp, m) > smp) ? 1 : 0;
  int r = (64 * 336 + n / 2) / n; r = r < 1 ? 1 : (r > 62 ? 62 : r);
  unsigned thr = 0u; int kept = n; bool ok = false;
  for (int it = 0; it < 6; ++it) {
    const unsigned long long mm = __ballot(rank == r);
    const int src = __ffsll((long long)mm) - 1;
    const unsigned cand = (unsigned)__builtin_amdgcn_readlane((int)smp, src < 0 ? 0 : src);
    int c = 0;
#pragma unroll
    for (int i = 0; i < IX_NV; ++i) c += __popcll(__ballot(v[i] > cand));
    if (c >= 256 && c <= 448) { thr = cand; kept = c; ok = true; break; }
    int r2 = (r * 336 + (c > 0 ? c / 2 : 0)) / (c > 0 ? c : 1);
    if (r2 == r) r2 = (c < 256) ? r + 1 : r - 1;
    r = r2 < 1 ? 1 : (r2 > 62 ? 62 : r2);
  }
  if (!ok) {
    unsigned lo = 0xffffffffu, hi = 0u;
#pragma unroll
    for (int i = 0; i < IX_NV; ++i) { const unsigned x = (i * 64 + lane < n) ? v[i] : 0xffffffffu; lo = lo < x ? lo : x; hi = hi > v[i] ? hi : v[i]; }
    lo = wave_umin_u(lo); hi = wave_umax_u(hi);
    unsigned a = lo, b = hi; thr = 0u; kept = n;
    for (int it = 0; it < 34 && kept > 448; ++it) {
      const unsigned mid = a + ((b - a) >> 1);
      if (mid == a) break;
      int c = 0;
#pragma unroll
      for (int i = 0; i < IX_NV; ++i) c += __popcll(__ballot(v[i] > mid));
      if (c >= 256) { a = mid; thr = mid; kept = c; } else b = mid;
    }
  }
  int pos = 0;
#pragma unroll
  for (int i = 0; i < IX_NV; ++i) {
    const bool keep = v[i] > thr;
    const unsigned long long m = __ballot(keep);
    if (keep) { const int p = pos + __builtin_amdgcn_mbcnt_hi((unsigned)(m >> 32), __builtin_amdgcn_mbcnt_lo((unsigned)m, 0u)); ck[p] = v[i]; }
    pos += __popcll(m);
  }
  if (lane == 0) { ((unsigned*)(smem + IX_CNT))[q] = (unsigned)kept; ((unsigned*)(smem + IX_CNT))[16 + q] = thr; }
}
__device__ __forceinline__ void emit_sorted(char* smem, int q, u16* sel, int lane, int wv) {
  const unsigned* ck = (const unsigned*)(smem + IX_CK) + q * IX_CAP;
  unsigned* bm = (unsigned*)(smem + IX_HIST) + wv * 256;
  for (int i = lane; i < 256; i += 64) bm[i] = 0u;
  __builtin_amdgcn_wave_barrier();
#pragma unroll
  for (int k = 0; k < 4; ++k) { const unsigned idx = 8191u - (ck[k * 64 + lane] & 0x1fffu); atomicOr(&bm[idx >> 5], 1u << (idx & 31)); }
  __builtin_amdgcn_wave_barrier();
  unsigned w[4]; unsigned tot = 0;
#pragma unroll
  for (int j = 0; j < 4; ++j) { w[j] = bm[4 * lane + j]; tot += __popc(w[j]); }
  unsigned incl = tot;
#pragma unroll
  for (int o = 1; o < 64; o <<= 1) { const unsigned t = su(incl, o); if (lane >= o) incl += t; }
  unsigned p = incl - tot;
#pragma unroll
  for (int j = 0; j < 4; ++j) {
    unsigned x = w[j];
    while (x) { const int bb = __ffs((int)x) - 1; if (p < 256u) sel[p] = (u16)(lane * 128 + j * 32 + bb); ++p; x &= x - 1; }
  }
}

#define ATT_ROWB 544
__device__ __forceinline__ int t5_bucket(int rel) {
  const int n = rel < 0 ? -rel : rel;
  const int lg = 8 + (n >= 12) + (n >= 16) + (n >= 23) + (n >= 32) + (n >= 46) + (n >= 64) + (n >= 91);
  return (rel > 0 ? 16 : 0) + (n < 8 ? n : lg);
}
#define DSA_SBIAS 139264
#define DSA_SSEL 140288
#define LDS_XB 148480
#define LDS_UNIT 148496
#define DSA_SBK 148544
#define LDS_TOTAL 154880
__device__ __forceinline__ void attn_query(const Params& P, int tv, const u16* ssel, char* rows, const float* sbias, unsigned char* sbk, int lane) {
  const int t = __builtin_amdgcn_readfirstlane(tv);
  const int lr = lane & 15, g = lane >> 4;
  const u16* ckv = (const u16*)(P.ws + OFF_CKVN);
  u16* qlat = (u16*)P.out;
  const int b = t >> 13, pos = t & 8191, L = ((pos >> 6) + 1) * 64, n = L < 256 ? L : 256;
  const u16* kb = ckv + (long)(b * SEQ) * 256;
  bf16x8 bq[8];
#pragma unroll
  for (int ks = 0; ks < 8; ++ks) {
    bf16x8 v = (bf16x8){0, 0, 0, 0, 0, 0, 0, 0};
    if (lr < 8) v = *(const bf16x8*)(qlat + (long)t * 2048 + lr * 256 + ks * 32 + g * 8);
    bq[ks] = v;
  }
  {
    unsigned pk = 0u;
#pragma unroll
    for (int j = 0; j < 4; ++j) pk |= (unsigned)t5_bucket((int)ssel[lane * 4 + j] - pos) << (8 * j);
    *(unsigned*)(sbk + lane * 4) = pk;
  }
  int nfarblk;
  {
    int c = 0;
#pragma unroll
    for (int j = 0; j < 4; ++j) c += __popcll(__ballot((lane * 4 + j) < n && (int)ssel[lane * 4 + j] <= pos - 91));
    nfarblk = __builtin_amdgcn_readfirstlane(c) >> 4;
  }
  const float farb = sbias[15 * 8 + (lr & 7)];
  __builtin_amdgcn_wave_barrier();
  float m_run = -3.0e38f, l_run = 0.f;
  f32x4 O[16];
#pragma unroll
  for (int i = 0; i < 16; ++i) O[i] = (f32x4){0.f, 0.f, 0.f, 0.f};
  const int nb = n >> 4;
  const int grow = lane >> 5, gch = (lane & 31);
  const int q = lr >> 2, pp = lr & 3;
  u32x4 gr[8];
#pragma unroll 1
  for (int j = 0; j < 2; ++j) {
#pragma unroll
    for (int i = 0; i < 8; ++i) { const unsigned idx = ssel[j * 16 + i * 2 + grow]; gr[i] = *(const u32x4*)((const char*)kb + (size_t)(idx * 512u + (unsigned)gch * 16u)); }
#pragma unroll
    for (int i = 0; i < 8; ++i) *(u32x4*)(rows + j * (16 * ATT_ROWB) + (i * 2 + grow) * ATT_ROWB + (gch ^ (i >> 2)) * 16) = gr[i];
  }
  __builtin_amdgcn_wave_barrier();
  auto qk_soft = [&](int j) -> s16x4 {
    const char* buf = rows + (j & 1) * (16 * ATT_ROWB);
    f32x4 S = (f32x4){0.f, 0.f, 0.f, 0.f}, S1 = (f32x4){0.f, 0.f, 0.f, 0.f};
#pragma unroll
    for (int ks = 0; ks < 8; ks += 2) {
      const bf16x8 a0 = *(const bf16x8*)(buf + lr * ATT_ROWB + ((ks * 4 + g) ^ (lr >> 3)) * 16), a1 = *(const bf16x8*)(buf + lr * ATT_ROWB + (((ks + 1) * 4 + g) ^ (lr >> 3)) * 16);
      S = mfma16(a0, bq[ks], S); S1 = mfma16(a1, bq[ks + 1], S1);
    }
    float mx = -3.0e38f;
    if (j < nfarblk) {
#pragma unroll
      for (int r = 0; r < 4; ++r) { S[r] = S[r] + S1[r] + farb; mx = fmaxf(mx, S[r]); }
    } else {
#pragma unroll
      for (int r = 0; r < 4; ++r) { S[r] = S[r] + S1[r] + sbias[(int)sbk[j * 16 + g * 4 + r] * 8 + (lr & 7)]; mx = fmaxf(mx, S[r]); }
    }
    if (__any(mx > m_run + 8.f)) {
      mx = fmaxf(mx, sx(mx, 16)); mx = fmaxf(mx, sx(mx, 32));
      const float m_new = fmaxf(m_run, mx);
      const float alpha = __expf(m_run - m_new);
      l_run *= alpha; m_run = m_new;
      float al[4];
#pragma unroll
      for (int r = 0; r < 4; ++r) al[r] = sh(alpha, g * 4 + r);
#pragma unroll
      for (int ct = 0; ct < 16; ++ct)
#pragma unroll
        for (int r = 0; r < 4; ++r) O[ct][r] *= al[r];
    }
    float ps = 0.f; s16x4 ap;
#pragma unroll
    for (int r = 0; r < 4; ++r) { const float pv = __expf(S[r] - m_run); ps += pv; ap[r] = (short)f2bf(pv); }
    l_run += ps;
    return ap;
  };
  s16x4 ap = qk_soft(0);
#pragma unroll 1
  for (int kbk = 0; kbk < nb; ++kbk) {
    const char* cur = rows + (kbk & 1) * (16 * ATT_ROWB);
    const bool more2 = (kbk + 2) < nb;
    if (more2) {
#pragma unroll
      for (int i = 0; i < 8; ++i) { const unsigned idx = ssel[(kbk + 2) * 16 + i * 2 + grow]; gr[i] = *(const u32x4*)((const char*)kb + (size_t)(idx * 512u + (unsigned)gch * 16u)); }
    }
    const char* tb0 = cur + (4 * g + q) * ATT_ROWB + ((pp * 8) ^ ((g >> 1) * 16));
#pragma unroll
    for (int ct = 0; ct < 16; ++ct) {
      const s16x4 bv = __builtin_amdgcn_ds_read_tr16_b64_v4i16((LAS s16x4*)(tb0 + ct * 32));
      O[ct] = __builtin_amdgcn_mfma_f32_16x16x16bf16_1k(ap, bv, O[ct], 0, 0, 0);
    }
    if (kbk + 1 < nb) ap = qk_soft(kbk + 1);
    __builtin_amdgcn_wave_barrier();
    if (more2) {
      char* dstb = rows + (kbk & 1) * (16 * ATT_ROWB);
#pragma unroll
      for (int i = 0; i < 8; ++i) *(u32x4*)(dstb + (i * 2 + grow) * ATT_ROWB + (gch ^ (i >> 2)) * 16) = gr[i];
    }
    __builtin_amdgcn_wave_barrier();
  }
  float lt = l_run; lt += sx(lt, 16); lt += sx(lt, 32);
  const float inv = 1.f / lt;
  float iv[4];
#pragma unroll
  for (int r = 0; r < 4; ++r) iv[r] = sh(inv, g * 4 + r);
  if (g < 2) {
#pragma unroll
    for (int ct = 0; ct < 16; ++ct)
#pragma unroll
      for (int r = 0; r < 4; ++r) qlat[(long)t * 2048 + (g * 4 + r) * 256 + ct * 16 + lr] = f2bf(O[ct][r] * iv[r]);
  }
}

__device__ __forceinline__ void dsa_unit(const Params& P, char* smem, int unit, int bid) {
  const int tidx = otid();
  const int tid = tidx, lane = tid & 63, wv = tid >> 6, lr = lane & 15, g = lane >> 4;
  const u16* qi = (const u16*)(P.ws + OFF_QI); const u16* kidx = (const u16*)(P.ws + OFF_KIDXN); const float* widx = (const float*)(P.ws + OFF_WIDX);
  u16* sselw = (u16*)(smem + DSA_SSEL) + wv * 512;
  const float* sbias = (const float*)(smem + DSA_SBIAS);
  unsigned* scnt = (unsigned*)(smem + IX_CNT); unsigned* stau = (unsigned*)(smem + IX_CNT) + 16;
  const int t0 = unit * 16, b = t0 >> 13, pos0 = t0 & 8191, L = ((pos0 >> 6) + 1) * 64;
  __syncthreads();
  if (L > 256) {
    if (tid < 16) { scnt[tid] = (unsigned)(L < 2048 ? L : 2048); stau[tid] = 0u; }
    bf16x8 a[8][2];
#pragma unroll
    for (int h = 0; h < 8; ++h)
#pragma unroll
      for (int ks = 0; ks < 2; ++ks) a[h][ks] = *(const bf16x8*)(qi + (long)(t0 + lr) * 512 + h * 64 + ks * 32 + g * 8);
    float wq[8];
    {
      const float4 w0 = *(const float4*)(widx + (long)(t0 + lr) * 8), w1 = *(const float4*)(widx + (long)(t0 + lr) * 8 + 4);
      wq[0] = w0.x; wq[1] = w0.y; wq[2] = w0.z; wq[3] = w0.w; wq[4] = w1.x; wq[5] = w1.y; wq[6] = w1.z; wq[7] = w1.w;
    }
    unsigned tauk = 0u; float tqf = -3.0e38f;
    LAS unsigned* ckq = (LAS unsigned*)(smem + IX_CK) + lr * IX_CAP;
    LAS unsigned* cntq = (LAS unsigned*)(smem + IX_CNT) + lr;
    const u16* kb = kidx + (long)(b * SEQ) * 64;
    const int nkt = L >> 4;
    bf16x8 c0[2], c1[2];
    {
      int k0 = wv; k0 = k0 < nkt ? k0 : nkt - 1;
      c0[0] = *(const bf16x8*)((const char*)kb + (size_t)((unsigned)(k0 * 16 + lr) * 128u + (unsigned)g * 16u)); c0[1] = *(const bf16x8*)((const char*)kb + (size_t)((unsigned)(k0 * 16 + lr) * 128u + 64u + (unsigned)g * 16u));
    }
    __syncthreads();
    const int nti = ((nkt + 63) >> 6) * 8;
#pragma unroll 1
    for (int i = 0; i < nti; ++i) {
      {
        int k1 = wv + 8 * (i + 1); k1 = k1 < nkt ? k1 : nkt - 1;
        c1[0] = *(const bf16x8*)((const char*)kb + (size_t)((unsigned)(k1 * 16 + lr) * 128u + (unsigned)g * 16u)); c1[1] = *(const bf16x8*)((const char*)kb + (size_t)((unsigned)(k1 * 16 + lr) * 128u + 64u + (unsigned)g * 16u));
      }
      const int kt = wv + 8 * i;
      if (kt < nkt) {
        float s[4] = {0.f, 0.f, 0.f, 0.f};
#pragma unroll
        for (int h = 0; h < 8; ++h) {
          f32x4 d = mfma16(c0[0], a[h][0], (f32x4){0.f, 0.f, 0.f, 0.f}); d = mfma16(c0[1], a[h][1], d);
#pragma unroll
          for (int r = 0; r < 4; ++r) s[r] = fmaf(relu_raw(d[r]), wq[h], s[r]);
        }
        if (i < 16) {
#pragma unroll
          for (int r = 0; r < 4; ++r) { const int key = kt * 16 + g * 4 + r; ckq[key] = (fkey(s[r]) & 0xffffe000u) | (unsigned)(8191 - key); }
        } else {
          unsigned kk[4]; bool pr[4]; int np = 0;
#pragma unroll
          for (int r = 0; r < 4; ++r) {
            const int key = kt * 16 + g * 4 + r;
            kk[r] = (fkey(s[r]) & 0xffffe000u) | (unsigned)(8191 - key);
            pr[r] = (s[r] >= tqf) && (kk[r] > tauk);
            np += pr[r] ? 1 : 0;
          }
          if (np > 0) {
            unsigned slot = __hip_atomic_fetch_add(cntq, (unsigned)np, __ATOMIC_RELAXED, __HIP_MEMORY_SCOPE_WORKGROUP);
#pragma unroll
            for (int r = 0; r < 4; ++r) { if (pr[r]) { if (slot < (unsigned)IX_CAP) ckq[slot] = kk[r]; ++slot; } }
          }
        }
      }
      c0[0] = c1[0]; c0[1] = c1[1];
      const bool last = (i + 1 >= nti);
      if ((i & 7) == 7 && (i >= 15 || last)) {
        __syncthreads();
#pragma unroll 1
        for (int qq = 0; qq < 2; ++qq) {
          const int q = wv * 2 + qq; const int n = (int)scnt[q];
          const int nn = n > IX_CAP ? IX_CAP : n;
          if (n > 1024) {
            quick_compact(smem, q, nn, lane);
            if (last) compact_query<8>(smem, q, (int)scnt[q], lane, wv);
          } else if (last && n > 512) compact_query<16>(smem, q, nn, lane, wv);
          else if (last && n > 256) compact_query<8>(smem, q, nn, lane, wv);
        }
        __syncthreads();
        tauk = stau[lr]; tqf = keyf(tauk & 0xffffe000u);
      }
    }
#pragma unroll 1
    for (int qq = 0; qq < 2; ++qq) emit_sorted(smem, wv * 2 + qq, sselw + qq * 256, lane, wv);
  } else {
#pragma unroll 1
    for (int qq = 0; qq < 2; ++qq) { u16* sel = sselw + qq * 256; for (int j = lane; j < 256; j += 64) sel[j] = (u16)(j < L ? j : 0); }
  }
  __syncthreads();
#pragma unroll 1
  for (int qq = 0; qq < 2; ++qq) attn_query(P, t0 + wv * 2 + qq, sselw + qq * 256, smem + wv * (32 * ATT_ROWB), sbias, (unsigned char*)(smem + DSA_SBK) + (wv * 2 + qq) * 256, lane);
}
__device__ __forceinline__ void dsa_queue_phase(const Params& P, char* smem, int bid, unsigned* qctr) {
  const int tidx = otid();
  const int tid = tidx;
  float* sbias = (float*)(smem + DSA_SBIAS);
  volatile int* sunit = (volatile int*)(smem + LDS_UNIT);
  const int pref = (int)(xb_xcc_id() & 3u);
  __syncthreads();
  for (int i = tid; i < 256; i += NTHR) sbias[i] = P.rel_bias[i];
  int qoff = 0;
  for (;;) {
    __syncthreads();
    if (otid() == 0) {
      int unit = -1; int qo = qoff;
      while (qo < 4) {
        const int bq = (pref + qo) & 3;
        const unsigned v = atomicAdd(qctr + bq * 64, 1u);
        if (v < 512u) { unit = bq * 512 + (511 - (int)v); break; }
        ++qo;
      }
      sunit[0] = unit; sunit[1] = qo;
    }
    __syncthreads();
    const int unit = sunit[0]; qoff = sunit[1];
    if (unit < 0) break;
    dsa_unit(P, smem, unit, bid);
  }
}

__device__ __forceinline__ void dn_prep_phase(const Params& P, int bid, int nblk) {
  const int tidx = otid();
  const int lane = tidx & 63, wv = tidx >> 6, hh = lane >> 4, cg = lane & 15;
  const u16* Pb = (const u16*)(P.ws + OFF_PB); const u16* Pa = (const u16*)(P.ws + OFF_PA);
  u16* qkv = (u16*)(P.ws + OFF_QKV);
  float* gg = (float*)(P.ws + OFF_GB); float* bt = gg + 16 * 8192;
  float w[3][4][8];
#pragma unroll
  for (int sec = 0; sec < 3; ++sec)
#pragma unroll
    for (int j = 0; j < 4; ++j) {
      const float4 w0 = *(const float4*)(P.conv_w + j * 1536 + sec * 512 + hh * 128 + cg * 8), w1 = *(const float4*)(P.conv_w + j * 1536 + sec * 512 + hh * 128 + cg * 8 + 4);
      w[sec][j][0] = w0.x; w[sec][j][1] = w0.y; w[sec][j][2] = w0.z; w[sec][j][3] = w0.w; w[sec][j][4] = w1.x; w[sec][j][5] = w1.y; w[sec][j][6] = w1.z; w[sec][j][7] = w1.w;
    }
  const float dtb = P.dt_bias[hh], aexp = __expf(P.A_log[hh]);
  for (int chk = bid * 8 + wv; chk < T_TOK / 16; chk += nblk * 8) {
    const int t0 = chk * 16, b = t0 >> 13, pos0 = t0 & 8191;
    u32x4 win[3][4];
#pragma unroll
    for (int sec = 0; sec < 3; ++sec) {
      const int col = sec * 512 + hh * 128 + cg * 8;
#pragma unroll
      for (int k = 0; k < 3; ++k) {
        u32x4 z = (u32x4){0u, 0u, 0u, 0u};
        if (pos0 - 3 + k >= 0) z = *(const u32x4*)(Pb + (long)(t0 - 3 + k) * 1536 + col);
        win[sec][k] = z;
      }
      win[sec][3] = *(const u32x4*)(Pb + (long)t0 * 1536 + col);
    }
#pragma unroll 1
    for (int i = 0; i < 16; ++i) {
      const int t = t0 + i, pos = pos0 + i;
      u32x4 nxt[3];
#pragma unroll
      for (int sec = 0; sec < 3; ++sec) nxt[sec] = *(const u32x4*)(Pb + (long)(i < 15 ? t + 1 : t) * 1536 + sec * 512 + hh * 128 + cg * 8);
      float abv = 0.f;
      if (cg == 0) abv = bf2f(Pa[(long)t * 768 + 584 + hh]);
      float bbv = 0.f;
      if (cg == 0) bbv = bf2f(Pa[(long)t * 768 + 588 + hh]);
#pragma unroll
      for (int sec = 0; sec < 3; ++sec) {
        float y[8];
#pragma unroll
        for (int e = 0; e < 8; ++e) y[e] = 0.f;
#pragma unroll
        for (int j = 0; j < 4; ++j) {
          const u32x4 xv = win[sec][j];
          y[0] += w[sec][j][0] * lo2f(xv[0]); y[1] += w[sec][j][1] * hi2f(xv[0]); y[2] += w[sec][j][2] * lo2f(xv[1]); y[3] += w[sec][j][3] * hi2f(xv[1]);
          y[4] += w[sec][j][4] * lo2f(xv[2]); y[5] += w[sec][j][5] * hi2f(xv[2]); y[6] += w[sec][j][6] * lo2f(xv[3]); y[7] += w[sec][j][7] * hi2f(xv[3]);
        }
        float ss = 0.f;
#pragma unroll
        for (int e = 0; e < 8; ++e) { y[e] = y[e] / (1.f + __expf(-y[e])); ss += y[e] * y[e]; }
        ss += sx(ss, 1); ss += sx(ss, 2); ss += sx(ss, 4); ss += sx(ss, 8);
        float sc = 1.f;
        if (sec == 0) sc = rsqrtf(ss + EPSV) * 0.08838834764831845f;
        else if (sec == 1) sc = rsqrtf(ss + EPSV);
        u32x4 o;
#pragma unroll
        for (int e = 0; e < 4; ++e) o[e] = pack2(y[2 * e] * sc, y[2 * e + 1] * sc);
        *(u32x4*)(qkv + (long)sec * (16l * 8192 * 128) + ((long)(b * 4 + hh) * 8192 + pos) * 128 + cg * 8) = o;
        win[sec][0] = win[sec][1]; win[sec][1] = win[sec][2]; win[sec][2] = win[sec][3]; win[sec][3] = nxt[sec];
      }
      if (cg == 0) {
        const float z = abv + dtb;
        const float sp = z > 20.f ? z : log1pf(__expf(z));
        gg[(long)(b * 4 + hh) * 8192 + pos] = -aexp * sp;
        bt[(long)(b * 4 + hh) * 8192 + pos] = 1.f / (1.f + __expf(-bbv));
      }
    }
  }
}

__device__ __forceinline__ int perm32_pos(int c) {
  const int blk = c & ~31, w = c & 31;
  const int hi = w >> 4, gq = (w >> 2) & 3, lo = w & 3;
  return blk + gq * 8 + hi * 4 + lo;
}
__device__ __forceinline__ void dn_intra_phase(const Params& P, char* smem, int bid, int nblk) {
  const int tidx = otid();
  const int tid = tidx, lane = tid & 63, wv = tid >> 6, lr = lane & 15, g = lane >> 4;
  u16* qkv = (u16*)(P.ws + OFF_QKV);
  const float* gg = (const float*)(P.ws + OFF_GB); const float* bt = gg + 16 * 8192; float* cdec = (float*)(P.ws + OFF_GB) + 32 * 8192;
  u16* wdn = (u16*)(P.ws + OFF_WDN); u16* intra = (u16*)(P.ws + OFF_INTRA);
  char* sQ = smem;
  char* sK = smem + 16384;
  char* sV = smem + 32768;
  float* sMT = (float*)(smem + 49152);
  float* sG = (float*)(smem + 66560);
  float* sX = (float*)(smem + 67584);
  u16* sI = (u16*)(smem + 133632);
  float* sT = (float*)(smem + 141824);
  u32x4 pre[6]; float pgv = 0.f, pbv = 0.f;
  if (bid < 2048) {
    const int bh0 = bid >> 7, ch0 = bid & 127;
    const long tb0 = ((long)bh0 * 8192 + ch0 * 64) * 128;
#pragma unroll
    for (int k = 0; k < 6; ++k) {
      const int i = tid + k * NTHR;
      const int which = i >> 10, q = i & 1023;
      pre[k] = *(const u32x4*)(qkv + (long)which * (16l * 8192 * 128) + tb0 + q * 8);
    }
    if (tid < 64) { pgv = gg[(long)bh0 * 8192 + ch0 * 64 + tid]; pbv = bt[(long)bh0 * 8192 + ch0 * 64 + tid]; }
  }
  for (int u = bid; u < 2048; u += nblk) {
    const int tidl = otid();
    const int tid = tidl, lane = tid & 63, wv = tid >> 6, lr = lane & 15, g = lane >> 4;
    const int bh = u >> 7, ch = u & 127;
    const long tbase = ((long)bh * 8192 + ch * 64) * 128;
    u16* tq = qkv + tbase; u16* tk = qkv + 16l * 8192 * 128 + tbase; u16* tv = qkv + 32l * 8192 * 128 + tbase;
    __syncthreads();
#pragma unroll
    for (int k = 0; k < 6; ++k) {
      const int i = tid + k * NTHR;
      const int which = i >> 10, q = i & 1023, row = q >> 4, chk = q & 15;
      *(u32x4*)(smem + which * 16384 + row * 256 + ((chk ^ (row & 15)) << 4)) = pre[k];
    }
    if (tid < 64) {
      float sc = pgv;
#pragma unroll
      for (int o = 1; o < 64; o <<= 1) { const float t = su(sc, o); if (tid >= o) sc += t; }
      sG[tid] = sc; sG[64 + tid] = pbv;
    }
    __syncthreads();
    {
      const int mi = wv & 3; const char* sAop = (wv < 4) ? sK : sQ;
      bf16x8 a[4];
#pragma unroll
      for (int ks = 0; ks < 4; ++ks) { const int row = mi * 16 + lr; a[ks] = *(const bf16x8*)(sAop + row * 256 + (((ks * 4 + g) ^ (row & 15)) << 4)); }
#pragma unroll
      for (int ni = 0; ni < 4; ++ni) {
        f32x4 d = (f32x4){0.f, 0.f, 0.f, 0.f};
#pragma unroll
        for (int ks = 0; ks < 4; ++ks) { const int row = ni * 16 + lr; const bf16x8 bb = *(const bf16x8*)(sK + row * 256 + (((ks * 4 + g) ^ (row & 15)) << 4)); d = mfma16(a[ks], bb, d); }
        const int j = ni * 16 + lr; const float gj = sG[j];
#pragma unroll
        for (int r = 0; r < 4; ++r) {
          const int i = mi * 16 + g * 4 + r; const float gi = sG[i];
          if (wv < 4) { sMT[j * 68 + i] = (j < i) ? sG[64 + i] * d[r] * __expf(gi - gj) : 0.f; }
          else { const float v = (j <= i) ? d[r] * __expf(gi - gj) : 0.f; sI[i * 64 + perm32_pos(j)] = f2bf(v); }
        }
      }
    }
    __syncthreads();
    if (wv == 0) {
      const int bi = lane >> 4, c = lane & 15;
      float t[16];
#pragma unroll
      for (int r = 0; r < 16; ++r) t[r] = (r == c) ? 1.f : 0.f;
#pragma unroll
      for (int q = 0; q < 15; ++q) {
        const float* mcol = sMT + (bi * 16 + q) * 68 + bi * 16;
        float m[16];
#pragma unroll
        for (int q4 = (q + 1) >> 2; q4 < 4; ++q4) { const float4 tt = *(const float4*)(mcol + q4 * 4); m[q4 * 4] = tt.x; m[q4 * 4 + 1] = tt.y; m[q4 * 4 + 2] = tt.z; m[q4 * 4 + 3] = tt.w; }
#pragma unroll
        for (int r = q + 1; r < 16; ++r) t[r] = fmaf(-m[r], t[q], t[r]);
      }
#pragma unroll
      for (int r = 0; r < 16; ++r) sT[bi * 272 + r * 17 + c] = t[r];
    } else if (wv <= 4) {
      const int t2 = tid - 64;
      const float glast = sG[63];
      {
        const int row = t2 >> 2, blk = t2 & 3;
        const float eg = __expf(sG[row]);
        float e[32];
#pragma unroll
        for (int c4 = 0; c4 < 4; ++c4) {
          const u32x4 v = *(const u32x4*)(sQ + row * 256 + (((blk * 4 + c4) ^ (row & 15)) << 4));
#pragma unroll
          for (int k = 0; k < 4; ++k) { e[c4 * 8 + 2 * k] = lo2f(v[k]) * eg; e[c4 * 8 + 2 * k + 1] = hi2f(v[k]) * eg; }
        }
#pragma unroll
        for (int gq = 0; gq < 4; ++gq) {
          u32x4 o;
#pragma unroll
          for (int k = 0; k < 4; ++k) { const int j0 = 2 * k, j1 = 2 * k + 1; o[k] = pack2(e[16 * (j0 >> 2) + 4 * gq + (j0 & 3)], e[16 * (j1 >> 2) + 4 * gq + (j1 & 3)]); }
          *(u32x4*)(tq + row * 128 + blk * 32 + gq * 8) = o;
        }
      }
      {
        const int dk = t2 >> 1, blk = t2 & 1;
        float e[32];
#pragma unroll
        for (int ii = 0; ii < 32; ++ii) {
          const int i = blk * 32 + ii;
          e[ii] = bf2f(*(const u16*)(sK + i * 256 + (((dk >> 3) ^ (i & 15)) << 4) + (dk & 7) * 2)) * __expf(glast - sG[i]);
        }
#pragma unroll
        for (int gq = 0; gq < 4; ++gq) {
          u32x4 o;
#pragma unroll
          for (int k = 0; k < 4; ++k) { const int j0 = 2 * k, j1 = 2 * k + 1; o[k] = pack2(e[16 * (j0 >> 2) + 4 * gq + (j0 & 3)], e[16 * (j1 >> 2) + 4 * gq + (j1 & 3)]); }
          *(u32x4*)(tk + dk * 64 + blk * 32 + gq * 8) = o;
        }
      }
#pragma unroll
      for (int k = 0; k < 2; ++k) { const int q = t2 + k * 256; *(u32x4*)(intra + (long)u * 4096 + q * 8) = *(const u32x4*)(sI + q * 8); }
      if (t2 == 0) cdec[u] = __expf(glast);
    }
    __syncthreads();
    if (u + nblk < 2048) {
      const int u2 = u + nblk; const int bh2 = u2 >> 7, ch2 = u2 & 127;
      const long tb2 = ((long)bh2 * 8192 + ch2 * 64) * 128;
#pragma unroll
      for (int k = 0; k < 6; ++k) {
        const int i = tid + k * NTHR;
        const int which = i >> 10, q = i & 1023;
        pre[k] = *(const u32x4*)(qkv + (long)which * (16l * 8192 * 128) + tb2 + q * 8);
      }
      if (tid < 64) { pgv = gg[(long)bh2 * 8192 + ch2 * 64 + tid]; pbv = bt[(long)bh2 * 8192 + ch2 * 64 + tid]; }
    }
    {
      const bool isv = wv < 4;
      const char* sSrc = isv ? sV : sK;
      f32x4 X[4][2];
#pragma unroll
      for (int bi = 0; bi < 4; ++bi) {
        f32x4 acc[2];
#pragma unroll
        for (int ct = 0; ct < 2; ++ct) {
          const int cc = (wv & 3) * 32 + ct * 16 + lr;
#pragma unroll
          for (int r = 0; r < 4; ++r) {
            const int i = bi * 16 + g * 4 + r;
            const float raw = bf2f(*(const u16*)(sSrc + i * 256 + (((cc >> 3) ^ (i & 15)) << 4) + (cc & 7) * 2));
            acc[ct][r] = raw * sG[64 + i] * (isv ? 1.f : __expf(sG[i]));
          }
        }
#pragma unroll
        for (int bj = 0; bj < bi; ++bj)
#pragma unroll
          for (int s4 = 0; s4 < 4; ++s4) {
            const float a = -sMT[(bj * 16 + 4 * g + s4) * 68 + bi * 16 + lr];
            acc[0] = __builtin_amdgcn_mfma_f32_16x16x4f32(a, X[bj][0][s4], acc[0], 0, 0, 0);
            acc[1] = __builtin_amdgcn_mfma_f32_16x16x4f32(a, X[bj][1][s4], acc[1], 0, 0, 0);
          }
        f32x4 x0 = (f32x4){0.f, 0.f, 0.f, 0.f}, x1 = (f32x4){0.f, 0.f, 0.f, 0.f};
#pragma unroll
        for (int s4 = 0; s4 < 4; ++s4) {
          const float a = sT[bi * 272 + lr * 17 + 4 * g + s4];
          x0 = __builtin_amdgcn_mfma_f32_16x16x4f32(a, acc[0][s4], x0, 0, 0, 0);
          x1 = __builtin_amdgcn_mfma_f32_16x16x4f32(a, acc[1][s4], x1, 0, 0, 0);
        }
        X[bi][0] = x0; X[bi][1] = x1;
#pragma unroll
        for (int r = 0; r < 4; ++r) {
          sX[(bi * 16 + g * 4 + r) * 257 + wv * 32 + lr] = x0[r];
          sX[(bi * 16 + g * 4 + r) * 257 + wv * 32 + 16 + lr] = x1[r];
        }
      }
    }
    __syncthreads();
    for (int it = tid; it < 2048; it += NTHR) {
      u32x4 o;
      if (it < 1024) {
        const int c = it >> 3, i0 = (it & 7) * 8;
#pragma unroll
        for (int k = 0; k < 4; ++k) o[k] = pack2(sX[(i0 + 2 * k) * 257 + c], sX[(i0 + 2 * k + 1) * 257 + c]);
        *(u32x4*)(tv + c * 64 + i0) = o;
      } else {
        const int q = it - 1024, row = q >> 4, pch = q & 15, b32 = pch >> 2, gq = pch & 3;
        const float* xr = sX + row * 257 + 128 + b32 * 32 + 4 * gq;
#pragma unroll
        for (int k = 0; k < 4; ++k) { const int j0 = 2 * k, j1 = 2 * k + 1; o[k] = pack2(xr[16 * (j0 >> 2) + (j0 & 3)], xr[16 * (j1 >> 2) + (j1 & 3)]); }
        *(u32x4*)(wdn + tbase + row * 128 + pch * 8) = o;
      }
    }
  }
}

#define SCAN_BUF 73728
__device__ __forceinline__ void dn_scan_phase(const Params& P, char* smem, int bid, int nblk) {
  const int tidx = otid();
  const int tid = tidx, lane = tid & 63, wv = tid >> 6, lr = lane & 15, g = lane >> 4;
  const u16* qkv = (const u16*)(P.ws + OFF_QKV);
  const u16* wdn = (const u16*)(P.ws + OFF_WDN); const u16* intra = (const u16*)(P.ws + OFF_INTRA);
  const float* cdec = (const float*)(P.ws + OFF_GB) + 32 * 8192;
  u16* mix = (u16*)(P.ws + OFF_MIX);
  for (int bh = bid; bh < 16; bh += nblk) {
    const int b = bh >> 2, hh = bh & 3;
    f32x4 S[8];
#pragma unroll
    for (int i = 0; i < 8; ++i) S[i] = (f32x4){0.f, 0.f, 0.f, 0.f};
    u32x4 st[9];
    unsigned lofs[9];
#pragma unroll
    for (int i = 0; i < 9; ++i) {
      const int q = tid + i * NTHR;
      unsigned o;
      if (q < 1024) o = (unsigned)OFF_WDN + (unsigned)bh * (8192u * 256u) + q * 16;
      else if (q < 4096) o = (unsigned)OFF_QKV + (unsigned)((q >> 10) - 1) * (16u * 8192u * 256u) + (unsigned)bh * (8192u * 256u) + (q & 1023) * 16;
      else o = (unsigned)OFF_INTRA + (unsigned)bh * (128u * 8192u) + (q - 4096) * 16;
      lofs[i] = o;
    }
    const char* wsb = P.ws;
    auto load_chunk = [&](int n) {
#pragma unroll
      for (int i = 0; i < 9; ++i) {
        const unsigned stride = (i < 8) ? 16384u : 8192u;
        st[i] = *(const u32x4*)(wsb + (size_t)(lofs[i] + (unsigned)n * stride));
      }
    };
    auto store_chunk = [&](int bufi) {
      char* base = smem + bufi * SCAN_BUF;
#pragma unroll
      for (int i = 0; i < 9; ++i) {
        const int q = tid + i * NTHR;
        unsigned off;
        if (q < 2048) { const int qq = q & 1023, row = qq >> 4, chk = qq & 15; off = (q >> 10) * 16384 + row * 256 + ((chk ^ (row & 15)) << 4); }
        else if (q < 4096) { const int qq = q & 1023, row = qq >> 3, chk = qq & 7; off = (q >> 10) * 16384 + row * 128 + ((chk ^ (row & 7)) << 4); }
        else { const int qq = q - 4096, row = qq >> 3, chk = qq & 7; off = 65536 + row * 128 + ((chk ^ (row & 7)) << 4); }
        *(u32x4*)(base + off) = st[i];
      }
    };
    __syncthreads();
    load_chunk(0); store_chunk(0); load_chunk(1);
    __syncthreads();
    for (int n = 0; n < 128; ++n) {
      const char* base = smem + (n & 1) * SCAN_BUF;
      const char* sW = base; const char* sQd = base + 16384; const char* sKT = base + 32768; const char* sUT = base + 49152; const char* sA = base + 65536;
      if (n + 1 < 128) { store_chunk((n + 1) & 1); if (n + 2 < 128) load_chunk(n + 2); }
      const float dcy = cdec[bh * 128 + n];
      bf16x8 sb[4];
#pragma unroll
      for (int s = 0; s < 4; ++s)
#pragma unroll
        for (int j = 0; j < 8; ++j) sb[s][j] = (short)f2bf(S[2 * s + (j >> 2)][j & 3]);
      f32x4 vn[4], o[4];
#pragma unroll
      for (int mi = 0; mi < 4; ++mi) {
        f32x4 dw = (f32x4){0.f, 0.f, 0.f, 0.f}, dq = (f32x4){0.f, 0.f, 0.f, 0.f};
        const int row = mi * 16 + lr;
#pragma unroll
        for (int s = 0; s < 4; ++s) {
          const unsigned off = row * 256 + (((s * 4 + g) ^ (row & 15)) << 4);
          dw = mfma16(*(const bf16x8*)(sW + off), sb[s], dw);
          dq = mfma16(*(const bf16x8*)(sQd + off), sb[s], dq);
        }
        const int urow = wv * 16 + lr;
        const int ucol = mi * 16 + g * 4;
        const u32x2 uv = *(const u32x2*)(sUT + urow * 128 + ((((ucol >> 3)) ^ (urow & 7)) << 4) + (ucol & 7) * 2);
        vn[mi][0] = lo2f(uv[0]) - dw[0]; vn[mi][1] = hi2f(uv[0]) - dw[1]; vn[mi][2] = lo2f(uv[1]) - dw[2]; vn[mi][3] = hi2f(uv[1]) - dw[3];
        o[mi] = dq;
      }
      bf16x8 vb[2];
#pragma unroll
      for (int s = 0; s < 2; ++s)
#pragma unroll
        for (int j = 0; j < 8; ++j) vb[s][j] = (short)f2bf(vn[2 * s + (j >> 2)][j & 3]);
#pragma unroll
      for (int mi = 0; mi < 4; ++mi) {
        const int row = mi * 16 + lr;
#pragma unroll
        for (int s = 0; s < 2; ++s) o[mi] = mfma16(*(const bf16x8*)(sA + row * 128 + (((s * 4 + g) ^ (row & 7)) << 4)), vb[s], o[mi]);
      }
#pragma unroll
      for (int m2 = 0; m2 < 8; ++m2) {
        f32x4 d = S[m2];
#pragma unroll
        for (int r = 0; r < 4; ++r) d[r] *= dcy;
        const int row = m2 * 16 + lr;
#pragma unroll
        for (int s = 0; s < 2; ++s) d = mfma16(*(const bf16x8*)(sKT + row * 128 + (((s * 4 + g) ^ (row & 7)) << 4)), vb[s], d);
        S[m2] = d;
      }
#pragma unroll
      for (int mi = 0; mi < 4; ++mi)
#pragma unroll
        for (int r = 0; r < 4; ++r) {
          const long t = (long)b * 8192 + n * 64 + mi * 16 + g * 4 + r;
          mix[t * 1024 + 512 + hh * 128 + wv * 16 + lr] = f2bf(o[mi][r]);
        }
      __syncthreads();
    }
  }
}

__device__ __forceinline__ void dn_gate_phase(const Params& P, int bid, int nblk) {
  const int tidx = otid();
  const int lane = tidx & 63, wv = tidx >> 6, hh = lane >> 4, cg = lane & 15;
  u16* mix = (u16*)(P.ws + OFF_MIX); const u16* bz = (const u16*)(P.ws + OFF_BZ);
  for (int t = bid * 8 + wv; t < T_TOK; t += nblk * 8) {
    u16* p = mix + (long)t * 1024 + 512 + hh * 128 + cg * 8;
    const u32x4 ov = *(const u32x4*)p; const u32x4 zv = *(const u32x4*)(bz + (long)t * 512 + hh * 128 + cg * 8);
    float o[8], z[8];
#pragma unroll
    for (int e = 0; e < 4; ++e) { o[2 * e] = lo2f(ov[e]); o[2 * e + 1] = hi2f(ov[e]); z[2 * e] = lo2f(zv[e]); z[2 * e + 1] = hi2f(zv[e]); }
    float ss = 0.f;
#pragma unroll
    for (int e = 0; e < 8; ++e) ss += o[e] * o[e];
    ss += sx(ss, 1); ss += sx(ss, 2); ss += sx(ss, 4); ss += sx(ss, 8);
    const float rs = rsqrtf(ss * (1.f / 128) + EPSV);
    u32x4 r;
#pragma unroll
    for (int e = 0; e < 4; ++e) {
      const float a = o[2 * e] * rs * P.g_onorm[cg * 8 + 2 * e] * (z[2 * e] / (1.f + __expf(-z[2 * e])));
      const float bq = o[2 * e + 1] * rs * P.g_onorm[cg * 8 + 2 * e + 1] * (z[2 * e + 1] / (1.f + __expf(-z[2 * e + 1])));
      r[e] = pack2(a, bq);
    }
    *(u32x4*)p = r;
  }
}

__device__ __forceinline__ void xattn_phase(const Params& P, char* smem, int bid, int nblk) {
  const int tidx = otid();
  const int tid = tidx, lane = tid & 63, wv = tid >> 6, lr = lane & 15, g = lane >> 4;
  const u16* qx = (const u16*)(P.ws + OFF_QX); const u16* kx = (const u16*)(P.ws + OFF_KX); const u16* vtx = (const u16*)(P.ws + OFF_VTX);
  u16* ox = (u16*)(P.ws + OFF_OX);
  char* sK = smem; char* sVT = smem + 65536;
  for (int u4 = bid; u4 < 256; u4 += nblk) {
    const int bh = u4 >> 4, b = bh >> 2, hh = bh & 3, grp = u4 & 15;
    __syncthreads();
    for (int i = tid; i < 4096; i += NTHR) {
      const int row = i >> 4, ch = i & 15;
      *(u32x4*)(sK + row * 256 + ((ch ^ (row & 15)) << 4)) = *(const u32x4*)(kx + (long)(b * 256 + row) * 512 + hh * 128 + ch * 8);
    }
    for (int i = tid; i < 4096; i += NTHR) {
      const int row = i >> 5, ch = i & 31;
      *(u32x4*)(sVT + row * 512 + ((ch ^ (row & 15)) << 4)) = *(const u32x4*)(vtx + ((long)b * 512 + hh * 128 + row) * 256 + ch * 8);
    }
    __syncthreads();
    const LAS char* kbs[4]; const LAS char* vbs[8];
#pragma unroll
    for (int ks = 0; ks < 4; ++ks) kbs[ks] = (const LAS char*)sK + lr * 256 + (((ks * 4 + g) ^ lr) << 4);
#pragma unroll
    for (int s2 = 0; s2 < 8; ++s2) vbs[s2] = (const LAS char*)sVT + lr * 512 + (((s2 * 4 + g) ^ lr) << 4);
#pragma unroll 1
    for (int qt = 0; qt < 4; ++qt) {
      asm volatile("" ::: "memory");
      const int t0 = b * 8192 + grp * 512 + qt * 128 + wv * 16;
      bf16x8 bq[4];
#pragma unroll
      for (int ks = 0; ks < 4; ++ks) bq[ks] = *(const bf16x8*)(qx + (long)(t0 + lr) * 512 + hh * 128 + ks * 32 + g * 8);
      f32x4 S[16];
      float mx = -3.0e38f;
#pragma unroll
      for (int m = 0; m < 16; ++m) {
        f32x4 d = (f32x4){0.f, 0.f, 0.f, 0.f};
#pragma unroll
        for (int ks = 0; ks < 4; ++ks) { const bf16x8 a = *(const LAS bf16x8*)(kbs[ks] + m * 4096); d = mfma16(a, bq[ks], d); }
        S[m] = d;
#pragma unroll
        for (int r = 0; r < 4; ++r) mx = fmaxf(mx, d[r]);
      }
      mx = fmaxf(mx, sx(mx, 16)); mx = fmaxf(mx, sx(mx, 32));
      float sum = 0.f;
#pragma unroll
      for (int m = 0; m < 16; ++m)
#pragma unroll
        for (int r = 0; r < 4; ++r) { S[m][r] = __expf(S[m][r] - mx); sum += S[m][r]; }
      sum += sx(sum, 16); sum += sx(sum, 32);
      const float inv = 1.f / sum;
      bf16x8 pb[8];
#pragma unroll
      for (int s2 = 0; s2 < 8; ++s2)
#pragma unroll
        for (int j = 0; j < 8; ++j) pb[s2][j] = (short)f2bf(S[2 * s2 + (j >> 2)][j & 3]);
#pragma unroll
      for (int dt = 0; dt < 8; ++dt) {
        f32x4 o = (f32x4){0.f, 0.f, 0.f, 0.f};
#pragma unroll
        for (int s2 = 0; s2 < 8; ++s2) { const bf16x8 a = *(const LAS bf16x8*)(vbs[s2] + dt * 8192); o = mfma16(a, pb[s2], o); }
        u32x2 w; w[0] = pack2(o[0] * inv, o[1] * inv); w[1] = pack2(o[2] * inv, o[3] * inv);
        *(u32x2*)(ox + (long)(t0 + lr) * 512 + hh * 128 + dt * 16 + g * 4) = w;
      }
    }
  }
}

__device__ __forceinline__ void g6_phase(const Params& P, char* smem, int bid, int nblk) {
  const int tidx = otid();
  const u16* A = (const u16*)(P.ws + OFF_H); const u16* Bt = (const u16*)(P.ws + OFF_WEFFT);
  unsigned* plist = (unsigned*)(P.ws + OFF_PLIST);
  const int tid = tidx;
  for (int t = bid; t < 128 * 16; t += nblk) {
    const int mp = t >> 4, np = t & 15;
    gemm_tile<133>(A + (long)mp * 256 * DM, DM, Bt + (long)np * 128 * DM, DM, DM, smem);
    const float* sC = (const float*)smem;
    const int row = tid >> 1, half = tid & 1;
    const float rs2 = rsqrtf(((const float*)(P.ws + OFF_SSQ2))[mp * 256 + row] * (1.f / DM) + EPSV);
    unsigned tk[16];
#pragma unroll
    for (int i = 0; i < 16; ++i) tk[i] = 0u;
    for (int i = 0; i < 64; ++i) {
      const int c = half * 64 + ((i + half * 16) & 63);
      const unsigned key = (fkey(sC[row * 133 + c] * rs2) & ~127u) | (unsigned)(127 - c);
#pragma unroll
      for (int s = 15; s >= 1; --s) tk[s] = umed3(tk[s - 1], tk[s], key);
      tk[0] = tk[0] > key ? tk[0] : key;
    }
#pragma unroll
    for (int i = 0; i < 16; ++i) {
      const unsigned key = sx(tk[i], 1);
      if (half == 0) {
#pragma unroll
        for (int s = 15; s >= 1; --s) tk[s] = umed3(tk[s - 1], tk[s], key);
        tk[0] = tk[0] > key ? tk[0] : key;
      }
    }
    if (half == 0) {
      unsigned* dst = plist + ((long)(mp * 256 + row) * 16 + np) * 16;
#pragma unroll
      for (int i = 0; i < 4; ++i) { u32x4 o; o[0] = tk[4 * i]; o[1] = tk[4 * i + 1]; o[2] = tk[4 * i + 2]; o[3] = tk[4 * i + 3]; *(u32x4*)(dst + 4 * i) = o; }
    }
  }
}

__device__ __forceinline__ void peer_top16_phase(const Params& P, int bid, int nblk) {
  const int tidx = otid();
  const u16* psc = (const u16*)(P.ws + OFF_PSC);
  unsigned* plist = (unsigned*)(P.ws + OFF_PLIST);
  for (int gid = bid * NTHR + tidx; gid < T_TOK * 16; gid += nblk * NTHR) {
    const u16* src = psc + (long)gid * 128;
    unsigned tk[16];
#pragma unroll
    for (int i = 0; i < 16; ++i) tk[i] = 0u;
#pragma unroll 1
    for (int c8 = 0; c8 < 16; ++c8) {
      const u32x4 v = *(const u32x4*)(src + c8 * 8);
#pragma unroll
      for (int e = 0; e < 8; ++e) {
        const unsigned bits = (e & 1) ? (v[e >> 1] & 0xffff0000u) : (v[e >> 1] << 16);
        const unsigned m = bits ^ ((bits >> 31) ? 0xffffffffu : 0x80000000u);
        const unsigned key = (m & ~127u) | (unsigned)(127 - (c8 * 8 + e));
#pragma unroll
        for (int q = 15; q >= 1; --q) tk[q] = umed3(tk[q - 1], tk[q], key);
        tk[0] = tk[0] > key ? tk[0] : key;
      }
    }
    unsigned* dst = plist + (long)gid * 16;
#pragma unroll
    for (int i = 0; i < 4; ++i) { u32x4 o; o[0] = tk[4 * i]; o[1] = tk[4 * i + 1]; o[2] = tk[4 * i + 2]; o[3] = tk[4 * i + 3]; *(u32x4*)(dst + 4 * i) = o; }
  }
}
__device__ __forceinline__ void peer_combine_phase(const Params& P, char* smem, int bid, int nblk) {
  const int tidx = otid();
  const int tid = tidx;
  const unsigned* plist = (const unsigned*)(P.ws + OFF_PLIST);
  u16* pe = (u16*)(P.ws + OFF_PEIDX); float* pg = (float*)(P.ws + OFF_PGATE);
  unsigned* skeys = (unsigned*)smem + tid * 33;
  for (int gid = bid * NTHR + tid; gid < T_TOK * 8; gid += nblk * NTHR) {
    const unsigned* src = plist + (long)gid * 32;
    unsigned k1[16], k2[16];
#pragma unroll
    for (int q = 0; q < 4; ++q) {
      const u32x4 a = *(const u32x4*)(src + q * 4), c = *(const u32x4*)(src + 16 + q * 4);
      k1[4 * q] = a[0]; k1[4 * q + 1] = a[1]; k1[4 * q + 2] = a[2]; k1[4 * q + 3] = a[3];
      k2[4 * q] = c[0]; k2[4 * q + 1] = c[1]; k2[4 * q + 2] = c[2]; k2[4 * q + 3] = c[3];
    }
#pragma unroll
    for (int i = 0; i < 16; ++i) { skeys[i] = k1[i]; skeys[16 + i] = k2[i]; }
    float s1[16], s2[16];
#pragma unroll
    for (int i = 0; i < 16; ++i) { s1[i] = keyf(k1[i] & ~127u); s2[i] = keyf(k2[i] & ~127u); }
    unsigned tk[16];
#pragma unroll
    for (int i = 0; i < 16; ++i) tk[i] = 0u;
#pragma unroll
    for (int i = 0; i < 16; ++i)
#pragma unroll
      for (int j = 0; j < 16; ++j)
        if ((i + 1) * (j + 1) <= 16) {
          const unsigned key = (fkey(s1[i] + s2[j]) & ~255u) | (unsigned)(255 - (i * 16 + j));
#pragma unroll
          for (int s = 15; s >= 1; --s) tk[s] = umed3(tk[s - 1], tk[s], key);
          tk[0] = tk[0] > key ? tk[0] : key;
        }
    float best[16]; unsigned ex[16]; float mx = -3.0e38f;
#pragma unroll
    for (int k = 0; k < 16; ++k) {
      const int cid = 255 - (int)(tk[k] & 255u); const int i = cid >> 4, j = cid & 15;
      const unsigned ka = skeys[i], kb2 = skeys[16 + j];
      best[k] = keyf(ka & ~127u) + keyf(kb2 & ~127u);
      ex[k] = (unsigned)((127 - (int)(ka & 127u)) * 128 + (127 - (int)(kb2 & 127u)));
      mx = fmaxf(mx, best[k]);
    }
    float sm = 0.f;
#pragma unroll
    for (int k = 0; k < 16; ++k) { best[k] = __expf(best[k] - mx); sm += best[k]; }
    const float inv = 1.f / sm;
#pragma unroll
    for (int k4 = 0; k4 < 4; ++k4) { float4 o; o.x = best[4 * k4] * inv; o.y = best[4 * k4 + 1] * inv; o.z = best[4 * k4 + 2] * inv; o.w = best[4 * k4 + 3] * inv; *(float4*)(pg + (long)gid * 16 + 4 * k4) = o; }
#pragma unroll
    for (int k8 = 0; k8 < 2; ++k8) {
      u32x4 o;
#pragma unroll
      for (int e = 0; e < 4; ++e) o[e] = ex[8 * k8 + 2 * e] | (ex[8 * k8 + 2 * e + 1] << 16);
      *(u32x4*)(pe + (long)gid * 16 + 8 * k8) = o;
    }
  }
}
__device__ __forceinline__ void peer_fused_phase(const Params& P, char* smem, int bid, int nblk) {
  const int tidx = otid();
  const int tid = tidx, lane = tid & 63, wv = tid >> 6;
  const u16* psc = (const u16*)(P.ws + OFF_PSC);
  const u16* h3 = (const u16*)(P.ws + OFF_H);
  const unsigned char* ue = (const unsigned char*)(P.ws + OFF_UEMB); const unsigned char* ve = (const unsigned char*)(P.ws + OFF_VEMB);
  const float* uscl = (const float*)(P.ws + OFF_USCL); const float* vscl = (const float*)(P.ws + OFF_VSCL);
  unsigned* sL = (unsigned*)smem;
  u16* sE = (u16*)(smem + 32768);
  float* sG = (float*)(smem + 65536);
  for (int tb = bid * 128; tb < T_TOK; tb += nblk * 128) {
#pragma unroll 1
    for (int c = 0; c < 4; ++c) {
      __syncthreads();
      {
        const long gid = (long)(tb + c * 32) * 16 + tid;
        const u16* src = psc + gid * 128;
        unsigned tk[16];
#pragma unroll
        for (int i = 0; i < 16; ++i) tk[i] = 0u;
#pragma unroll 1
        for (int c8 = 0; c8 < 16; ++c8) {
          const u32x4 v = *(const u32x4*)(src + c8 * 8);
#pragma unroll
          for (int e = 0; e < 8; ++e) {
            const unsigned bits = (e & 1) ? (v[e >> 1] & 0xffff0000u) : (v[e >> 1] << 16);
            const unsigned m = bits ^ ((bits >> 31) ? 0xffffffffu : 0x80000000u);
            const unsigned key = (m & ~127u) | (unsigned)(127 - (c8 * 8 + e));
#pragma unroll
            for (int q = 15; q >= 1; --q) tk[q] = umed3(tk[q - 1], tk[q], key);
            tk[0] = tk[0] > key ? tk[0] : key;
          }
        }
#pragma unroll
        for (int i = 0; i < 4; ++i) { u32x4 o; o[0] = tk[4 * i]; o[1] = tk[4 * i + 1]; o[2] = tk[4 * i + 2]; o[3] = tk[4 * i + 3]; *(u32x4*)(sL + tid * 16 + 4 * i) = o; }
      }
      __syncthreads();
      if (tid < 256) {
        const unsigned* kk = sL + tid * 32;
        float s1[16], s2[16];
#pragma unroll
        for (int i = 0; i < 16; ++i) { s1[i] = keyf(kk[i] & ~127u); s2[i] = keyf(kk[16 + i] & ~127u); }
        unsigned tk[16];
#pragma unroll
        for (int i = 0; i < 16; ++i) tk[i] = 0u;
#pragma unroll
        for (int i = 0; i < 16; ++i)
#pragma unroll
          for (int j = 0; j < 16; ++j)
            if ((i + 1) * (j + 1) <= 16) {
              const unsigned key = (fkey(s1[i] + s2[j]) & ~255u) | (unsigned)(255 - (i * 16 + j));
#pragma unroll
              for (int q = 15; q >= 1; --q) tk[q] = umed3(tk[q - 1], tk[q], key);
              tk[0] = tk[0] > key ? tk[0] : key;
            }
        float best[16]; unsigned ex[16]; float mx = -3.0e38f;
#pragma unroll
        for (int k = 0; k < 16; ++k) {
          const int cid = 255 - (int)(tk[k] & 255u); const int i = cid >> 4, j = cid & 15;
          const unsigned ka = kk[i], kb2 = kk[16 + j];
          best[k] = keyf(ka & ~127u) + keyf(kb2 & ~127u);
          ex[k] = (unsigned)((127 - (int)(ka & 127u)) * 128 + (127 - (int)(kb2 & 127u)));
          mx = fmaxf(mx, best[k]);
        }
        float sm = 0.f;
#pragma unroll
        for (int k = 0; k < 16; ++k) { best[k] = __expf(best[k] - mx); sm += best[k]; }
        const float inv = 1.f / sm;
        const int eo = (c * 32 + (tid >> 3)) * 128 + (tid & 7) * 16;
#pragma unroll
        for (int k4 = 0; k4 < 4; ++k4) { float4 o; o.x = best[4 * k4] * inv; o.y = best[4 * k4 + 1] * inv; o.z = best[4 * k4 + 2] * inv; o.w = best[4 * k4 + 3] * inv; *(float4*)(sG + eo + 4 * k4) = o; }
#pragma unroll
        for (int k8 = 0; k8 < 2; ++k8) {
          u32x4 o;
#pragma unroll
          for (int e = 0; e < 4; ++e) o[e] = ex[8 * k8 + 2 * e] | (ex[8 * k8 + 2 * e + 1] << 16);
          *(u32x4*)(sE + eo + 8 * k8) = o;
        }
      }
    }
    __syncthreads();
#pragma unroll 1
    for (int it = 0; it < 16; ++it) {
      const int tl = it * 8 + wv, t = tb + tl;
      const u16* sidx = sE + tl * 128; const float* sgate = sG + tl * 128;
    const float rs2t = rsqrtf(((const float*)(P.ws + OFF_SSQ2))[t] * (1.f / DM) + EPSV);
    int xh0 = 0, xh1 = 0, xl0 = 0, xl1 = 0; float sxq;
    {
      const u32x4 v0 = *(const u32x4*)(h3 + (long)t * DM + lane * 16), v1 = *(const u32x4*)(h3 + (long)t * DM + lane * 16 + 8);
      float xa[16];
#pragma unroll
      for (int e = 0; e < 4; ++e) { xa[2 * e] = lo2f(v0[e]); xa[2 * e + 1] = hi2f(v0[e]); xa[8 + 2 * e] = lo2f(v1[e]); xa[8 + 2 * e + 1] = hi2f(v1[e]); }
      float am = 0.f;
#pragma unroll
      for (int e = 0; e < 16; ++e) am = fmaxf(am, fabsf(xa[e]));
#pragma unroll
      for (int o = 32; o >= 1; o >>= 1) am = fmaxf(am, sx(am, o));
      sxq = am > 0.f ? am * (1.f / 119.f) : 1.f;
      const float inv = 1.f / sxq;
#pragma unroll
      for (int e = 0; e < 16; ++e) {
        const int qv = (int)rintf(xa[e] * inv);
        const int lo = ((qv + 8) & 15) - 8, hi = (qv - lo) >> 4;
        const int sh4 = 4 * (e & 7);
        if (e < 8) { xl0 |= (lo & 15) << sh4; xh0 |= (hi & 15) << sh4; } else { xl1 |= (lo & 15) << sh4; xh1 |= (hi & 15) << sh4; }
      }
    }
    f32x2 acc2[8];
#pragma unroll
    for (int e = 0; e < 8; ++e) acc2[e] = (f32x2){0.f, 0.f};
    const int myk = ((lane >> 5) & 1) * 8 + ((lane >> 4) & 1) * 4 + ((lane >> 3) & 1) * 2 + ((lane >> 2) & 1);
    for (int bt = 0; bt < 8; ++bt) {
      u32x2 uu[16], vv[16];
#pragma unroll
      for (int k = 0; k < 16; ++k) {
        const unsigned eo = sidx[bt * 16 + k] * 512u + (unsigned)lane * 8u;
        uu[k] = *(const u32x2*)(ue + (size_t)eo);
        vv[k] = *(const u32x2*)(ve + (size_t)eo);
      }
      const unsigned emy = sidx[bt * 16 + myk];
      const float su = uscl[emy], sv = vscl[emy];
      int pd[16];
#pragma unroll
      for (int k = 0; k < 16; ++k) {
        int ah = __builtin_amdgcn_sdot8((int)uu[k][0], xh0, 0, false); ah = __builtin_amdgcn_sdot8((int)uu[k][1], xh1, ah, false);
        int al = __builtin_amdgcn_sdot8((int)uu[k][0], xl0, 0, false); al = __builtin_amdgcn_sdot8((int)uu[k][1], xl1, al, false);
        pd[k] = (ah << 4) + al;
      }
      int r8[8], r4[4], r2[2], r1;
      {
        const bool u5 = (lane & 32) != 0, u4 = (lane & 16) != 0, u3 = (lane & 8) != 0, u2 = (lane & 4) != 0;
#pragma unroll
        for (int k = 0; k < 8; ++k) { const int mine = u5 ? pd[k + 8] : pd[k]; const int oth = u5 ? pd[k] : pd[k + 8]; r8[k] = mine + sx(oth, 32); }
#pragma unroll
        for (int k = 0; k < 4; ++k) { const int mine = u4 ? r8[k + 4] : r8[k]; const int oth = u4 ? r8[k] : r8[k + 4]; r4[k] = mine + sx(oth, 16); }
#pragma unroll
        for (int k = 0; k < 2; ++k) { const int mine = u3 ? r4[k + 2] : r4[k]; const int oth = u3 ? r4[k] : r4[k + 2]; r2[k] = mine + sx(oth, 8); }
        { const int mine = u2 ? r2[1] : r2[0]; const int oth = u2 ? r2[0] : r2[1]; r1 = mine + sx(oth, 4); }
        r1 += sx(r1, 2); r1 += sx(r1, 1);
      }
      const float dot = (float)r1 * (su * sxq) * rs2t;
      const float act = 0.5f * dot * (1.f + erff(dot * 0.7071067811865475f));
      const float coef = sgate[bt * 16 + myk] * act * sv;
#pragma unroll
      for (int k = 0; k < 16; ++k) {
        const int srcl = ((k >> 3) & 1) * 32 + ((k >> 2) & 1) * 16 + ((k >> 1) & 1) * 8 + (k & 1) * 4;
        const float ck = sh(coef, srcl);
        const f32x2 ck2 = (f32x2){ck, ck};
#pragma unroll
        for (int d = 0; d < 2; ++d) {
#define PEER_V(BS) { const f32x2 q = __builtin_amdgcn_cvt_scalef32_pk_f32_fp4(vv[k][d], 1.0f, BS); acc2[4 * d + BS] = __builtin_elementwise_fma(ck2, q, acc2[4 * d + BS]); }
          PEER_V(0) PEER_V(1) PEER_V(2) PEER_V(3)
#undef PEER_V
        }
      }
    }
    float acc[16];
#pragma unroll
    for (int e = 0; e < 8; ++e) { acc[2 * e] = acc2[e][0]; acc[2 * e + 1] = acc2[e][1]; }
    float* orow = P.out + (long)t * DM + lane * 16;
    float xr[16]; float ss = 0.f;
#pragma unroll
    for (int q = 0; q < 4; ++q) {
      const float4 v = *(const float4*)(orow + q * 4);
      xr[q * 4 + 0] = v.x + acc[q * 4 + 0]; xr[q * 4 + 1] = v.y + acc[q * 4 + 1]; xr[q * 4 + 2] = v.z + acc[q * 4 + 2]; xr[q * 4 + 3] = v.w + acc[q * 4 + 3];
    }
#pragma unroll
    for (int e = 0; e < 16; ++e) ss += xr[e] * xr[e];
    ss = wave_sum(ss);
    const float rs = rsqrtf(ss * (1.f / DM) + EPSV);
#pragma unroll
    for (int q = 0; q < 4; ++q) {
      const float4 gf = *(const float4*)(P.g_final + lane * 16 + q * 4);
      float4 o; o.x = xr[q * 4 + 0] * rs * gf.x; o.y = xr[q * 4 + 1] * rs * gf.y; o.z = xr[q * 4 + 2] * rs * gf.z; o.w = xr[q * 4 + 3] * rs * gf.w;
      *(float4*)(orow + q * 4) = o;
    }
    }
  }
}

#define XB_TMO      128
#define XB_XCNT(j)  (256  + 64 * (j))
#define XB_XSUB(j)  (1280 + 64 * (j))
#define XB_XGEN(j)  (2304 + 64 * (j))
#define XB_TOP      3328
#define XB_TOPGEN   3392
#define XCD_BAR_WORDS 3456
#define XB_SPIN_CAP (1u << 18)

__device__ __forceinline__ unsigned xb_ld(unsigned* p)              { return __hip_atomic_load(p, __ATOMIC_RELAXED, __HIP_MEMORY_SCOPE_AGENT); }
__device__ __forceinline__ unsigned xb_add(unsigned* p, unsigned v) { return __hip_atomic_fetch_add(p, v, __ATOMIC_RELAXED, __HIP_MEMORY_SCOPE_AGENT); }
__device__ __forceinline__ unsigned xb_xcc_id() { return (unsigned)__builtin_amdgcn_s_getreg((3 << 11) | 20) & 0xFu; }
#define XB_SPIN(cond, bar) do { unsigned _sp = 0; while (cond) { __builtin_amdgcn_s_sleep(1); \
    if ((++_sp & 255u) == 0u) { if (xb_ld(&(bar)[XB_TMO])) break; if (_sp > XB_SPIN_CAP) { atomicAdd(&(bar)[XB_TMO], 1u); break; } } } } while (0)

struct XcdBarrier {
    unsigned* bar; unsigned x;
    volatile LAS unsigned* st;
};

__device__ __forceinline__ XcdBarrier xcd_barrier_post(unsigned* bar, volatile LAS unsigned* st) {
    XcdBarrier b; b.bar = bar; b.x = xb_xcc_id(); b.st = st;
    if (threadIdx.x == 0) (void)xb_add(&bar[XB_XCNT(b.x)], 1u);
    return b;
}
__device__ __forceinline__ void xcd_barrier_complete(unsigned* bar, unsigned x, unsigned& nloc, unsigned& nx) {
    const unsigned G = gridDim.x * gridDim.y * gridDim.z;
    unsigned sum, cnt, mine, sp = 0u;
    for (;;) {
        sum = 0u; cnt = 0u; mine = 0u;
#pragma unroll
        for (unsigned j = 0; j < 16; ++j) { const unsigned c = xb_ld(&bar[XB_XCNT(j)]); sum += c; cnt += (c > 0u) ? 1u : 0u; mine = (j == x) ? c : mine; }
        if (sum == G) break;
        __builtin_amdgcn_s_sleep(1);
        if ((++sp & 255u) == 0u) { if (xb_ld(&bar[XB_TMO])) break; if (sp > XB_SPIN_CAP) { atomicAdd(&bar[XB_TMO], 1u); break; } }
    }
    nloc = mine > 0u ? mine : 1u; nx = cnt > 0u ? cnt : 1u;
}

__device__ __forceinline__ void xcd_barrier(const XcdBarrier& b) {
    asm volatile("s_waitcnt vmcnt(0)" ::: "memory");
    __syncthreads();
    if (threadIdx.x == 0) {
        unsigned* bar = b.bar;
        __builtin_amdgcn_s_waitcnt(0);
        unsigned nloc = b.st[0], nx = b.st[1];
        if (nloc == 0u) { xcd_barrier_complete(bar, b.x, nloc, nx); b.st[0] = nloc; b.st[1] = nx; }
        const unsigned old = xb_add(&bar[XB_XSUB(b.x)], 1u);
        const unsigned gen = old / nloc;
        if (old + 1u == (gen + 1u) * nloc) {
            __builtin_amdgcn_fence(__ATOMIC_RELEASE, "agent");
            asm volatile("s_waitcnt vmcnt(0)" ::: "memory");
            const unsigned og = xb_add(&bar[XB_TOP], 1u);
            const unsigned tg = og / nx;
            if (og + 1u == (tg + 1u) * nx) xb_add(&bar[XB_TOPGEN], 1u);
            else XB_SPIN(xb_ld(&bar[XB_TOPGEN]) == tg, bar);
            __builtin_amdgcn_fence(__ATOMIC_ACQUIRE, "agent");
            xb_add(&bar[XB_XGEN(b.x)], 1u);
            asm volatile("s_waitcnt vmcnt(0)" ::: "memory");
        } else {
            XB_SPIN(xb_ld(&bar[XB_XGEN(b.x)]) == gen, bar);
            __builtin_amdgcn_fence(__ATOMIC_ACQUIRE, "agent");
            asm volatile("s_waitcnt vmcnt(0)" ::: "memory");
        }
    }
    __syncthreads();
}

__device__ __forceinline__ GemmP mk_gemm(const u16* A, long lda, long a_bs, const u16* Bt, long ldb, long b_bs, u16* C, long ldc, long c_bs, int M, int N, int K, int nbatch, float scale, int ncols, int tstore) {
  GemmP g; g.A = A; g.lda = lda; g.a_bs = a_bs; g.Bt = Bt; g.ldb = ldb; g.b_bs = b_bs; g.C = C; g.ldc = ldc; g.c_bs = c_bs; g.M = M; g.N = N; g.K = K; g.nbatch = nbatch; g.scale = scale; g.ncols = ncols; g.tstore = tstore;
  return g;
}
#define QCTR_WORD (XCD_BAR_WORDS + 64)

__global__ void __launch_bounds__(NTHR, 2) mega(Params P, CvtJobs J1, CvtJobs J2) {
  extern __shared__ __attribute__((aligned(16))) char smem[];
  const int bid = blockIdx.x, nblk = gridDim.x, rbid = nblk - 1 - bid;
  char* ws = P.ws;
  unsigned* barw = (unsigned*)(ws + OFF_BAR);
  if (threadIdx.x == 0) *(uint4*)(smem + LDS_XB) = make_uint4(0u, 0u, 0u, 0u);
  __syncthreads();
  (void)xcd_barrier_post(barw, (volatile LAS unsigned*)(smem + LDS_XB));
#define GRID_SYNC() do { XcdBarrier bar_; bar_.bar = (unsigned*)(P.ws + OFF_BAR); bar_.x = xb_xcc_id(); bar_.st = (volatile LAS unsigned*)(smem + LDS_XB); xcd_barrier(bar_); } while (0)

  cvt_run(J1, smem, bid, nblk);
  rmsnorm_rows(P.x, P.g_mix, (u16*)(ws + OFF_H), T_TOK, bid, nblk);
  rmsnorm_rows(P.mem, P.g_mem, (u16*)(ws + OFF_MEMN), 1024, rbid, nblk);
  GRID_SYNC();

  {
    const GemmP g = mk_gemm((u16*)(ws + OFF_WUK), 512, 64, (u16*)(ws + OFF_WUQ), 512, 64, (u16*)(ws + OFF_WG2T) + 512l * 256, 256, 256l * 256, 256, 256, 64, 8, 0.125f, 128, 0);
    gemm_bf16_phase(g, smem, rbid, nblk);
  }
  {
    const GemmP g = mk_gemm((u16*)(ws + OFF_WPQ), 2048, 128, (u16*)(ws + OFF_SUBK), 128, 128l * 128, (u16*)(ws + OFF_WEFFT), 1024, 128l * 1024, 1024, 128, 128, 16, 1.f, 128, 1);
    gemm_bf16_phase(g, smem, rbid - 16 < 0 ? rbid - 16 + nblk : rbid - 16, nblk);
  }
  {
    const GemmP g = mk_gemm((u16*)(ws + OFF_MEMN), 1024, 0, (u16*)(ws + OFF_WKT), 1024, 0, (u16*)(ws + OFF_KX), 512, 0, 1024, 512, 1024, 1, 1.f, 128, 0);
    gemm_bf16_phase(g, smem, rbid - 80 < 0 ? rbid - 80 + nblk : rbid - 80, nblk);
  }
  {
    const GemmP g = mk_gemm((u16*)(ws + OFF_WVT), 1024, 0, (u16*)(ws + OFF_MEMN), 1024, 256l * 1024, (u16*)(ws + OFF_VTX), 256, 512l * 256, 512, 256, 1024, 4, 1.f, 128, 2);
    gemm_bf16_phase(g, smem, rbid - 96 < 0 ? rbid - 96 + nblk : rbid - 96, nblk);
  }
  { EpiG1 e; e.ws = ws; pg_phase((const u16*)(ws + OFF_H), (const u16*)(ws + OFF_WINT), T_TOK, 2816, 1024, e, smem, bid, nblk); }
  GRID_SYNC();

  dsa_prep_phase(P, bid, nblk);
  dn_prep_phase(P, bid, nblk);
  GRID_SYNC();

  dn_intra_phase(P, smem, bid, nblk);
  { EpiG2 e; e.qi = (u16*)(ws + OFF_QI); e.qlat = (u16*)P.out; pg_phase((const u16*)(ws + OFF_CQN), (const u16*)(ws + OFF_WG2T), T_TOK, 2560, 256, e, smem, bid, nblk); }
  GRID_SYNC();

  if (bid < 16) dn_scan_phase(P, smem, bid, 16);
  dsa_queue_phase(P, smem, bid, (unsigned*)(P.ws + OFF_BAR) + QCTR_WORD);
  GRID_SYNC();

  dn_gate_phase(P, bid, nblk);
  {
    const GemmP g = mk_gemm((u16*)P.out, 2048, 256, (u16*)(ws + OFF_WUVT), 256, 128l * 256, (u16*)(ws + OFF_MIX), 1024, 64, T_TOK, 128, 256, 8, 1.f, 64, 0);
    gemm_bf16_phase(g, smem, bid, nblk);
  }
  cvt_i4_rows(P.u_emb, P.g_ffn, (unsigned char*)(ws + OFF_UEMB), (float*)(ws + OFF_USCL), 16384, bid, nblk);
  cvt_fp4_rows(P.v_emb, nullptr, (unsigned char*)(ws + OFF_VEMB), (float*)(ws + OFF_VSCL), 16384, bid, nblk);
  GRID_SYNC();

  { EpiResid e; e.R = P.x; e.C = P.out; e.hb = (u16*)(ws + OFF_H); e.ssq = (float*)(ws + OFF_SSQ1); pg_phase((const u16*)(ws + OFF_MIX), (const u16*)(ws + OFF_WOUTT), T_TOK, 1024, 1024, e, smem, bid, nblk); }
  GRID_SYNC();
  { EpiB16 e; e.O = (u16*)(ws + OFF_QX); e.ldc = 512; e.ssq = (const float*)(ws + OFF_SSQ1); pg_phase((const u16*)(ws + OFF_H), (const u16*)(ws + OFF_WQT), T_TOK, 512, 1024, e, smem, bid, nblk); }
  GRID_SYNC();
  xattn_phase(P, smem, bid, nblk);
  GRID_SYNC();
  { EpiResid e; e.R = P.out; e.C = P.out; e.hb = (u16*)(ws + OFF_H); e.ssq = (float*)(ws + OFF_SSQ2); pg_phase((const u16*)(ws + OFF_OX), (const u16*)(ws + OFF_WOT), T_TOK, 1024, 512, e, smem, bid, nblk); }
  GRID_SYNC();
  { EpiB16 e; e.O = (u16*)(ws + OFF_PSC); e.ldc = 2048; e.ssq = (const float*)(ws + OFF_SSQ2); pg_phase((const u16*)(ws + OFF_H), (const u16*)(ws + OFF_WEFFT), T_TOK, 2048, 1024, e, smem, bid, nblk); }
  GRID_SYNC();
  peer_fused_phase(P, smem, bid, nblk);
}

static void add_job(CvtJobs& J, const float* src, u16* dst, int R, int C, long sld, long dld, float scale, int tr, const float* rowscale = nullptr) {
  CvtJob& j = J.j[J.n++]; j.src = src; j.dst = dst; j.rowscale = rowscale; j.R = R; j.C = C; j.sld = sld; j.dld = dld; j.scale = scale; j.transpose = tr;
}

extern "C" void kernel_launch(void* const* d_in, const int* in_sizes, int n_in, void* d_out, int out_size, void* d_ws, size_t ws_size, hipStream_t stream) {
  if (ws_size < WS_NEED) { fprintf(stderr, "workspace too small: %zu < %llu\n", ws_size, (unsigned long long)WS_NEED); return; }
  Params P; memset(&P, 0, sizeof(P));
  const float** pp = (const float**)&P;
  for (int i = 0; i < 29; ++i) pp[i] = (const float*)d_in[i];
  P.out = (float*)d_out; P.ws = (char*)d_ws;
  char* ws = (char*)d_ws;
  static int grid = 0;
  if (!grid) {
    int dev = 0, cus = 0, per_cu = 0;
    (void)hipGetDevice(&dev);
    (void)hipDeviceGetAttribute(&cus, hipDeviceAttributeMultiprocessorCount, dev);
    (void)hipFuncSetAttribute((const void*)mega, hipFuncAttributeMaxDynamicSharedMemorySize, LDS_TOTAL);
    (void)hipOccupancyMaxActiveBlocksPerMultiprocessor(&per_cu, (const void*)mega, NTHR, LDS_TOTAL);
    grid = cus * (per_cu < 1 ? per_cu : 1);
    if (grid <= 0) { fprintf(stderr, "mega kernel not launchable (cus %d, per_cu %d)\n", cus, per_cu); grid = 0; return; }
  }
  (void)hipMemsetAsync(ws + OFF_BAR, 0, 16384, stream);
  (void)hipMemsetAsync(ws + OFF_WINT, 0, 2816ull * 1024 * 2, stream);
  (void)hipMemsetAsync(ws + OFF_WUVT, 0, 8ull * 128 * 256 * 2, stream);
  (void)hipMemsetAsync(ws + OFF_SSQ1, 0, 2 * 256 * 1024, stream);
  CvtJobs J1; memset(&J1, 0, sizeof(J1));
  CvtJobs J2; memset(&J2, 0, sizeof(J2));
  {
    u16* winT = (u16*)(ws + OFF_WINT);
    add_job(J1, P.w_in, winT, 1024, 584, 2640, 1024, 1.f, 1);
    add_job(J1, P.w_in + 2632, winT + 584l * 1024, 1024, 8, 2640, 1024, 1.f, 1);
    add_job(J1, P.w_in + 584, winT + 768l * 1024, 1024, 1536, 2640, 1024, 1.f, 1);
    add_job(J1, P.w_in + 2120, winT + 2304l * 1024, 1024, 512, 2640, 1024, 1.f, 1);
    add_job(J1, P.w_iq, (u16*)(ws + OFF_WG2T), 256, 512, 512, 256, 1.f, 1);
    add_job(J1, P.w_uq, (u16*)(ws + OFF_WUQ), 256, 512, 512, 512, 1.f, 0);
    add_job(J1, P.w_uk, (u16*)(ws + OFF_WUK), 256, 512, 512, 512, 1.f, 0);
    for (int h = 0; h < 8; ++h) add_job(J1, P.w_uv + h * 64, (u16*)(ws + OFF_WUVT) + h * 128l * 256, 256, 64, 512, 256, 1.f, 1);
    add_job(J1, P.w_out, (u16*)(ws + OFF_WOUTT), 1024, 1024, 1024, 1024, 1.f, 1);
    add_job(J1, P.wq_x, (u16*)(ws + OFF_WQT), 1024, 512, 512, 1024, 0.08838834764831845f, 1, P.g_cross);
    add_job(J1, P.wk_x, (u16*)(ws + OFF_WKT), 1024, 512, 512, 1024, 1.f, 1);
    add_job(J1, P.wv_x, (u16*)(ws + OFF_WVT), 1024, 512, 512, 1024, 1.f, 1);
    add_job(J1, P.wo_x, (u16*)(ws + OFF_WOT), 512, 1024, 1024, 512, 1.f, 1);
    add_job(J1, P.w_pq, (u16*)(ws + OFF_WPQ), 1024, 2048, 2048, 2048, 1.f, 0, P.g_ffn);
    add_job(J1, P.sub_keys, (u16*)(ws + OFF_SUBK), 2048, 128, 128, 128, 1.f, 0);
    add_job(J2, P.u_emb, (u16*)(ws + OFF_UEMB), 16384, 1024, 1024, 1024, 1.f, 0);
    add_job(J2, P.v_emb, (u16*)(ws + OFF_VEMB), 16384, 1024, 1024, 1024, 1.f, 0);
  }
  hipLaunchKernelGGL(mega, dim3(grid), dim3(NTHR), LDS_TOTAL, stream, P, J1, J2);
}
```

```cpp
#include <hip/hip_runtime.h>
#include <stdint.h>
#include <stdio.h>
#include <string.h>

typedef unsigned short u16;
typedef __attribute__((ext_vector_type(8))) short bf16x8;
typedef __attribute__((ext_vector_type(4))) short s16x4;
typedef __attribute__((ext_vector_type(4))) float f32x4;
typedef __attribute__((ext_vector_type(4))) unsigned u32x4;
typedef __attribute__((ext_vector_type(2))) unsigned u32x2;
typedef __attribute__((ext_vector_type(2))) float f32x2;
#define LAS __attribute__((address_space(3)))

#define T_TOK 32768
#define SEQ 8192
#define NB 4
#define DM 1024
#define NTHR 512
#define EPSV 1e-6f

__device__ __forceinline__ u16 f2bf(float f) { __bf16 b = (__bf16)f; return __builtin_bit_cast(u16, b); }
__device__ __forceinline__ float bf2f(u16 h) { return __uint_as_float(((unsigned)h) << 16); }
__device__ __forceinline__ unsigned pack2(float a, float b) { return (unsigned)f2bf(a) | ((unsigned)f2bf(b) << 16); }
__device__ __forceinline__ float lo2f(unsigned v) { return __uint_as_float(v << 16); }
__device__ __forceinline__ float hi2f(unsigned v) { return __uint_as_float(v & 0xffff0000u); }
__device__ __forceinline__ int otid() { int t = threadIdx.x; asm volatile("" : "+v"(t)); return t; }
__device__ __forceinline__ int lane_id() { return (int)__builtin_amdgcn_mbcnt_hi(~0u, __builtin_amdgcn_mbcnt_lo(~0u, 0u)); }
template <class T> __device__ __forceinline__ T sx(T v, int m) { return __builtin_bit_cast(T, __builtin_amdgcn_ds_bpermute((lane_id() ^ m) << 2, __builtin_bit_cast(int, v))); }
template <class T> __device__ __forceinline__ T sh(T v, int src) { return __builtin_bit_cast(T, __builtin_amdgcn_ds_bpermute(src << 2, __builtin_bit_cast(int, v))); }
template <class T> __device__ __forceinline__ T su(T v, int d) { const int l = lane_id(); const int src = l - d < 0 ? l : l - d; return __builtin_bit_cast(T, __builtin_amdgcn_ds_bpermute(src << 2, __builtin_bit_cast(int, v))); }
__device__ __forceinline__ float wave_sum(float v) {
#pragma unroll
  for (int o = 32; o >= 1; o >>= 1) v += sx(v, o);
  return v;
}
template <int CTRL> __device__ __forceinline__ float dpp_f(float v) { return __int_as_float(__builtin_amdgcn_update_dpp(0, __float_as_int(v), CTRL, 0xf, 0xf, true)); }
__device__ __forceinline__ float wave_max_u(float v) {
  v = fmaxf(v, dpp_f<0xB1>(v)); v = fmaxf(v, dpp_f<0x4E>(v)); v = fmaxf(v, dpp_f<0x141>(v)); v = fmaxf(v, dpp_f<0x140>(v));
  const int vi = __float_as_int(v);
  const float a = __int_as_float(__builtin_amdgcn_readlane(vi, 0)), b = __int_as_float(__builtin_amdgcn_readlane(vi, 16));
  const float c = __int_as_float(__builtin_amdgcn_readlane(vi, 32)), d = __int_as_float(__builtin_amdgcn_readlane(vi, 48));
  return fmaxf(fmaxf(a, b), fmaxf(c, d));
}
__device__ __forceinline__ float wave_min_u(float v) { return -wave_max_u(-v); }
__device__ __forceinline__ float relu_raw(float x) { return __builtin_amdgcn_fmed3f(x, 0.f, 3.0e38f); }
__device__ __forceinline__ f32x4 mfma16(bf16x8 a, bf16x8 b, f32x4 c) { return __builtin_amdgcn_mfma_f32_16x16x32_bf16(a, b, c, 0, 0, 0); }
__device__ __forceinline__ unsigned umed3(unsigned a, unsigned b, unsigned c) { unsigned r; asm("v_med3_u32 %0, %1, %2, %3" : "=v"(r) : "v"(a), "v"(b), "v"(c)); return r; }
__device__ __forceinline__ unsigned fkey(float f) { unsigned u = __float_as_uint(f); return u ^ ((u >> 31) ? 0xffffffffu : 0x80000000u); }
__device__ __forceinline__ float keyf(unsigned m) { unsigned u = (m & 0x80000000u) ? (m ^ 0x80000000u) : ~m; return __uint_as_float(u); }

#define MB (1024ull * 1024ull)
#define OFF_BAR      0ull
#define OFF_WINT     (1 * MB)
#define OFF_WG2T     (7 * MB)
#define OFF_WUQ      (9 * MB)
#define OFF_WUK      (9 * MB + 512 * 1024)
#define OFF_WUVT     (10 * MB)
#define OFF_WOUTT    (11 * MB)
#define OFF_WQT      (13 * MB)
#define OFF_WKT      (14 * MB)
#define OFF_WVT      (15 * MB)
#define OFF_WOT      (16 * MB)
#define OFF_WPQ      (17 * MB)
#define OFF_SUBK     (21 * MB)
#define OFF_WEFFT    (22 * MB)
#define OFF_MEMN     (26 * MB)
#define OFF_KX       (28 * MB)
#define OFF_VTX      (29 * MB)
#define OFF_KIDXN    (30 * MB)
#define OFF_WIDX     (34 * MB)
#define OFF_GB       (35 * MB)
#define OFF_SSQ1     (36 * MB + 256 * 1024)
#define OFF_SSQ2     (36 * MB + 512 * 1024)
#define OFF_INTRA    (37 * MB)
#define OFF_WDN      (53 * MB)
#define OFF_SEL      (85 * MB)
#define OFF_H        (101 * MB)
#define OFF_QI       (OFF_H)
#define OFF_CQN      (OFF_H + 32 * MB)
#define OFF_CKVN     (OFF_H + 48 * MB)
#define OFF_PA       (165 * MB)
#define OFF_PB       (213 * MB)
#define OFF_SCORES   (OFF_PA)
#define OFF_UEMB     (OFF_PA)
#define OFF_VEMB     (OFF_PA + 16 * MB)
#define OFF_USCL     (OFF_PA + 32 * MB)
#define OFF_VSCL     (OFF_PA + 33 * MB)
#define OFF_PSC      (OFF_PB)
#define OFF_BZ       (309 * MB)
#define OFF_QKV      (341 * MB)
#define OFF_QX       (OFF_QKV)
#define OFF_OX       (OFF_QKV + 32 * MB)
#define OFF_PEIDX    (OFF_QKV)
#define OFF_PGATE    (OFF_QKV + 8 * MB)
#define OFF_PLIST    (OFF_QKV + 64 * MB)
#define OFF_MIX      (437 * MB)
#define WS_NEED      (501 * MB)

struct CvtJob { const float* src; u16* dst; const float* rowscale; int R, C; long sld, dld; float scale; int transpose; };
#define MAXJOBS 24
struct CvtJobs { CvtJob j[MAXJOBS]; int n; int pad; };

__device__ __forceinline__ void cvt_run(const CvtJobs& J, char* smem, int bid, int nblk) {
  const int tidx = otid();
  float* tile = (float*)smem;
  for (int ji = 0; ji < J.n; ++ji) {
    const CvtJob jb = J.j[ji];
    if (jb.transpose) continue;
    const long nvec = (long)jb.R * (jb.C >> 2);
    const int cv = jb.C >> 2;
    for (long i = (long)bid * NTHR + tidx; i < nvec; i += (long)nblk * NTHR) {
      const long r = i / cv; const int c = (int)(i - r * cv) * 4;
      const float4 v = *(const float4*)(jb.src + r * jb.sld + c);
      const float sc = jb.rowscale ? jb.scale * jb.rowscale[r] : jb.scale;
      u32x2 o; o[0] = pack2(v.x * sc, v.y * sc); o[1] = pack2(v.z * sc, v.w * sc);
      *(u32x2*)(jb.dst + r * jb.dld + c) = o;
    }
  }
  int total = 0;
  for (int ji = 0; ji < J.n; ++ji) if (J.j[ji].transpose) total += ((J.j[ji].R + 63) >> 6) * ((J.j[ji].C + 63) >> 6);
  for (int tg = bid; tg < total; tg += nblk) {
    int ji = 0, t = tg;
    for (;; ++ji) {
      if (!J.j[ji].transpose) continue;
      const int nt = ((J.j[ji].R + 63) >> 6) * ((J.j[ji].C + 63) >> 6);
      if (t < nt) break;
      t -= nt;
    }
    const CvtJob jb = J.j[ji];
    const int tc = (jb.C + 63) >> 6;
    const int r0 = (t / tc) * 64, c0 = (t % tc) * 64;
    __syncthreads();
    for (int i = tidx; i < 4096; i += NTHR) {
      const int r = i >> 6, c = i & 63;
      float v = 0.f;
      if (r0 + r < jb.R && c0 + c < jb.C) v = jb.src[(long)(r0 + r) * jb.sld + c0 + c];
      tile[r * 65 + c] = v;
    }
    __syncthreads();
    for (int i = tidx; i < 4096; i += NTHR) {
      const int c = i >> 6, r = i & 63;
      if (r0 + r < jb.R && c0 + c < jb.C) jb.dst[(long)(c0 + c) * jb.dld + r0 + r] = f2bf(tile[r * 65 + c] * (jb.rowscale ? jb.scale * jb.rowscale[r0 + r] : jb.scale));
    }
  }
}

__device__ __forceinline__ void cvt_fp8_rows(const float* src, unsigned char* dst, float* scl, int nrows, int bid, int nblk) {
  const int tidx = otid();
  const int lane = tidx & 63, wv = tidx >> 6;
  for (int r = bid * 8 + wv; r < nrows; r += nblk * 8) {
    const float* p = src + (long)r * DM + lane * 16;
    float4 v[4]; float am = 0.f;
#pragma unroll
    for (int i = 0; i < 4; ++i) { v[i] = *(const float4*)(p + i * 4); am = fmaxf(am, fmaxf(fmaxf(fabsf(v[i].x), fabsf(v[i].y)), fmaxf(fabsf(v[i].z), fabsf(v[i].w)))); }
#pragma unroll
    for (int o = 32; o >= 1; o >>= 1) am = fmaxf(am, sx(am, o));
    const float sc = am > 0.f ? am * (1.f / 440.f) : 1.f;
    const float inv = 1.f / sc;
    u32x4 o;
#pragma unroll
    for (int i = 0; i < 4; ++i) {
      int w = 0;
      w = __builtin_amdgcn_cvt_pk_fp8_f32(v[i].x * inv, v[i].y * inv, w, false);
      w = __builtin_amdgcn_cvt_pk_fp8_f32(v[i].z * inv, v[i].w * inv, w, true);
      o[i] = (unsigned)w;
    }
    *(u32x4*)(dst + (long)r * DM + lane * 16) = o;
    if (lane == 0) scl[r] = sc;
  }
}

__device__ __forceinline__ void cvt_fp4_rows(const float* src, const float* colscale, unsigned char* dst, float* scl, int nrows, int bid, int nblk) {
  const int tidx = otid();
  const int lane = tidx & 63, wv = tidx >> 6;
  float4 cs[4];
#pragma unroll
  for (int i = 0; i < 4; ++i) cs[i] = colscale ? *(const float4*)(colscale + lane * 16 + i * 4) : make_float4(1.f, 1.f, 1.f, 1.f);
  for (int r = bid * 8 + wv; r < nrows; r += nblk * 8) {
    const float* p = src + (long)r * DM + lane * 16;
    float4 v[4]; float am = 0.f;
#pragma unroll
    for (int i = 0; i < 4; ++i) { v[i] = *(const float4*)(p + i * 4); v[i].x *= cs[i].x; v[i].y *= cs[i].y; v[i].z *= cs[i].z; v[i].w *= cs[i].w; am = fmaxf(am, fmaxf(fmaxf(fabsf(v[i].x), fabsf(v[i].y)), fmaxf(fabsf(v[i].z), fabsf(v[i].w)))); }
#pragma unroll
    for (int o = 32; o >= 1; o >>= 1) am = fmaxf(am, sx(am, o));
    const float sc = am > 0.f ? am * (1.f / 6.f) : 1.f;
    const float inv = 1.f / sc;
    u32x2 o;
#pragma unroll
    for (int d = 0; d < 2; ++d) {
      unsigned w = 0u;
      w = __builtin_amdgcn_cvt_scalef32_pk_fp4_f32(w, v[2 * d].x * inv, v[2 * d].y * inv, 1.0f, 0);
      w = __builtin_amdgcn_cvt_scalef32_pk_fp4_f32(w, v[2 * d].z * inv, v[2 * d].w * inv, 1.0f, 1);
      w = __builtin_amdgcn_cvt_scalef32_pk_fp4_f32(w, v[2 * d + 1].x * inv, v[2 * d + 1].y * inv, 1.0f, 2);
      w = __builtin_amdgcn_cvt_scalef32_pk_fp4_f32(w, v[2 * d + 1].z * inv, v[2 * d + 1].w * inv, 1.0f, 3);
      o[d] = w;
    }
    *(u32x2*)(dst + (long)r * 512 + lane * 8) = o;
    if (lane == 0) scl[r] = sc;
  }
}

__device__ __forceinline__ void cvt_i4_rows(const float* src, const float* colscale, unsigned char* dst, float* scl, int nrows, int bid, int nblk) {
  const int tidx = otid();
  const int lane = tidx & 63, wv = tidx >> 6;
  float4 cs[4];
#pragma unroll
  for (int i = 0; i < 4; ++i) cs[i] = colscale ? *(const float4*)(colscale + lane * 16 + i * 4) : make_float4(1.f, 1.f, 1.f, 1.f);
  for (int r = bid * 8 + wv; r < nrows; r += nblk * 8) {
    const float* p = src + (long)r * DM + lane * 16;
    float x[16]; float am = 0.f, ss = 0.f;
#pragma unroll
    for (int i = 0; i < 4; ++i) {
      const float4 v = *(const float4*)(p + i * 4);
      x[4 * i] = v.x * cs[i].x; x[4 * i + 1] = v.y * cs[i].y; x[4 * i + 2] = v.z * cs[i].z; x[4 * i + 3] = v.w * cs[i].w;
    }
#pragma unroll
    for (int e = 0; e < 16; ++e) { am = fmaxf(am, fabsf(x[e])); ss += x[e] * x[e]; }
#pragma unroll
    for (int o = 32; o >= 1; o >>= 1) { am = fmaxf(am, sx(am, o)); ss += sx(ss, o); }
    const float lim = fminf(am, 2.6f * sqrtf(ss * (1.f / DM)));
    const float sc = lim > 0.f ? lim * (1.f / 7.f) : 1.f;
    const float inv = 1.f / sc;
    u32x2 o;
#pragma unroll
    for (int d = 0; d < 2; ++d) {
      unsigned w = 0u;
#pragma unroll
      for (int i = 0; i < 8; ++i) {
        float qf = rintf(x[8 * d + i] * inv); qf = fminf(fmaxf(qf, -7.f), 7.f);
        w |= ((unsigned)(int)qf & 15u) << (4 * i);
      }
      o[d] = w;
    }
    *(u32x2*)(dst + (long)r * 512 + lane * 8) = o;
    if (lane == 0) scl[r] = sc;
  }
}

__device__ __forceinline__ void rmsnorm_rows(const float* src, const float* g, u16* dst, int nrows, int bid, int nblk) {
  const int tidx = otid();
  const int lane = tidx & 63, wv = tidx >> 6;
  float4 gg[4];
#pragma unroll
  for (int i = 0; i < 4; ++i) gg[i] = *(const float4*)(g + i * 256 + lane * 4);
  for (int r = (bid * 8 + wv) * 2; r < nrows; r += nblk * 16) {
    float4 v[2][4]; float ss[2] = {0.f, 0.f};
#pragma unroll
    for (int k = 0; k < 2; ++k)
#pragma unroll
      for (int i = 0; i < 4; ++i) v[k][i] = *(const float4*)(src + (long)(r + k) * DM + i * 256 + lane * 4);
#pragma unroll
    for (int k = 0; k < 2; ++k) {
#pragma unroll
      for (int i = 0; i < 4; ++i) ss[k] += v[k][i].x * v[k][i].x + v[k][i].y * v[k][i].y + v[k][i].z * v[k][i].z + v[k][i].w * v[k][i].w;
      ss[k] = wave_sum(ss[k]);
      const float rs = rsqrtf(ss[k] * (1.f / DM) + EPSV);
#pragma unroll
      for (int i = 0; i < 4; ++i) {
        u32x2 o; o[0] = pack2(v[k][i].x * rs * gg[i].x, v[k][i].y * rs * gg[i].y); o[1] = pack2(v[k][i].z * rs * gg[i].z, v[k][i].w * rs * gg[i].w);
        *(u32x2*)(dst + (long)(r + k) * DM + i * 256 + lane * 4) = o;
      }
    }
  }
}

template <int LDC>
__device__ __forceinline__ void gemm_tile(const u16* __restrict__ A, long lda, const u16* __restrict__ Bt, long ldb, int K, char* smem) {
  const int tidx = otid();
  const int tid = tidx, lane = tid & 63, wv = tid >> 6, lr = lane & 15, g = lane >> 4;
  const int wm = wv >> 1, wn = wv & 1;
  f32x4 acc[4][4];
#pragma unroll
  for (int i = 0; i < 4; ++i)
#pragma unroll
    for (int j = 0; j < 4; ++j) acc[i][j] = (f32x4){0.f, 0.f, 0.f, 0.f};
  u32x4 ra[4], rb[2];
  const int nk = K >> 6;
  const int srow = tid >> 3, sch = tid & 7;
  const u16* pa = A + (long)srow * lda + sch * 8;
  const u16* pb = Bt + (long)srow * ldb + sch * 8;
  const unsigned lds_off = (unsigned)(srow * 128 + ((sch ^ (srow & 7)) << 4));
#pragma unroll
  for (int i = 0; i < 4; ++i) ra[i] = *(const u32x4*)(pa + (long)(i * 64) * lda);
#pragma unroll
  for (int i = 0; i < 2; ++i) rb[i] = *(const u32x4*)(pb + (long)(i * 64) * ldb);
  __syncthreads();
#pragma unroll
  for (int i = 0; i < 4; ++i) *(u32x4*)(smem + lds_off + i * 8192) = ra[i];
#pragma unroll
  for (int i = 0; i < 2; ++i) *(u32x4*)(smem + 32768 + lds_off + i * 8192) = rb[i];
  __syncthreads();
  for (int kt = 0; kt < nk; ++kt) {
    const char* sA = smem + (kt & 1) * 49152;
    const char* sB = sA + 32768;
    if (kt + 1 < nk) {
#pragma unroll
      for (int i = 0; i < 4; ++i) ra[i] = *(const u32x4*)(pa + (long)(i * 64) * lda + (kt + 1) * 64);
#pragma unroll
      for (int i = 0; i < 2; ++i) rb[i] = *(const u32x4*)(pb + (long)(i * 64) * ldb + (kt + 1) * 64);
    }
#pragma unroll
    for (int ks = 0; ks < 2; ++ks) {
      bf16x8 a[4], b[4];
#pragma unroll
      for (int mi = 0; mi < 4; ++mi) { const int row = wm * 64 + mi * 16 + lr; a[mi] = *(const bf16x8*)(sA + row * 128 + (((ks * 4 + g) ^ (row & 7)) << 4)); }
#pragma unroll
      for (int ni = 0; ni < 4; ++ni) { const int row = wn * 64 + ni * 16 + lr; b[ni] = *(const bf16x8*)(sB + row * 128 + (((ks * 4 + g) ^ (row & 7)) << 4)); }
#pragma unroll
      for (int mi = 0; mi < 4; ++mi)
#pragma unroll
        for (int ni = 0; ni < 4; ++ni) acc[mi][ni] = mfma16(a[mi], b[ni], acc[mi][ni]);
    }
    if (kt + 1 < nk) {
      char* dA = smem + ((kt + 1) & 1) * 49152;
#pragma unroll
      for (int i = 0; i < 4; ++i) *(u32x4*)(dA + lds_off + i * 8192) = ra[i];
#pragma unroll
      for (int i = 0; i < 2; ++i) *(u32x4*)(dA + 32768 + lds_off + i * 8192) = rb[i];
    }
    __syncthreads();
  }
  float* sC = (float*)smem;
#pragma unroll
  for (int mi = 0; mi < 4; ++mi)
#pragma unroll
    for (int ni = 0; ni < 4; ++ni)
#pragma unroll
      for (int r = 0; r < 4; ++r) sC[(wm * 64 + mi * 16 + g * 4 + r) * LDC + wn * 64 + ni * 16 + lr] = acc[mi][ni][r];
  __syncthreads();
}

__device__ __forceinline__ void epi_store_bf16(const char* smem, u16* C, long ldc, float scale, int ncols) {
  const int tidx = otid();
  const float* sC = (const float*)smem;
  const int cv = ncols >> 2;
  for (int i = tidx; i < 256 * cv; i += NTHR) {
    const int r = i / cv, c = (i - r * cv) * 4;
    const float4 v = *(const float4*)(sC + r * 132 + c);
    u32x2 o; o[0] = pack2(v.x * scale, v.y * scale); o[1] = pack2(v.z * scale, v.w * scale);
    *(u32x2*)(C + (long)r * ldc + c) = o;
  }
}
__device__ __forceinline__ void epi_resid_f32(const char* smem, const float* R, float* C, long ldc) {
  const int tidx = otid();
  const float* sC = (const float*)smem;
  for (int i = tidx; i < 256 * 32; i += NTHR) {
    const int r = i >> 5, c = (i & 31) * 4;
    const float4 v = *(const float4*)(sC + r * 132 + c);
    const float4 x = *(const float4*)(R + (long)r * ldc + c);
    float4 o; o.x = v.x + x.x; o.y = v.y + x.y; o.z = v.z + x.z; o.w = v.w + x.w;
    *(float4*)(C + (long)r * ldc + c) = o;
  }
}

namespace pg8 {
#define PG8_LAS __attribute__((address_space(3)))
typedef unsigned short bf16_t;
typedef short bf16x8 __attribute__((ext_vector_type(8)));
typedef float f32x4 __attribute__((ext_vector_type(4)));
typedef unsigned u32x4 __attribute__((ext_vector_type(4)));
constexpr int BM = 256, BK = 64, HALF = 128, HTB = HALF * BK * 2  , STAGE_BYTES = 8 * HTB, NXCD = 8, WGM = 8;

__host__ __device__ __forceinline__ int lds_byte(int r, int c) { const int st = (r >> 4) * 2 + (c >> 5), rr = r & 15, cc = c & 31, ob = rr * 64 + cc * 2; return st * 1024 + (ob ^ (((ob >> 9) & 1) << 5)); }
__host__ __device__ __forceinline__ void stage_rc(int b, int& R, int& C) { const int st = b / 1024, sb = b % 1024, swz = sb ^ (((sb >> 9) & 1) << 5); R = (st >> 1) * 16 + swz / 64; C = (st & 1) * 32 + (swz % 64) / 2; }
__host__ __device__ __forceinline__ int perm32(int rho) { const int n = rho >> 4, i = rho & 15; return 8 * (i >> 2) + 4 * n + (i & 3); }

struct Unit { int pm, pn; };
struct Gemm { const bf16_t* A; const bf16_t* Bt; int M, N, K; };
struct StaticOrder {
    int nM, nN, nwg, G, c;
    __host__ __device__ void init(int M, int N, int G_, int c_) { nM = M / BM; nN = N / BM; nwg = nM * nN; G = G_; c = c_; }
    __host__ __device__ bool next(int i, Unit& u) const {
        const long L = (long)i * G + c; if (L >= nwg) return false;
        int wgid = (int)L; { const int q = nwg / NXCD, r = nwg % NXCD, xcd = wgid % NXCD, off = wgid / NXCD; wgid = (xcd < r ? xcd * (q + 1) : r * (q + 1) + (xcd - r) * q) + off; }
        const int nig = WGM * nN, gid = wgid / nig, fm = gid * WGM, gsz = (nM - fm) < WGM ? (nM - fm) : WGM;
        u.pm = fm + ((wgid % nig) % gsz); u.pn = (wgid % nig) / gsz; return true;
    }
    __device__ __forceinline__ void a_ready(const Unit&) const {}
    __device__ __forceinline__ void done(const Unit&) const {}
};
__device__ __forceinline__ unsigned cvt_pk_bf16(float lo, float hi) { unsigned r; asm volatile("v_cvt_pk_bf16_f32 %0, %1, %2" : "=v"(r) : "v"(lo), "v"(hi)); return r; }
template <class Epi, class Sched, bool STAMP = false>
__device__ __forceinline__ void gemm_phase(PG8_LAS unsigned char* lds, const Gemm g, const Sched& S, const Epi& E, unsigned long long* stamps) {
    const int tid = otid(), wid = __builtin_amdgcn_readfirstlane(tid >> 6), lane = tid & 63, wr = wid >> 2, wc = wid & 3, fr = lane & 15, fq = lane >> 4;
    const int K = g.K, nt = K / BK;
    int ts_lo = 0, ts_hi = 0, nts = 0; const unsigned long long rt_entry = STAMP ? (unsigned long long)wall_clock64() : 0ull;
#define PG8_STAMP() do { if (STAMP && wid == 0 && nts < 64) { const unsigned long long _c = (unsigned long long)clock64(); \
        ts_lo = (lane == nts) ? (int)(unsigned)_c : ts_lo; ts_hi = (lane == nts) ? (int)(unsigned)(_c >> 32) : ts_hi; ++nts; } } while (0)
    PG8_STAMP();
    unsigned voffA[2], voffB[2];
#pragma unroll
    for (int i = 0; i < 2; ++i) { int R, C; stage_rc(tid * 16 + i * 8192, R, C); const int Rb = Epi::PERM ? ((R & ~31) + perm32(R & 31)) : R;
        voffA[i] = (unsigned)(R * K + C) * 2u; voffB[i] = (unsigned)(Rb * K + C) * 2u; }
    const size_t kstep = (size_t)(BK * 2);
    const size_t hstep = (size_t)HALF * K * 2;
    const size_t tstep = 2 * hstep;
    const unsigned ldsw = (unsigned)wid * 1024u;
    const int aoff = lds_byte(wr * 64 + fr, fq * 8), boff = lds_byte(wc * 32 + fr, fq * 8);
#define PG8_SA(b, h) (((b) * 2 + (h)) * HTB)
#define PG8_SB(b, h) ((4 + (b) * 2 + (h)) * HTB)
#define PG8_STAGE(bufoff, gbase, voff) do { _Pragma("unroll") for (int _i = 0; _i < 2; ++_i) \
        __builtin_amdgcn_global_load_lds((const unsigned*)((const char*)(gbase) + (voff)[_i]), (PG8_LAS unsigned*)(lds + (bufoff) + ldsw + _i * 8192), 16, 0, 0); } while (0)
#define PG8_LDA(dst, b, h) do { _Pragma("unroll") for (int m = 0; m < 4; ++m) _Pragma("unroll") for (int k = 0; k < 2; ++k) dst[m][k] = *(const PG8_LAS bf16x8*)(lds + PG8_SA(b, h) + aoff + m * 2048 + k * 1024); } while (0)
#define PG8_LDB(dst, b, h) do { _Pragma("unroll") for (int n = 0; n < 2; ++n) _Pragma("unroll") for (int k = 0; k < 2; ++k) dst[n][k] = *(const PG8_LAS bf16x8*)(lds + PG8_SB(b, h) + boff + n * 2048 + k * 1024); } while (0)
#define PG8_MMA(ai, bj, At, Bt) do { __builtin_amdgcn_s_setprio(1); _Pragma("unroll") for (int m = 0; m < 4; ++m) _Pragma("unroll") for (int n = 0; n < 2; ++n) _Pragma("unroll") for (int k = 0; k < 2; ++k) \
        acc[ai][bj][m][n] = __builtin_amdgcn_mfma_f32_16x16x32_bf16(Bt[n][k], At[m][k], acc[ai][bj][m][n], 0, 0, 0); __builtin_amdgcn_s_setprio(0); } while (0)
#define PG8_WAIT_V(n) asm volatile("s_waitcnt vmcnt(" #n ")" ::: "memory")
#define PG8_WAIT_L(n) asm volatile("s_waitcnt lgkmcnt(" #n ")" ::: "memory")
#define PG8_BAR __builtin_amdgcn_s_barrier()
#define PG8_SCHED __builtin_amdgcn_sched_barrier(0)
    Unit cur, nxt; int ui = 0;
    if (!S.next(0, cur)) return;
    f32x4 acc[2][2][4][2];
#pragma unroll
    for (int a = 0; a < 2; ++a)
#pragma unroll
        for (int b = 0; b < 2; ++b)
#pragma unroll
            for (int m = 0; m < 4; ++m)
#pragma unroll
                for (int n = 0; n < 2; ++n) acc[a][b][m][n] = (f32x4){0.f, 0.f, 0.f, 0.f};
    bf16x8 At[4][2], B0[2][2], B1[2][2];
    const char* cA = (const char*)g.A + (size_t)cur.pm * tstep; const char* cB = (const char*)g.Bt + (size_t)cur.pn * tstep;
    S.a_ready(cur);
    PG8_STAGE(PG8_SB(0, 0), cB, voffB); PG8_STAGE(PG8_SA(0, 0), cA, voffA); PG8_STAGE(PG8_SB(0, 1), cB + hstep, voffB); PG8_STAGE(PG8_SA(0, 1), cA + hstep, voffA);
    if (wr == 1) PG8_BAR;
    PG8_WAIT_V(4); PG8_BAR;
    PG8_STAGE(PG8_SB(1, 0), cB + kstep, voffB); PG8_STAGE(PG8_SA(1, 0), cA + kstep, voffA); PG8_STAGE(PG8_SB(1, 1), cB + hstep + kstep, voffB);
    PG8_WAIT_V(6); PG8_BAR;
    PG8_STAMP();
    for (;;) {
        const bool has_next = S.next(ui + 1, nxt);
        const char* nA = has_next ? (const char*)g.A + (size_t)nxt.pm * tstep : cA; const char* nB = has_next ? (const char*)g.Bt + (size_t)nxt.pn * tstep : cB;
        for (int t = 0; t < nt; t += 2) {
            const bool last = (t == nt - 2);
            const char* a1 = cA + (size_t)(t + 1) * kstep;
            const char* a2 = last ? nA : cA + (size_t)(t + 2) * kstep; const char* b2 = last ? nB : cB + (size_t)(t + 2) * kstep;
            const char* a3 = a2 + kstep; const char* b3 = b2 + kstep;
            if (last && has_next) S.a_ready(nxt);
            PG8_LDB(B0, 0, 0); PG8_SCHED; PG8_LDA(At, 0, 0); PG8_STAGE(PG8_SA(1, 1), a1 + hstep, voffA);
            PG8_WAIT_L(8); PG8_BAR; PG8_WAIT_L(0); PG8_MMA(0, 0, At, B0); PG8_BAR; PG8_SCHED;
            PG8_LDB(B1, 0, 1); PG8_STAGE(PG8_SB(0, 0), b2, voffB);
            PG8_BAR; PG8_WAIT_L(0); PG8_MMA(0, 1, At, B1); PG8_BAR;
            PG8_LDA(At, 0, 1); PG8_STAGE(PG8_SA(0, 0), a2, voffA);
            PG8_BAR; PG8_WAIT_L(0); PG8_MMA(1, 0, At, B0); PG8_BAR; PG8_SCHED;
            PG8_STAGE(PG8_SB(0, 1), b2 + hstep, voffB);
            PG8_WAIT_V(6); PG8_BAR; PG8_MMA(1, 1, At, B1); PG8_BAR;
            PG8_LDB(B0, 1, 0); PG8_SCHED; PG8_LDA(At, 1, 0); PG8_STAGE(PG8_SA(0, 1), a2 + hstep, voffA);
            PG8_WAIT_L(8); PG8_BAR; PG8_WAIT_L(0); PG8_MMA(0, 0, At, B0); PG8_BAR; PG8_SCHED;
            PG8_LDB(B1, 1, 1); PG8_STAGE(PG8_SB(1, 0), b3, voffB);
            PG8_BAR; PG8_WAIT_L(0); PG8_MMA(0, 1, At, B1); PG8_BAR;
            PG8_LDA(At, 1, 1); PG8_STAGE(PG8_SA(1, 0), a3, voffA);
            PG8_BAR; PG8_WAIT_L(0); PG8_MMA(1, 0, At, B0); PG8_BAR; PG8_SCHED;
            PG8_STAGE(PG8_SB(1, 1), b3 + hstep, voffB);
            PG8_WAIT_V(6); PG8_BAR; PG8_MMA(1, 1, At, B1); PG8_BAR;
        }
        PG8_STAMP();
        if constexpr (!Epi::AFTER_DRAIN) { E(acc, cur, wr, wc, fr, fq); S.done(cur); }
        PG8_STAMP();
        if (!has_next) break;
#pragma unroll
        for (int a = 0; a < 2; ++a)
#pragma unroll
            for (int b = 0; b < 2; ++b)
#pragma unroll
                for (int m = 0; m < 4; ++m)
#pragma unroll
                    for (int n = 0; n < 2; ++n) acc[a][b][m][n] = (f32x4){0.f, 0.f, 0.f, 0.f};
        cur = nxt; cA = nA; cB = nB; ++ui;
    }
    PG8_WAIT_V(0);
    if (wr == 0) PG8_BAR;
    PG8_BAR;
    if constexpr (Epi::AFTER_DRAIN) { E.fused(acc, cur, wr, wc, fr, fq, lds, wid, lane); S.done(cur); }
    PG8_STAMP();
    if (STAMP && wid == 0) { stamps[lane] = lane < nts ? (((unsigned long long)(unsigned)ts_hi << 32) | (unsigned)ts_lo) : 0ull;
        if (lane == 62) stamps[62] = rt_entry; if (lane == 63) stamps[63] = (unsigned long long)wall_clock64(); }
#undef PG8_STAMP
#undef PG8_SA
#undef PG8_SB
#undef PG8_STAGE
#undef PG8_LDA
#undef PG8_LDB
#undef PG8_MMA
#undef PG8_WAIT_V
#undef PG8_WAIT_L
#undef PG8_BAR
#undef PG8_SCHED
}
}

__device__ __forceinline__ void pg_store_bf16(const pg8::f32x4 (&acc)[2][2][4][2], u16* base, long ldc, int row0, int col0) {
#pragma unroll
  for (int ai = 0; ai < 2; ++ai)
#pragma unroll
    for (int m = 0; m < 4; ++m) {
      u16* rowp = base + (size_t)(row0 + ai * 128 + m * 16) * ldc + col0;
#pragma unroll
      for (int bj = 0; bj < 2; ++bj) {
        const pg8::f32x4 v0 = acc[ai][bj][m][0], v1 = acc[ai][bj][m][1];
        u32x4 w; w[0] = pg8::cvt_pk_bf16(v0[0], v0[1]); w[1] = pg8::cvt_pk_bf16(v0[2], v0[3]); w[2] = pg8::cvt_pk_bf16(v1[0], v1[1]); w[3] = pg8::cvt_pk_bf16(v1[2], v1[3]);
        *(u32x4*)(rowp + bj * 128) = w;
      }
    }
}
struct EpiG1 {
  static constexpr bool PERM = true, AFTER_DRAIN = false; char* ws;
  __device__ __forceinline__ void operator()(const pg8::f32x4 (&acc)[2][2][4][2], const pg8::Unit& u, int wr, int wc, int fr, int fq) const {
    u16* base; long ldc; int colt;
    if (u.pn < 3) { base = (u16*)(ws + OFF_PA); ldc = 768; colt = u.pn * 256; }
    else if (u.pn < 9) { base = (u16*)(ws + OFF_PB); ldc = 1536; colt = (u.pn - 3) * 256; }
    else { base = (u16*)(ws + OFF_BZ); ldc = 512; colt = (u.pn - 9) * 256; }
    pg_store_bf16(acc, base, ldc, u.pm * 256 + wr * 64 + fr, colt + wc * 32 + 8 * fq);
  }
};
struct EpiG2 {
  static constexpr bool PERM = true, AFTER_DRAIN = false; u16* qi; u16* qlat;
  __device__ __forceinline__ void operator()(const pg8::f32x4 (&acc)[2][2][4][2], const pg8::Unit& u, int wr, int wc, int fr, int fq) const {
    u16* base; long ldc; int colt;
    if (u.pn < 2) { base = qi; ldc = 512; colt = u.pn * 256; } else { base = qlat; ldc = 2048; colt = (u.pn - 2) * 256; }
    pg_store_bf16(acc, base, ldc, u.pm * 256 + wr * 64 + fr, colt + wc * 32 + 8 * fq);
  }
};
struct EpiB16 {
  static constexpr bool PERM = true, AFTER_DRAIN = false; u16* O; long ldc; const float* ssq;
  __device__ __forceinline__ void operator()(const pg8::f32x4 (&acc)[2][2][4][2], const pg8::Unit& u, int wr, int wc, int fr, int fq) const {
    const int row0 = u.pm * 256 + wr * 64 + fr, col0 = u.pn * 256 + wc * 32 + 8 * fq;
#pragma unroll
    for (int ai = 0; ai < 2; ++ai)
#pragma unroll
      for (int m = 0; m < 4; ++m) {
        const int row = row0 + ai * 128 + m * 16;
        const float rs = rsqrtf(ssq[row] * (1.f / DM) + EPSV);
        u16* rowp = O + (size_t)row * ldc + col0;
#pragma unroll
        for (int bj = 0; bj < 2; ++bj) {
          const pg8::f32x4 v0 = acc[ai][bj][m][0] * rs, v1 = acc[ai][bj][m][1] * rs;
          u32x4 w; w[0] = pg8::cvt_pk_bf16(v0[0], v0[1]); w[1] = pg8::cvt_pk_bf16(v0[2], v0[3]); w[2] = pg8::cvt_pk_bf16(v1[0], v1[1]); w[3] = pg8::cvt_pk_bf16(v1[2], v1[3]);
          *(u32x4*)(rowp + bj * 128) = w;
        }
      }
  }
};
struct EpiResid {
  static constexpr bool PERM = false, AFTER_DRAIN = false; const float* R; float* C; u16* hb; float* ssq;
  __device__ __forceinline__ void operator()(const pg8::f32x4 (&acc)[2][2][4][2], const pg8::Unit& u, int wr, int wc, int fr, int fq) const {
    const int row0 = u.pm * 256 + wr * 64 + fr, col0 = u.pn * 256 + wc * 32 + 4 * fq;
#pragma unroll
    for (int ai = 0; ai < 2; ++ai)
#pragma unroll
      for (int m = 0; m < 4; ++m) {
        const int row = row0 + ai * 128 + m * 16;
        const size_t ro = (size_t)row * DM + col0;
        float sq = 0.f;
#pragma unroll
        for (int bj = 0; bj < 2; ++bj)
#pragma unroll
          for (int n = 0; n < 2; ++n) {
            const pg8::f32x4 x = *(const pg8::f32x4*)(R + ro + bj * 128 + n * 16);
            const pg8::f32x4 y = x + acc[ai][bj][m][n];
            *(pg8::f32x4*)(C + ro + bj * 128 + n * 16) = y;
            u32x2 hw; hw[0] = pg8::cvt_pk_bf16(y[0], y[1]); hw[1] = pg8::cvt_pk_bf16(y[2], y[3]);
            *(u32x2*)(hb + ro + bj * 128 + n * 16) = hw;
            sq += y[0] * y[0] + y[1] * y[1] + y[2] * y[2] + y[3] * y[3];
          }
        sq += sx(sq, 16); sq += sx(sq, 32);
        if (fq == 0) atomicAdd(ssq + row, sq);
      }
  }
};
template <class Epi>
__device__ __forceinline__ void pg_phase(const u16* A, const u16* Bt, int M, int N, int K, const Epi& E, char* smem, int bid, int nblk) {
  pg8::Gemm g; g.A = A; g.Bt = Bt; g.M = M; g.N = N; g.K = K;
  pg8::StaticOrder S; S.init(M, N, nblk, bid);
  __syncthreads();
  pg8::gemm_phase<Epi, pg8::StaticOrder, false>((PG8_LAS unsigned char*)smem, g, S, E, nullptr);
  __syncthreads();
}

struct Params {
  const float *x, *mem, *g_mix, *w_in, *g_cq, *g_ckv, *g_kidx, *w_uq, *w_iq, *w_uk, *w_uv, *rel_bias, *conv_w, *A_log, *dt_bias, *g_onorm,
      *w_out, *g_cross, *g_mem, *wq_x, *wk_x, *wv_x, *wo_x, *g_ffn, *w_pq, *sub_keys, *u_emb, *v_emb, *g_final;
  float* out;
  char* ws;
};


__device__ __forceinline__ int perm32_pos(int c);
struct GemmP { const u16* A; long lda, a_bs; const u16* Bt; long ldb, b_bs; u16* C; long ldc, c_bs; int M, N, K, nbatch; float scale; int ncols; int tstore; };
__device__ __forceinline__ void gemm_bf16_phase(const GemmP& p, char* smem, int bid, int nblk) {
  const int tidx = otid();
  const int nm = p.M >> 8, nn = p.N >> 7, per = nm * nn;
  for (int t = bid; t < per * p.nbatch; t += nblk) {
    const int b = t / per, r = t - b * per, mp = r / nn, np = r - mp * nn;
    gemm_tile<132>(p.A + b * p.a_bs + (long)mp * 256 * p.lda, p.lda, p.Bt + b * p.b_bs + (long)np * 128 * p.ldb, p.ldb, p.K, smem);
    if (!p.tstore) epi_store_bf16(smem, p.C + b * p.c_bs + (long)mp * 256 * p.ldc + np * 128, p.ldc, p.scale, p.ncols);
    else if (p.tstore == 2) {
      const float* sC = (const float*)smem;
      u16* C = p.C + b * p.c_bs + (long)mp * 256 * p.ldc + np * 128;
      for (int i = tidx; i < 256 * 128; i += NTHR) { const int m = i >> 7, n = i & 127; C[(long)m * p.ldc + perm32_pos(n)] = f2bf(sC[m * 132 + n] * p.scale); }
    } else {
      const float* sC = (const float*)smem;
      u16* C = p.C + b * p.c_bs + (long)np * 128 * p.ldc + mp * 256;
      for (int i = tidx; i < 256 * 128; i += NTHR) { const int n = i >> 8, m = i & 255; C[(long)n * p.ldc + m] = f2bf(sC[m * 132 + n] * p.scale); }
    }
  }
}

__device__ __forceinline__ void g1_phase(const Params& P, char* smem, int bid, int nblk) {
  const u16* A = (const u16*)(P.ws + OFF_H); const u16* Bt = (const u16*)(P.ws + OFF_WINT);
  for (int t = bid; t < 128 * 21; t += nblk) {
    const int mp = t / 21, np = t - mp * 21;
    gemm_tile<132>(A + (long)mp * 256 * DM, DM, Bt + (long)np * 128 * DM, DM, DM, smem);
    u16* C; long ldc;
    if (np < 5) { C = (u16*)(P.ws + OFF_PA) + np * 128; ldc = 640; }
    else if (np < 17) { C = (u16*)(P.ws + OFF_PB) + (np - 5) * 128; ldc = 1536; }
    else { C = (u16*)(P.ws + OFF_BZ) + (np - 17) * 128; ldc = 512; }
    epi_store_bf16(smem, C + (long)mp * 256 * ldc, ldc, 1.f, 128);
  }
}

__device__ __forceinline__ void g2_phase(const Params& P, char* smem, int bid, int nblk) {
  const u16* A = (const u16*)(P.ws + OFF_CQN); const u16* Bt = (const u16*)(P.ws + OFF_WG2T);
  for (int t = bid; t < 128 * 20; t += nblk) {
    const int mp = t / 20, np = t - mp * 20;
    gemm_tile<132>(A + (long)mp * 256 * 256, 256, Bt + (long)np * 128 * 256, 256, 256, smem);
    if (np < 4) epi_store_bf16(smem, (u16*)(P.ws + OFF_QI) + (long)mp * 256 * 512 + np * 128, 512, 1.f, 128);
    else epi_store_bf16(smem, (u16*)P.out + (long)mp * 256 * 2048 + (np - 4) * 128, 2048, 1.f, 128);
  }
}

struct GemmR { const u16* A; long lda; const u16* Bt; long ldb; const float* R; float* C; int K; };
__device__ __forceinline__ void gemm_resid_phase(const GemmR& p, char* smem, int bid, int nblk) {
  for (int t = bid; t < 128 * 8; t += nblk) {
    const int mp = t >> 3, np = t & 7;
    gemm_tile<132>(p.A + (long)mp * 256 * p.lda, p.lda, p.Bt + (long)np * 128 * p.ldb, p.ldb, p.K, smem);
    epi_resid_f32(smem, p.R + (long)mp * 256 * DM + np * 128, p.C + (long)mp * 256 * DM + np * 128, DM);
  }
}

__device__ __forceinline__ void dsa_prep_phase(const Params& P, int bid, int nblk) {
  const int tidx = otid();
  const int lane = tidx & 63, wv = tidx >> 6;
  const u16* Pa = (const u16*)(P.ws + OFF_PA);
  u16* cqn = (u16*)(P.ws + OFF_CQN); u16* ckvn = (u16*)(P.ws + OFF_CKVN); u16* kidxn = (u16*)(P.ws + OFF_KIDXN); float* widx = (float*)(P.ws + OFF_WIDX);
  const float4 ga = *(const float4*)(P.g_cq + lane * 4), gc = *(const float4*)(P.g_ckv + lane * 4);
  const float gk = P.g_kidx[lane];
  for (int t0 = (bid * 8 + wv) * 4; t0 < T_TOK; t0 += nblk * 32) {
    u32x2 av[4], cv[4]; u16 kv[4], wvv[4];
#pragma unroll
    for (int k = 0; k < 4; ++k) {
      const u16* row = Pa + (long)(t0 + k) * 768;
      av[k] = *(const u32x2*)(row + lane * 4); cv[k] = *(const u32x2*)(row + 256 + lane * 4); kv[k] = row[512 + lane]; wvv[k] = row[576 + (lane & 7)];
    }
#pragma unroll
    for (int k = 0; k < 4; ++k) {
      const int t = t0 + k;
      const float kf = bf2f(kv[k]);
      const float a0 = lo2f(av[k][0]), a1 = hi2f(av[k][0]), a2 = lo2f(av[k][1]), a3 = hi2f(av[k][1]);
      const float c0 = lo2f(cv[k][0]), c1 = hi2f(cv[k][0]), c2 = lo2f(cv[k][1]), c3 = hi2f(cv[k][1]);
      const float sa = wave_sum(a0 * a0 + a1 * a1 + a2 * a2 + a3 * a3), sc = wave_sum(c0 * c0 + c1 * c1 + c2 * c2 + c3 * c3), sk = wave_sum(kf * kf);
      const float ra = rsqrtf(sa * (1.f / 256) + EPSV), rc = rsqrtf(sc * (1.f / 256) + EPSV), rk = rsqrtf(sk * (1.f / 64) + EPSV);
      u32x2 o; o[0] = pack2(a0 * ra * ga.x, a1 * ra * ga.y); o[1] = pack2(a2 * ra * ga.z, a3 * ra * ga.w);
      *(u32x2*)(cqn + (long)t * 256 + lane * 4) = o;
      o[0] = pack2(c0 * rc * gc.x, c1 * rc * gc.y); o[1] = pack2(c2 * rc * gc.z, c3 * rc * gc.w);
      *(u32x2*)(ckvn + (long)t * 256 + lane * 4) = o;
      kidxn[(long)t * 64 + lane] = f2bf(kf * rk * gk);
      if (lane < 8) widx[(long)t * 8 + lane] = bf2f(wvv[k]) * 0.04419417382415922f;
    }
  }
}

__device__ __forceinline__ unsigned xb_xcc_id();
#define IX_CAP 2048
#define IX_CK 0
#define IX_HIST 131072
#define IX_CV 152640
#define IX_CNT 154688
#define IX_NV (IX_CAP / 64)
__device__ __forceinline__ unsigned wave_umax_u(unsigned v) {
#pragma unroll
  for (int o = 32; o >= 1; o >>= 1) { const unsigned t = (unsigned)sx((int)v, o); v = v > t ? v : t; }
  return v;
}
__device__ __forceinline__ unsigned wave_umin_u(unsigned v) { return ~wave_umax_u(~v); }
template <int NV>
__device__ __forceinline__ void compact_query(char* smem, int q, int n, int lane, int wv) {
  unsigned* ck = (unsigned*)(smem + IX_CK) + q * IX_CAP;
  unsigned* hist = (unsigned*)(smem + IX_HIST) + wv * 256;
  unsigned* cval = (unsigned*)(smem + IX_CV) + wv * 64;
  unsigned v[NV];
#pragma unroll
  for (int i = 0; i < NV; ++i) { const int e = i * 64 + lane; v[i] = (e < n) ? ck[e] : 0u; }
  unsigned lo = 0xffffffffu, hi = 0u;
#pragma unroll
  for (int i = 0; i < NV; ++i) { const unsigned x = (i * 64 + lane < n) ? v[i] : 0xffffffffu; lo = lo < x ? lo : x; hi = hi > v[i] ? hi : v[i]; }
  lo = wave_umin_u(lo); hi = wave_umax_u(hi);
  int need = 256;
  unsigned tau = lo;
  for (int iter = 0; iter < 40; ++iter) {
    if (hi == lo) { tau = lo; break; }
    const unsigned range = hi - lo;
    const int nbits = 32 - __clz((int)range);
    const int shift = nbits > 8 ? nbits - 8 : 0;
    for (int i = lane; i < 256; i += 64) hist[i] = 0u;
    __builtin_amdgcn_wave_barrier();
#pragma unroll
    for (int i = 0; i < NV; ++i) { const unsigned x = v[i]; if (x >= lo && x <= hi) atomicAdd(&hist[(x - lo) >> shift], 1u); }
    __builtin_amdgcn_wave_barrier();
    unsigned c[4]; unsigned tot = 0;
#pragma unroll
    for (int j = 0; j < 4; ++j) { c[j] = hist[255 - 4 * lane - j]; tot += c[j]; }
    unsigned incl = tot;
#pragma unroll
    for (int o = 1; o < 64; o <<= 1) { const unsigned t = su(incl, o); if (lane >= o) incl += t; }
    const unsigned excl = incl - tot;
    const bool mine = (excl < (unsigned)need) && (incl >= (unsigned)need);
    int bsel = 0; unsigned above = 0, nstar = 0;
    if (mine) {
      unsigned run = excl;
#pragma unroll
      for (int j = 0; j < 4; ++j) { if (run < (unsigned)need && run + c[j] >= (unsigned)need) { bsel = 255 - 4 * lane - j; above = run; nstar = c[j]; } run += c[j]; }
    }
    const unsigned long long mk = __ballot(mine);
    const int src = __ffsll((long long)mk) - 1;
    bsel = sh(bsel, src); above = sh(above, src); nstar = sh(nstar, src);
    need -= (int)above;
    unsigned nlo = 0xffffffffu, nhi = 0u; int cnt = 0;
#pragma unroll
    for (int i = 0; i < NV; ++i) {
      const unsigned x = v[i];
      const bool in = (x >= lo && x <= hi) && ((int)((x - lo) >> shift) == bsel);
      if (in) { nlo = nlo < x ? nlo : x; nhi = nhi > x ? nhi : x; }
      if (nstar <= 64u) {
        const unsigned long long m = __ballot(in);
        if (in) { const int pos = cnt + __builtin_amdgcn_mbcnt_hi((unsigned)(m >> 32), __builtin_amdgcn_mbcnt_lo((unsigned)m, 0u)); cval[pos] = x; }
        cnt += __popcll(m);
      }
    }
    nlo = wave_umin_u(nlo); nhi = wave_umax_u(nhi);
    if (nstar <= 64u) {
      __builtin_amdgcn_wave_barrier();
      const bool act = lane < (int)nstar;
      const unsigned mv = act ? cval[lane] : 0u;
      int rank = 0;
      for (int j = 0; j < (int)nstar; ++j) rank += (cval[j] > mv) ? 1 : 0;
      const unsigned long long mm = __ballot(act && rank == need - 1);
      const int s2 = __ffsll((long long)mm) - 1;
      tau = (unsigned)sh((int)mv, s2 < 0 ? 0 : s2);
      break;
    }
    lo = nlo; hi = nhi;
  }
  int pos = 0;
#pragma unroll
  for (int i = 0; i < NV; ++i) {
    const bool keep = v[i] >= tau && v[i] != 0u;
    const unsigned long long m = __ballot(keep);
    if (keep) { const int p = pos + __builtin_amdgcn_mbcnt_hi((unsigned)(m >> 32), __builtin_amdgcn_mbcnt_lo((unsigned)m, 0u)); if (p < IX_CAP) ck[p] = v[i]; }
    pos += __popcll(m);
  }
  if (lane == 0) { ((unsigned*)(smem + IX_CNT))[q] = 256u; ((unsigned*)(smem + IX_CNT))[16 + q] = tau; }
}
__device__ __forceinline__ void quick_compact(char* smem, int q, int n, int lane) {
  unsigned* ck = (unsigned*)(smem + IX_CK) + q * IX_CAP;
  unsigned v[IX_NV];
#pragma unroll
  for (int i = 0; i < IX_NV; ++i) { const int e = i * 64 + lane; v[i] = (e < n) ? ck[e] : 0u; }
  const unsigned smp = v[0];
  int rank = 0;
#pragma unroll
  for (int m = 0; m < 64; ++m) rank += ((unsigned)__builtin_amdgcn_readlane((int)smp, m) > smp) ? 1 : 0;
  int r = (64 * 336 + n / 2) / n; r = r < 1 ? 1 : (r > 62 ? 62 : r);
  unsigned thr = 0u; int kept = n; bool ok = false;
  for (int it = 0; it < 6; ++it) {
    const unsigned long long mm = __ballot(rank == r);
    const int src = __ffsll((long long)mm) - 1;
    const unsigned cand = (unsigned)__builtin_amdgcn_readlane((int)smp, src < 0 ? 0 : src);
    int c = 0;
#pragma unroll
    for (int i = 0; i < IX_NV; ++i) c += __popcll(__ballot(v[i] > cand));
    if (c >= 256 && c <= 448) { thr = cand; kept = c; ok = true; break; }
    int r2 = (r * 336 + (c > 0 ? c / 2 : 0)) / (c > 0 ? c : 1);
    if (r2 == r) r2 = (c < 256) ? r + 1 : r - 1;
    r = r2 < 1 ? 1 : (r2 > 62 ? 62 : r2);
  }
  if (!ok) {
    unsigned lo = 0xffffffffu, hi = 0u;
#pragma unroll
    for (int i = 0; i < IX_NV; ++i) { const unsigned x = (i * 64 + lane < n) ? v[i] : 0xffffffffu; lo = lo < x ? lo : x; hi = hi > v[i] ? hi : v[i]; }
    lo = wave_umin_u(lo); hi = wave_umax_u(hi);
    unsigned a = lo, b = hi; thr = 0u; kept = n;
    for (int it = 0; it < 34 && kept > 448; ++it) {
      const unsigned mid = a + ((b - a) >> 1);
      if (mid == a) break;
      int c = 0;
#pragma unroll
      for (int i = 0; i < IX_NV; ++i) c += __popcll(__ballot(v[i] > mid));
      if (c >= 256) { a = mid; thr = mid; kept = c; } else b = mid;
    }
  }
  int pos = 0;
#pragma unroll
  for (int i = 0; i < IX_NV; ++i) {
    const bool keep = v[i] > thr;
    const unsigned long long m = __ballot(keep);
    if (keep) { const int p = pos + __builtin_amdgcn_mbcnt_hi((unsigned)(m >> 32), __builtin_amdgcn_mbcnt_lo((unsigned)m, 0u)); ck[p] = v[i]; }
    pos += __popcll(m);
  }
  if (lane == 0) { ((unsigned*)(smem + IX_CNT))[q] = (unsigned)kept; ((unsigned*)(smem + IX_CNT))[16 + q] = thr; }
}
__device__ __forceinline__ void emit_sorted(char* smem, int q, u16* sel, int lane, int wv) {
  const unsigned* ck = (const unsigned*)(smem + IX_CK) + q * IX_CAP;
  unsigned* bm = (unsigned*)(smem + IX_HIST) + wv * 256;
  for (int i = lane; i < 256; i += 64) bm[i] = 0u;
  __builtin_amdgcn_wave_barrier();
#pragma unroll
  for (int k = 0; k < 4; ++k) { const unsigned idx = 8191u - (ck[k * 64 + lane] & 0x1fffu); atomicOr(&bm[idx >> 5], 1u << (idx & 31)); }
  __builtin_amdgcn_wave_barrier();
  unsigned w[4]; unsigned tot = 0;
#pragma unroll
  for (int j = 0; j < 4; ++j) { w[j] = bm[4 * lane + j]; tot += __popc(w[j]); }
  unsigned incl = tot;
#pragma unroll
  for (int o = 1; o < 64; o <<= 1) { const unsigned t = su(incl, o); if (lane >= o) incl += t; }
  unsigned p = incl - tot;
#pragma unroll
  for (int j = 0; j < 4; ++j) {
    unsigned x = w[j];
    while (x) { const int bb = __ffs((int)x) - 1; if (p < 256u) sel[p] = (u16)(lane * 128 + j * 32 + bb); ++p; x &= x - 1; }
  }
}

#define ATT_ROWB 544
__device__ __forceinline__ int t5_bucket(int rel) {
  const int n = rel < 0 ? -rel : rel;
  const int lg = 8 + (n >= 12) + (n >= 16) + (n >= 23) + (n >= 32) + (n >= 46) + (n >= 64) + (n >= 91);
  return (rel > 0 ? 16 : 0) + (n < 8 ? n : lg);
}
#define DSA_SBIAS 139264
#define DSA_SSEL 140288
#define LDS_XB 148480
#define LDS_UNIT 148496
#define DSA_SBK 148544
#define LDS_TOTAL 154880
__device__ __forceinline__ void attn_query(const Params& P, int tv, const u16* ssel, char* rows, const float* sbias, unsigned char* sbk, int lane) {
  const int t = __builtin_amdgcn_readfirstlane(tv);
  const int lr = lane & 15, g = lane >> 4;
  const u16* ckv = (const u16*)(P.ws + OFF_CKVN);
  u16* qlat = (u16*)P.out;
  const int b = t >> 13, pos = t & 8191, L = ((pos >> 6) + 1) * 64, n = L < 256 ? L : 256;
  const u16* kb = ckv + (long)(b * SEQ) * 256;
  bf16x8 bq[8];
#pragma unroll
  for (int ks = 0; ks < 8; ++ks) {
    bf16x8 v = (bf16x8){0, 0, 0, 0, 0, 0, 0, 0};
    if (lr < 8) v = *(const bf16x8*)(qlat + (long)t * 2048 + lr * 256 + ks * 32 + g * 8);
    bq[ks] = v;
  }
  {
    unsigned pk = 0u;
#pragma unroll
    for (int j = 0; j < 4; ++j) pk |= (unsigned)t5_bucket((int)ssel[lane * 4 + j] - pos) << (8 * j);
    *(unsigned*)(sbk + lane * 4) = pk;
  }
  int nfarblk;
  {
    int c = 0;
#pragma unroll
    for (int j = 0; j < 4; ++j) c += __popcll(__ballot((lane * 4 + j) < n && (int)ssel[lane * 4 + j] <= pos - 91));
    nfarblk = __builtin_amdgcn_readfirstlane(c) >> 4;
  }
  const float farb = sbias[15 * 8 + (lr & 7)];
  __builtin_amdgcn_wave_barrier();
  float m_run = -3.0e38f, l_run = 0.f;
  f32x4 O[16];
#pragma unroll
  for (int i = 0; i < 16; ++i) O[i] = (f32x4){0.f, 0.f, 0.f, 0.f};
  const int nb = n >> 4;
  const int grow = lane >> 5, gch = (lane & 31);
  const int q = lr >> 2, pp = lr & 3;
  u32x4 gr[8];
#pragma unroll 1
  for (int j = 0; j < 2; ++j) {
#pragma unroll
    for (int i = 0; i < 8; ++i) { const unsigned idx = ssel[j * 16 + i * 2 + grow]; gr[i] = *(const u32x4*)((const char*)kb + (size_t)(idx * 512u + (unsigned)gch * 16u)); }
#pragma unroll
    for (int i = 0; i < 8; ++i) *(u32x4*)(rows + j * (16 * ATT_ROWB) + (i * 2 + grow) * ATT_ROWB + (gch ^ (i >> 2)) * 16) = gr[i];
  }
  __builtin_amdgcn_wave_barrier();
  auto qk_soft = [&](int j) -> s16x4 {
    const char* buf = rows + (j & 1) * (16 * ATT_ROWB);
    f32x4 S = (f32x4){0.f, 0.f, 0.f, 0.f}, S1 = (f32x4){0.f, 0.f, 0.f, 0.f};
#pragma unroll
    for (int ks = 0; ks < 8; ks += 2) {
      const bf16x8 a0 = *(const bf16x8*)(buf + lr * ATT_ROWB + ((ks * 4 + g) ^ (lr >> 3)) * 16), a1 = *(const bf16x8*)(buf + lr * ATT_ROWB + (((ks + 1) * 4 + g) ^ (lr >> 3)) * 16);
      S = mfma16(a0, bq[ks], S); S1 = mfma16(a1, bq[ks + 1], S1);
    }
    float mx = -3.0e38f;
    if (j < nfarblk) {
#pragma unroll
      for (int r = 0; r < 4; ++r) { S[r] = S[r] + S1[r] + farb; mx = fmaxf(mx, S[r]); }
    } else {
#pragma unroll
      for (int r = 0; r < 4; ++r) { S[r] = S[r] + S1[r] + sbias[(int)sbk[j * 16 + g * 4 + r] * 8 + (lr & 7)]; mx = fmaxf(mx, S[r]); }
    }
    if (__any(mx > m_run + 8.f)) {
      mx = fmaxf(mx, sx(mx, 16)); mx = fmaxf(mx, sx(mx, 32));
      const float m_new = fmaxf(m_run, mx);
      const float alpha = __expf(m_run - m_new);
      l_run *= alpha; m_run = m_new;
      float al[4];
#pragma unroll
      for (int r = 0; r < 4; ++r) al[r] = sh(alpha, g * 4 + r);
#pragma unroll
      for (int ct = 0; ct < 16; ++ct)
#pragma unroll
        for (int r = 0; r < 4; ++r) O[ct][r] *= al[r];
    }
    float ps = 0.f; s16x4 ap;
#pragma unroll
    for (int r = 0; r < 4; ++r) { const float pv = __expf(S[r] - m_run); ps += pv; ap[r] = (short)f2bf(pv); }
    l_run += ps;
    return ap;
  };
  s16x4 ap = qk_soft(0);
#pragma unroll 1
  for (int kbk = 0; kbk < nb; ++kbk) {
    const char* cur = rows + (kbk & 1) * (16 * ATT_ROWB);
    const bool more2 = (kbk + 2) < nb;
    if (more2) {
#pragma unroll
      for (int i = 0; i < 8; ++i) { const unsigned idx = ssel[(kbk + 2) * 16 + i * 2 + grow]; gr[i] = *(const u32x4*)((const char*)kb + (size_t)(idx * 512u + (unsigned)gch * 16u)); }
    }
    const char* tb0 = cur + (4 * g + q) * ATT_ROWB + ((pp * 8) ^ ((g >> 1) * 16));
#pragma unroll
    for (int ct = 0; ct < 16; ++ct) {
      const s16x4 bv = __builtin_amdgcn_ds_read_tr16_b64_v4i16((LAS s16x4*)(tb0 + ct * 32));
      O[ct] = __builtin_amdgcn_mfma_f32_16x16x16bf16_1k(ap, bv, O[ct], 0, 0, 0);
    }
    if (kbk + 1 < nb) ap = qk_soft(kbk + 1);
    __builtin_amdgcn_wave_barrier();
    if (more2) {
      char* dstb = rows + (kbk & 1) * (16 * ATT_ROWB);
#pragma unroll
      for (int i = 0; i < 8; ++i) *(u32x4*)(dstb + (i * 2 + grow) * ATT_ROWB + (gch ^ (i >> 2)) * 16) = gr[i];
    }
    __builtin_amdgcn_wave_barrier();
  }
  float lt = l_run; lt += sx(lt, 16); lt += sx(lt, 32);
  const float inv = 1.f / lt;
  float iv[4];
#pragma unroll
  for (int r = 0; r < 4; ++r) iv[r] = sh(inv, g * 4 + r);
  if (g < 2) {
#pragma unroll
    for (int ct = 0; ct < 16; ++ct)
#pragma unroll
      for (int r = 0; r < 4; ++r) qlat[(long)t * 2048 + (g * 4 + r) * 256 + ct * 16 + lr] = f2bf(O[ct][r] * iv[r]);
  }
}

__device__ __forceinline__ void dsa_unit(const Params& P, char* smem, int unit, int bid) {
  const int tidx = otid();
  const int tid = tidx, lane = tid & 63, wv = tid >> 6, lr = lane & 15, g = lane >> 4;
  const u16* qi = (const u16*)(P.ws + OFF_QI); const u16* kidx = (const u16*)(P.ws + OFF_KIDXN); const float* widx = (const float*)(P.ws + OFF_WIDX);
  u16* sselw = (u16*)(smem + DSA_SSEL) + wv * 512;
  const float* sbias = (const float*)(smem + DSA_SBIAS);
  unsigned* scnt = (unsigned*)(smem + IX_CNT); unsigned* stau = (unsigned*)(smem + IX_CNT) + 16;
  const int t0 = unit * 16, b = t0 >> 13, pos0 = t0 & 8191, L = ((pos0 >> 6) + 1) * 64;
  __syncthreads();
  if (L > 256) {
    if (tid < 16) { scnt[tid] = (unsigned)(L < 2048 ? L : 2048); stau[tid] = 0u; }
    bf16x8 a[8][2];
#pragma unroll
    for (int h = 0; h < 8; ++h)
#pragma unroll
      for (int ks = 0; ks < 2; ++ks) a[h][ks] = *(const bf16x8*)(qi + (long)(t0 + lr) * 512 + h * 64 + ks * 32 + g * 8);
    float wq[8];
    {
      const float4 w0 = *(const float4*)(widx + (long)(t0 + lr) * 8), w1 = *(const float4*)(widx + (long)(t0 + lr) * 8 + 4);
      wq[0] = w0.x; wq[1] = w0.y; wq[2] = w0.z; wq[3] = w0.w; wq[4] = w1.x; wq[5] = w1.y; wq[6] = w1.z; wq[7] = w1.w;
    }
    unsigned tauk = 0u;
    LAS unsigned* ckq = (LAS unsigned*)(smem + IX_CK) + lr * IX_CAP;
    LAS unsigned* cntq = (LAS unsigned*)(smem + IX_CNT) + lr;
    const u16* kb = kidx + (long)(b * SEQ) * 64;
    const int nkt = L >> 4;
    bf16x8 c0[2], c1[2];
    {
      int k0 = wv; k0 = k0 < nkt ? k0 : nkt - 1;
      c0[0] = *(const bf16x8*)((const char*)kb + (size_t)((unsigned)(k0 * 16 + lr) * 128u + (unsigned)g * 16u)); c0[1] = *(const bf16x8*)((const char*)kb + (size_t)((unsigned)(k0 * 16 + lr) * 128u + 64u + (unsigned)g * 16u));
    }
    __syncthreads();
    const int nti = ((nkt + 63) >> 6) * 8;
#pragma unroll 1
    for (int i = 0; i < nti; ++i) {
      {
        int k1 = wv + 8 * (i + 1); k1 = k1 < nkt ? k1 : nkt - 1;
        c1[0] = *(const bf16x8*)((const char*)kb + (size_t)((unsigned)(k1 * 16 + lr) * 128u + (unsigned)g * 16u)); c1[1] = *(const bf16x8*)((const char*)kb + (size_t)((unsigned)(k1 * 16 + lr) * 128u + 64u + (unsigned)g * 16u));
      }
      const int kt = wv + 8 * i;
      if (kt < nkt) {
        float s[4] = {0.f, 0.f, 0.f, 0.f};
#pragma unroll
        for (int h = 0; h < 8; ++h) {
          f32x4 d = mfma16(c0[0], a[h][0], (f32x4){0.f, 0.f, 0.f, 0.f}); d = mfma16(c0[1], a[h][1], d);
#pragma unroll
          for (int r = 0; r < 4; ++r) s[r] = fmaf(relu_raw(d[r]), wq[h], s[r]);
        }
        if (i < 16) {
#pragma unroll
          for (int r = 0; r < 4; ++r) { const int key = kt * 16 + g * 4 + r; ckq[key] = (fkey(s[r]) & 0xffffe000u) | (unsigned)(8191 - key); }
        } else {
          unsigned kk[4]; bool pr[4]; int np = 0;
#pragma unroll
          for (int r = 0; r < 4; ++r) {
            const int key = kt * 16 + g * 4 + r;
            kk[r] = (fkey(s[r]) & 0xffffe000u) | (unsigned)(8191 - key);
            pr[r] = kk[r] > tauk;
            np += pr[r] ? 1 : 0;
          }
          if (np > 0) {
            unsigned slot = __hip_atomic_fetch_add(cntq, (unsigned)np, __ATOMIC_RELAXED, __HIP_MEMORY_SCOPE_WORKGROUP);
#pragma unroll
            for (int r = 0; r < 4; ++r) { if (pr[r]) { if (slot < (unsigned)IX_CAP) ckq[slot] = kk[r]; ++slot; } }
          }
        }
      }
      c0[0] = c1[0]; c0[1] = c1[1];
      const bool last = (i + 1 >= nti);
      if ((i & 7) == 7 && (i >= 15 || last)) {
        __syncthreads();
#pragma unroll 1
        for (int qq = 0; qq < 2; ++qq) {
          const int q = wv * 2 + qq; const int n = (int)scnt[q];
          const int nn = n > IX_CAP ? IX_CAP : n;
          if (n > 1024) {
            quick_compact(smem, q, nn, lane);
            if (last) compact_query<8>(smem, q, (int)scnt[q], lane, wv);
          } else if (last && n > 512) compact_query<16>(smem, q, nn, lane, wv);
          else if (last && n > 256) compact_query<8>(smem, q, nn, lane, wv);
        }
        __syncthreads();
        tauk = stau[lr];
      }
    }
#pragma unroll 1
    for (int qq = 0; qq < 2; ++qq) emit_sorted(smem, wv * 2 + qq, sselw + qq * 256, lane, wv);
  } else {
#pragma unroll 1
    for (int qq = 0; qq < 2; ++qq) { u16* sel = sselw + qq * 256; for (int j = lane; j < 256; j += 64) sel[j] = (u16)(j < L ? j : 0); }
  }
  __syncthreads();
#pragma unroll 1
  for (int qq = 0; qq < 2; ++qq) attn_query(P, t0 + wv * 2 + qq, sselw + qq * 256, smem + wv * (32 * ATT_ROWB), sbias, (unsigned char*)(smem + DSA_SBK) + (wv * 2 + qq) * 256, lane);
}
__device__ __forceinline__ void dsa_queue_phase(const Params& P, char* smem, int bid, unsigned* qctr) {
  const int tidx = otid();
  const int tid = tidx;
  float* sbias = (float*)(smem + DSA_SBIAS);
  volatile int* sunit = (volatile int*)(smem + LDS_UNIT);
  const int pref = (int)(xb_xcc_id() & 3u);
  __syncthreads();
  for (int i = tid; i < 256; i += NTHR) sbias[i] = P.rel_bias[i];
  int qoff = 0;
  for (;;) {
    __syncthreads();
    if (otid() == 0) {
      int unit = -1; int qo = qoff;
      while (qo < 4) {
        const int bq = (pref + qo) & 3;
        const unsigned v = atomicAdd(qctr + bq * 64, 1u);
        if (v < 512u) { unit = bq * 512 + (511 - (int)v); break; }
        ++qo;
      }
      sunit[0] = unit; sunit[1] = qo;
    }
    __syncthreads();
    const int unit = sunit[0]; qoff = sunit[1];
    if (unit < 0) break;
    dsa_unit(P, smem, unit, bid);
  }
}

__device__ __forceinline__ void dn_prep_phase(const Params& P, int bid, int nblk) {
  const int tidx = otid();
  const int lane = tidx & 63, wv = tidx >> 6, hh = lane >> 4, cg = lane & 15;
  const u16* Pb = (const u16*)(P.ws + OFF_PB); const u16* Pa = (const u16*)(P.ws + OFF_PA);
  u16* qkv = (u16*)(P.ws + OFF_QKV);
  float* gg = (float*)(P.ws + OFF_GB); float* bt = gg + 16 * 8192;
  float w[3][4][8];
#pragma unroll
  for (int sec = 0; sec < 3; ++sec)
#pragma unroll
    for (int j = 0; j < 4; ++j) {
      const float4 w0 = *(const float4*)(P.conv_w + j * 1536 + sec * 512 + hh * 128 + cg * 8), w1 = *(const float4*)(P.conv_w + j * 1536 + sec * 512 + hh * 128 + cg * 8 + 4);
      w[sec][j][0] = w0.x; w[sec][j][1] = w0.y; w[sec][j][2] = w0.z; w[sec][j][3] = w0.w; w[sec][j][4] = w1.x; w[sec][j][5] = w1.y; w[sec][j][6] = w1.z; w[sec][j][7] = w1.w;
    }
  const float dtb = P.dt_bias[hh], aexp = __expf(P.A_log[hh]);
  for (int chk = bid * 8 + wv; chk < T_TOK / 16; chk += nblk * 8) {
    const int t0 = chk * 16, b = t0 >> 13, pos0 = t0 & 8191;
    u32x4 win[3][4];
#pragma unroll
    for (int sec = 0; sec < 3; ++sec) {
      const int col = sec * 512 + hh * 128 + cg * 8;
#pragma unroll
      for (int k = 0; k < 3; ++k) {
        u32x4 z = (u32x4){0u, 0u, 0u, 0u};
        if (pos0 - 3 + k >= 0) z = *(const u32x4*)(Pb + (long)(t0 - 3 + k) * 1536 + col);
        win[sec][k] = z;
      }
      win[sec][3] = *(const u32x4*)(Pb + (long)t0 * 1536 + col);
    }
#pragma unroll 1
    for (int i = 0; i < 16; ++i) {
      const int t = t0 + i, pos = pos0 + i;
      u32x4 nxt[3];
#pragma unroll
      for (int sec = 0; sec < 3; ++sec) nxt[sec] = *(const u32x4*)(Pb + (long)(i < 15 ? t + 1 : t) * 1536 + sec * 512 + hh * 128 + cg * 8);
      float abv = 0.f;
      if (cg == 0) abv = bf2f(Pa[(long)t * 768 + 584 + hh]);
      float bbv = 0.f;
      if (cg == 0) bbv = bf2f(Pa[(long)t * 768 + 588 + hh]);
#pragma unroll
      for (int sec = 0; sec < 3; ++sec) {
        float y[8];
#pragma unroll
        for (int e = 0; e < 8; ++e) y[e] = 0.f;
#pragma unroll
        for (int j = 0; j < 4; ++j) {
          const u32x4 xv = win[sec][j];
          y[0] += w[sec][j][0] * lo2f(xv[0]); y[1] += w[sec][j][1] * hi2f(xv[0]); y[2] += w[sec][j][2] * lo2f(xv[1]); y[3] += w[sec][j][3] * hi2f(xv[1]);
          y[4] += w[sec][j][4] * lo2f(xv[2]); y[5] += w[sec][j][5] * hi2f(xv[2]); y[6] += w[sec][j][6] * lo2f(xv[3]); y[7] += w[sec][j][7] * hi2f(xv[3]);
        }
        float ss = 0.f;
#pragma unroll
        for (int e = 0; e < 8; ++e) { y[e] = y[e] / (1.f + __expf(-y[e])); ss += y[e] * y[e]; }
        ss += sx(ss, 1); ss += sx(ss, 2); ss += sx(ss, 4); ss += sx(ss, 8);
        float sc = 1.f;
        if (sec == 0) sc = rsqrtf(ss + EPSV) * 0.08838834764831845f;
        else if (sec == 1) sc = rsqrtf(ss + EPSV);
        u32x4 o;
#pragma unroll
        for (int e = 0; e < 4; ++e) o[e] = pack2(y[2 * e] * sc, y[2 * e + 1] * sc);
        *(u32x4*)(qkv + (long)sec * (16l * 8192 * 128) + ((long)(b * 4 + hh) * 8192 + pos) * 128 + cg * 8) = o;
        win[sec][0] = win[sec][1]; win[sec][1] = win[sec][2]; win[sec][2] = win[sec][3]; win[sec][3] = nxt[sec];
      }
      if (cg == 0) {
        const float z = abv + dtb;
        const float sp = z > 20.f ? z : log1pf(__expf(z));
        gg[(long)(b * 4 + hh) * 8192 + pos] = -aexp * sp;
        bt[(long)(b * 4 + hh) * 8192 + pos] = 1.f / (1.f + __expf(-bbv));
      }
    }
  }
}

__device__ __forceinline__ int perm32_pos(int c) {
  const int blk = c & ~31, w = c & 31;
  const int hi = w >> 4, gq = (w >> 2) & 3, lo = w & 3;
  return blk + gq * 8 + hi * 4 + lo;
}
__device__ __forceinline__ void dn_intra_phase(const Params& P, char* smem, int bid, int nblk) {
  const int tidx = otid();
  const int tid = tidx, lane = tid & 63, wv = tid >> 6, lr = lane & 15, g = lane >> 4;
  u16* qkv = (u16*)(P.ws + OFF_QKV);
  const float* gg = (const float*)(P.ws + OFF_GB); const float* bt = gg + 16 * 8192; float* cdec = (float*)(P.ws + OFF_GB) + 32 * 8192;
  u16* wdn = (u16*)(P.ws + OFF_WDN); u16* intra = (u16*)(P.ws + OFF_INTRA);
  char* sQ = smem;
  char* sK = smem + 16384;
  char* sV = smem + 32768;
  float* sMT = (float*)(smem + 49152);
  float* sG = (float*)(smem + 66560);
  float* sX = (float*)(smem + 67584);
  u16* sI = (u16*)(smem + 133632);
  float* sT = (float*)(smem + 141824);
  u32x4 pre[6]; float pgv = 0.f, pbv = 0.f;
  if (bid < 2048) {
    const int bh0 = bid >> 7, ch0 = bid & 127;
    const long tb0 = ((long)bh0 * 8192 + ch0 * 64) * 128;
#pragma unroll
    for (int k = 0; k < 6; ++k) {
      const int i = tid + k * NTHR;
      const int which = i >> 10, q = i & 1023;
      pre[k] = *(const u32x4*)(qkv + (long)which * (16l * 8192 * 128) + tb0 + q * 8);
    }
    if (tid < 64) { pgv = gg[(long)bh0 * 8192 + ch0 * 64 + tid]; pbv = bt[(long)bh0 * 8192 + ch0 * 64 + tid]; }
  }
  for (int u = bid; u < 2048; u += nblk) {
    const int tidl = otid();
    const int tid = tidl, lane = tid & 63, wv = tid >> 6, lr = lane & 15, g = lane >> 4;
    const int bh = u >> 7, ch = u & 127;
    const long tbase = ((long)bh * 8192 + ch * 64) * 128;
    u16* tq = qkv + tbase; u16* tk = qkv + 16l * 8192 * 128 + tbase; u16* tv = qkv + 32l * 8192 * 128 + tbase;
    __syncthreads();
#pragma unroll
    for (int k = 0; k < 6; ++k) {
      const int i = tid + k * NTHR;
      const int which = i >> 10, q = i & 1023, row = q >> 4, chk = q & 15;
      *(u32x4*)(smem + which * 16384 + row * 256 + ((chk ^ (row & 15)) << 4)) = pre[k];
    }
    if (tid < 64) {
      float sc = pgv;
#pragma unroll
      for (int o = 1; o < 64; o <<= 1) { const float t = su(sc, o); if (tid >= o) sc += t; }
      sG[tid] = sc; sG[64 + tid] = pbv;
    }
    __syncthreads();
    {
      const int mi = wv & 3; const char* sAop = (wv < 4) ? sK : sQ;
      bf16x8 a[4];
#pragma unroll
      for (int ks = 0; ks < 4; ++ks) { const int row = mi * 16 + lr; a[ks] = *(const bf16x8*)(sAop + row * 256 + (((ks * 4 + g) ^ (row & 15)) << 4)); }
#pragma unroll
      for (int ni = 0; ni < 4; ++ni) {
        f32x4 d = (f32x4){0.f, 0.f, 0.f, 0.f};
#pragma unroll
        for (int ks = 0; ks < 4; ++ks) { const int row = ni * 16 + lr; const bf16x8 bb = *(const bf16x8*)(sK + row * 256 + (((ks * 4 + g) ^ (row & 15)) << 4)); d = mfma16(a[ks], bb, d); }
        const int j = ni * 16 + lr; const float gj = sG[j];
#pragma unroll
        for (int r = 0; r < 4; ++r) {
          const int i = mi * 16 + g * 4 + r; const float gi = sG[i];
          if (wv < 4) { sMT[j * 68 + i] = (j < i) ? sG[64 + i] * d[r] * __expf(gi - gj) : 0.f; }
          else { const float v = (j <= i) ? d[r] * __expf(gi - gj) : 0.f; sI[i * 64 + perm32_pos(j)] = f2bf(v); }
        }
      }
    }
    __syncthreads();
    if (wv == 0) {
      const int bi = lane >> 4, c = lane & 15;
      float t[16];
#pragma unroll
      for (int r = 0; r < 16; ++r) t[r] = (r == c) ? 1.f : 0.f;
#pragma unroll
      for (int q = 0; q < 15; ++q) {
        const float* mcol = sMT + (bi * 16 + q) * 68 + bi * 16;
        float m[16];
#pragma unroll
        for (int q4 = (q + 1) >> 2; q4 < 4; ++q4) { const float4 tt = *(const float4*)(mcol + q4 * 4); m[q4 * 4] = tt.x; m[q4 * 4 + 1] = tt.y; m[q4 * 4 + 2] = tt.z; m[q4 * 4 + 3] = tt.w; }
#pragma unroll
        for (int r = q + 1; r < 16; ++r) t[r] = fmaf(-m[r], t[q], t[r]);
      }
#pragma unroll
      for (int r = 0; r < 16; ++r) sT[bi * 272 + r * 17 + c] = t[r];
    } else if (wv <= 4) {
      const int t2 = tid - 64;
      const float glast = sG[63];
      {
        const int row = t2 >> 2, blk = t2 & 3;
        const float eg = __expf(sG[row]);
        float e[32];
#pragma unroll
        for (int c4 = 0; c4 < 4; ++c4) {
          const u32x4 v = *(const u32x4*)(sQ + row * 256 + (((blk * 4 + c4) ^ (row & 15)) << 4));
#pragma unroll
          for (int k = 0; k < 4; ++k) { e[c4 * 8 + 2 * k] = lo2f(v[k]) * eg; e[c4 * 8 + 2 * k + 1] = hi2f(v[k]) * eg; }
        }
#pragma unroll
        for (int gq = 0; gq < 4; ++gq) {
          u32x4 o;
#pragma unroll
          for (int k = 0; k < 4; ++k) { const int j0 = 2 * k, j1 = 2 * k + 1; o[k] = pack2(e[16 * (j0 >> 2) + 4 * gq + (j0 & 3)], e[16 * (j1 >> 2) + 4 * gq + (j1 & 3)]); }
          *(u32x4*)(tq + row * 128 + blk * 32 + gq * 8) = o;
        }
      }
      {
        const int dk = t2 >> 1, blk = t2 & 1;
        float e[32];
#pragma unroll
        for (int ii = 0; ii < 32; ++ii) {
          const int i = blk * 32 + ii;
          e[ii] = bf2f(*(const u16*)(sK + i * 256 + (((dk >> 3) ^ (i & 15)) << 4) + (dk & 7) * 2)) * __expf(glast - sG[i]);
        }
#pragma unroll
        for (int gq = 0; gq < 4; ++gq) {
          u32x4 o;
#pragma unroll
          for (int k = 0; k < 4; ++k) { const int j0 = 2 * k, j1 = 2 * k + 1; o[k] = pack2(e[16 * (j0 >> 2) + 4 * gq + (j0 & 3)], e[16 * (j1 >> 2) + 4 * gq + (j1 & 3)]); }
          *(u32x4*)(tk + dk * 64 + blk * 32 + gq * 8) = o;
        }
      }
#pragma unroll
      for (int k = 0; k < 2; ++k) { const int q = t2 + k * 256; *(u32x4*)(intra + (long)u * 4096 + q * 8) = *(const u32x4*)(sI + q * 8); }
      if (t2 == 0) cdec[u] = __expf(glast);
    }
    __syncthreads();
    if (u + nblk < 2048) {
      const int u2 = u + nblk; const int bh2 = u2 >> 7, ch2 = u2 & 127;
      const long tb2 = ((long)bh2 * 8192 + ch2 * 64) * 128;
#pragma unroll
      for (int k = 0; k < 6; ++k) {
        const int i = tid + k * NTHR;
        const int which = i >> 10, q = i & 1023;
        pre[k] = *(const u32x4*)(qkv + (long)which * (16l * 8192 * 128) + tb2 + q * 8);
      }
      if (tid < 64) { pgv = gg[(long)bh2 * 8192 + ch2 * 64 + tid]; pbv = bt[(long)bh2 * 8192 + ch2 * 64 + tid]; }
    }
    {
      const bool isv = wv < 4;
      const char* sSrc = isv ? sV : sK;
      f32x4 X[4][2];
#pragma unroll
      for (int bi = 0; bi < 4; ++bi) {
        f32x4 acc[2];
#pragma unroll
        for (int ct = 0; ct < 2; ++ct) {
          const int cc = (wv & 3) * 32 + ct * 16 + lr;
#pragma unroll
          for (int r = 0; r < 4; ++r) {
            const int i = bi * 16 + g * 4 + r;
            const float raw = bf2f(*(const u16*)(sSrc + i * 256 + (((cc >> 3) ^ (i & 15)) << 4) + (cc & 7) * 2));
            acc[ct][r] = raw * sG[64 + i] * (isv ? 1.f : __expf(sG[i]));
          }
        }
#pragma unroll
        for (int bj = 0; bj < bi; ++bj)
#pragma unroll
          for (int s4 = 0; s4 < 4; ++s4) {
            const float a = -sMT[(bj * 16 + 4 * g + s4) * 68 + bi * 16 + lr];
            acc[0] = __builtin_amdgcn_mfma_f32_16x16x4f32(a, X[bj][0][s4], acc[0], 0, 0, 0);
            acc[1] = __builtin_amdgcn_mfma_f32_16x16x4f32(a, X[bj][1][s4], acc[1], 0, 0, 0);
          }
        f32x4 x0 = (f32x4){0.f, 0.f, 0.f, 0.f}, x1 = (f32x4){0.f, 0.f, 0.f, 0.f};
#pragma unroll
        for (int s4 = 0; s4 < 4; ++s4) {
          const float a = sT[bi * 272 + lr * 17 + 4 * g + s4];
          x0 = __builtin_amdgcn_mfma_f32_16x16x4f32(a, acc[0][s4], x0, 0, 0, 0);
          x1 = __builtin_amdgcn_mfma_f32_16x16x4f32(a, acc[1][s4], x1, 0, 0, 0);
        }
        X[bi][0] = x0; X[bi][1] = x1;
#pragma unroll
        for (int r = 0; r < 4; ++r) {
          sX[(bi * 16 + g * 4 + r) * 257 + wv * 32 + lr] = x0[r];
          sX[(bi * 16 + g * 4 + r) * 257 + wv * 32 + 16 + lr] = x1[r];
        }
      }
    }
    __syncthreads();
    for (int it = tid; it < 2048; it += NTHR) {
      u32x4 o;
      if (it < 1024) {
        const int c = it >> 3, i0 = (it & 7) * 8;
#pragma unroll
        for (int k = 0; k < 4; ++k) o[k] = pack2(sX[(i0 + 2 * k) * 257 + c], sX[(i0 + 2 * k + 1) * 257 + c]);
        *(u32x4*)(tv + c * 64 + i0) = o;
      } else {
        const int q = it - 1024, row = q >> 4, pch = q & 15, b32 = pch >> 2, gq = pch & 3;
        const float* xr = sX + row * 257 + 128 + b32 * 32 + 4 * gq;
#pragma unroll
        for (int k = 0; k < 4; ++k) { const int j0 = 2 * k, j1 = 2 * k + 1; o[k] = pack2(xr[16 * (j0 >> 2) + (j0 & 3)], xr[16 * (j1 >> 2) + (j1 & 3)]); }
        *(u32x4*)(wdn + tbase + row * 128 + pch * 8) = o;
      }
    }
  }
}

#define SCAN_BUF 73728
__device__ __forceinline__ void dn_scan_phase(const Params& P, char* smem, int bid, int nblk) {
  const int tidx = otid();
  const int tid = tidx, lane = tid & 63, wv = tid >> 6, lr = lane & 15, g = lane >> 4;
  const u16* qkv = (const u16*)(P.ws + OFF_QKV);
  const u16* wdn = (const u16*)(P.ws + OFF_WDN); const u16* intra = (const u16*)(P.ws + OFF_INTRA);
  const float* cdec = (const float*)(P.ws + OFF_GB) + 32 * 8192;
  u16* mix = (u16*)(P.ws + OFF_MIX);
  for (int bh = bid; bh < 16; bh += nblk) {
    const int b = bh >> 2, hh = bh & 3;
    f32x4 S[8];
#pragma unroll
    for (int i = 0; i < 8; ++i) S[i] = (f32x4){0.f, 0.f, 0.f, 0.f};
    u32x4 st[9];
    unsigned lofs[9];
#pragma unroll
    for (int i = 0; i < 9; ++i) {
      const int q = tid + i * NTHR;
      unsigned o;
      if (q < 1024) o = (unsigned)OFF_WDN + (unsigned)bh * (8192u * 256u) + q * 16;
      else if (q < 4096) o = (unsigned)OFF_QKV + (unsigned)((q >> 10) - 1) * (16u * 8192u * 256u) + (unsigned)bh * (8192u * 256u) + (q & 1023) * 16;
      else o = (unsigned)OFF_INTRA + (unsigned)bh * (128u * 8192u) + (q - 4096) * 16;
      lofs[i] = o;
    }
    const char* wsb = P.ws;
    auto load_chunk = [&](int n) {
#pragma unroll
      for (int i = 0; i < 9; ++i) {
        const unsigned stride = (i < 8) ? 16384u : 8192u;
        st[i] = *(const u32x4*)(wsb + (size_t)(lofs[i] + (unsigned)n * stride));
      }
    };
    auto store_chunk = [&](int bufi) {
      char* base = smem + bufi * SCAN_BUF;
#pragma unroll
      for (int i = 0; i < 9; ++i) {
        const int q = tid + i * NTHR;
        unsigned off;
        if (q < 2048) { const int qq = q & 1023, row = qq >> 4, chk = qq & 15; off = (q >> 10) * 16384 + row * 256 + ((chk ^ (row & 15)) << 4); }
        else if (q < 4096) { const int qq = q & 1023, row = qq >> 3, chk = qq & 7; off = (q >> 10) * 16384 + row * 128 + ((chk ^ (row & 7)) << 4); }
        else { const int qq = q - 4096, row = qq >> 3, chk = qq & 7; off = 65536 + row * 128 + ((chk ^ (row & 7)) << 4); }
        *(u32x4*)(base + off) = st[i];
      }
    };
    __syncthreads();
    load_chunk(0); store_chunk(0); load_chunk(1);
    __syncthreads();
    for (int n = 0; n < 128; ++n) {
      const char* base = smem + (n & 1) * SCAN_BUF;
      const char* sW = base; const char* sQd = base + 16384; const char* sKT = base + 32768; const char* sUT = base + 49152; const char* sA = base + 65536;
      if (n + 1 < 128) { store_chunk((n + 1) & 1); if (n + 2 < 128) load_chunk(n + 2); }
      const float dcy = cdec[bh * 128 + n];
      bf16x8 sb[4];
#pragma unroll
      for (int s = 0; s < 4; ++s)
#pragma unroll
        for (int j = 0; j < 8; ++j) sb[s][j] = (short)f2bf(S[2 * s + (j >> 2)][j & 3]);
      f32x4 vn[4], o[4];
#pragma unroll
      for (int mi = 0; mi < 4; ++mi) {
        f32x4 dw = (f32x4){0.f, 0.f, 0.f, 0.f}, dq = (f32x4){0.f, 0.f, 0.f, 0.f};
        const int row = mi * 16 + lr;
#pragma unroll
        for (int s = 0; s < 4; ++s) {
          const unsigned off = row * 256 + (((s * 4 + g) ^ (row & 15)) << 4);
          dw = mfma16(*(const bf16x8*)(sW + off), sb[s], dw);
          dq = mfma16(*(const bf16x8*)(sQd + off), sb[s], dq);
        }
        const int urow = wv * 16 + lr;
        const int ucol = mi * 16 + g * 4;
        const u32x2 uv = *(const u32x2*)(sUT + urow * 128 + ((((ucol >> 3)) ^ (urow & 7)) << 4) + (ucol & 7) * 2);
        vn[mi][0] = lo2f(uv[0]) - dw[0]; vn[mi][1] = hi2f(uv[0]) - dw[1]; vn[mi][2] = lo2f(uv[1]) - dw[2]; vn[mi][3] = hi2f(uv[1]) - dw[3];
        o[mi] = dq;
      }
      bf16x8 vb[2];
#pragma unroll
      for (int s = 0; s < 2; ++s)
#pragma unroll
        for (int j = 0; j < 8; ++j) vb[s][j] = (short)f2bf(vn[2 * s + (j >> 2)][j & 3]);
#pragma unroll
      for (int mi = 0; mi < 4; ++mi) {
        const int row = mi * 16 + lr;
#pragma unroll
        for (int s = 0; s < 2; ++s) o[mi] = mfma16(*(const bf16x8*)(sA + row * 128 + (((s * 4 + g) ^ (row & 7)) << 4)), vb[s], o[mi]);
      }
#pragma unroll
      for (int m2 = 0; m2 < 8; ++m2) {
        f32x4 d = S[m2];
#pragma unroll
        for (int r = 0; r < 4; ++r) d[r] *= dcy;
        const int row = m2 * 16 + lr;
#pragma unroll
        for (int s = 0; s < 2; ++s) d = mfma16(*(const bf16x8*)(sKT + row * 128 + (((s * 4 + g) ^ (row & 7)) << 4)), vb[s], d);
        S[m2] = d;
      }
#pragma unroll
      for (int mi = 0; mi < 4; ++mi)
#pragma unroll
        for (int r = 0; r < 4; ++r) {
          const long t = (long)b * 8192 + n * 64 + mi * 16 + g * 4 + r;
          mix[t * 1024 + 512 + hh * 128 + wv * 16 + lr] = f2bf(o[mi][r]);
        }
      __syncthreads();
    }
  }
}

__device__ __forceinline__ void dn_gate_phase(const Params& P, int bid, int nblk) {
  const int tidx = otid();
  const int lane = tidx & 63, wv = tidx >> 6, hh = lane >> 4, cg = lane & 15;
  u16* mix = (u16*)(P.ws + OFF_MIX); const u16* bz = (const u16*)(P.ws + OFF_BZ);
  for (int t = bid * 8 + wv; t < T_TOK; t += nblk * 8) {
    u16* p = mix + (long)t * 1024 + 512 + hh * 128 + cg * 8;
    const u32x4 ov = *(const u32x4*)p; const u32x4 zv = *(const u32x4*)(bz + (long)t * 512 + hh * 128 + cg * 8);
    float o[8], z[8];
#pragma unroll
    for (int e = 0; e < 4; ++e) { o[2 * e] = lo2f(ov[e]); o[2 * e + 1] = hi2f(ov[e]); z[2 * e] = lo2f(zv[e]); z[2 * e + 1] = hi2f(zv[e]); }
    float ss = 0.f;
#pragma unroll
    for (int e = 0; e < 8; ++e) ss += o[e] * o[e];
    ss += sx(ss, 1); ss += sx(ss, 2); ss += sx(ss, 4); ss += sx(ss, 8);
    const float rs = rsqrtf(ss * (1.f / 128) + EPSV);
    u32x4 r;
#pragma unroll
    for (int e = 0; e < 4; ++e) {
      const float a = o[2 * e] * rs * P.g_onorm[cg * 8 + 2 * e] * (z[2 * e] / (1.f + __expf(-z[2 * e])));
      const float bq = o[2 * e + 1] * rs * P.g_onorm[cg * 8 + 2 * e + 1] * (z[2 * e + 1] / (1.f + __expf(-z[2 * e + 1])));
      r[e] = pack2(a, bq);
    }
    *(u32x4*)p = r;
  }
}

__device__ __forceinline__ void xattn_phase(const Params& P, char* smem, int bid, int nblk) {
  const int tidx = otid();
  const int tid = tidx, lane = tid & 63, wv = tid >> 6, lr = lane & 15, g = lane >> 4;
  const u16* qx = (const u16*)(P.ws + OFF_QX); const u16* kx = (const u16*)(P.ws + OFF_KX); const u16* vtx = (const u16*)(P.ws + OFF_VTX);
  u16* ox = (u16*)(P.ws + OFF_OX);
  char* sK = smem; char* sVT = smem + 65536;
  for (int u4 = bid; u4 < 256; u4 += nblk) {
    const int bh = u4 >> 4, b = bh >> 2, hh = bh & 3, grp = u4 & 15;
    __syncthreads();
    for (int i = tid; i < 4096; i += NTHR) {
      const int row = i >> 4, ch = i & 15;
      *(u32x4*)(sK + row * 256 + ((ch ^ (row & 15)) << 4)) = *(const u32x4*)(kx + (long)(b * 256 + row) * 512 + hh * 128 + ch * 8);
    }
    for (int i = tid; i < 4096; i += NTHR) {
      const int row = i >> 5, ch = i & 31;
      *(u32x4*)(sVT + row * 512 + ((ch ^ (row & 15)) << 4)) = *(const u32x4*)(vtx + ((long)b * 512 + hh * 128 + row) * 256 + ch * 8);
    }
    __syncthreads();
    const LAS char* kbs[4]; const LAS char* vbs[8];
#pragma unroll
    for (int ks = 0; ks < 4; ++ks) kbs[ks] = (const LAS char*)sK + lr * 256 + (((ks * 4 + g) ^ lr) << 4);
#pragma unroll
    for (int s2 = 0; s2 < 8; ++s2) vbs[s2] = (const LAS char*)sVT + lr * 512 + (((s2 * 4 + g) ^ lr) << 4);
#pragma unroll 1
    for (int qt = 0; qt < 4; ++qt) {
      asm volatile("" ::: "memory");
      const int t0 = b * 8192 + grp * 512 + qt * 128 + wv * 16;
      bf16x8 bq[4];
#pragma unroll
      for (int ks = 0; ks < 4; ++ks) bq[ks] = *(const bf16x8*)(qx + (long)(t0 + lr) * 512 + hh * 128 + ks * 32 + g * 8);
      f32x4 S[16];
      float mx = -3.0e38f;
#pragma unroll
      for (int m = 0; m < 16; ++m) {
        f32x4 d = (f32x4){0.f, 0.f, 0.f, 0.f};
#pragma unroll
        for (int ks = 0; ks < 4; ++ks) { const bf16x8 a = *(const LAS bf16x8*)(kbs[ks] + m * 4096); d = mfma16(a, bq[ks], d); }
        S[m] = d;
#pragma unroll
        for (int r = 0; r < 4; ++r) mx = fmaxf(mx, d[r]);
      }
      mx = fmaxf(mx, sx(mx, 16)); mx = fmaxf(mx, sx(mx, 32));
      float sum = 0.f;
#pragma unroll
      for (int m = 0; m < 16; ++m)
#pragma unroll
        for (int r = 0; r < 4; ++r) { S[m][r] = __expf(S[m][r] - mx); sum += S[m][r]; }
      sum += sx(sum, 16); sum += sx(sum, 32);
      const float inv = 1.f / sum;
      bf16x8 pb[8];
#pragma unroll
      for (int s2 = 0; s2 < 8; ++s2)
#pragma unroll
        for (int j = 0; j < 8; ++j) pb[s2][j] = (short)f2bf(S[2 * s2 + (j >> 2)][j & 3]);
#pragma unroll
      for (int dt = 0; dt < 8; ++dt) {
        f32x4 o = (f32x4){0.f, 0.f, 0.f, 0.f};
#pragma unroll
        for (int s2 = 0; s2 < 8; ++s2) { const bf16x8 a = *(const LAS bf16x8*)(vbs[s2] + dt * 8192); o = mfma16(a, pb[s2], o); }
        u32x2 w; w[0] = pack2(o[0] * inv, o[1] * inv); w[1] = pack2(o[2] * inv, o[3] * inv);
        *(u32x2*)(ox + (long)(t0 + lr) * 512 + hh * 128 + dt * 16 + g * 4) = w;
      }
    }
  }
}

__device__ __forceinline__ void g6_phase(const Params& P, char* smem, int bid, int nblk) {
  const int tidx = otid();
  const u16* A = (const u16*)(P.ws + OFF_H); const u16* Bt = (const u16*)(P.ws + OFF_WEFFT);
  unsigned* plist = (unsigned*)(P.ws + OFF_PLIST);
  const int tid = tidx;
  for (int t = bid; t < 128 * 16; t += nblk) {
    const int mp = t >> 4, np = t & 15;
    gemm_tile<133>(A + (long)mp * 256 * DM, DM, Bt + (long)np * 128 * DM, DM, DM, smem);
    const float* sC = (const float*)smem;
    const int row = tid >> 1, half = tid & 1;
    const float rs2 = rsqrtf(((const float*)(P.ws + OFF_SSQ2))[mp * 256 + row] * (1.f / DM) + EPSV);
    unsigned tk[16];
#pragma unroll
    for (int i = 0; i < 16; ++i) tk[i] = 0u;
    for (int i = 0; i < 64; ++i) {
      const int c = half * 64 + ((i + half * 16) & 63);
      const unsigned key = (fkey(sC[row * 133 + c] * rs2) & ~127u) | (unsigned)(127 - c);
#pragma unroll
      for (int s = 15; s >= 1; --s) tk[s] = umed3(tk[s - 1], tk[s], key);
      tk[0] = tk[0] > key ? tk[0] : key;
    }
#pragma unroll
    for (int i = 0; i < 16; ++i) {
      const unsigned key = sx(tk[i], 1);
      if (half == 0) {
#pragma unroll
        for (int s = 15; s >= 1; --s) tk[s] = umed3(tk[s - 1], tk[s], key);
        tk[0] = tk[0] > key ? tk[0] : key;
      }
    }
    if (half == 0) {
      unsigned* dst = plist + ((long)(mp * 256 + row) * 16 + np) * 16;
#pragma unroll
      for (int i = 0; i < 4; ++i) { u32x4 o; o[0] = tk[4 * i]; o[1] = tk[4 * i + 1]; o[2] = tk[4 * i + 2]; o[3] = tk[4 * i + 3]; *(u32x4*)(dst + 4 * i) = o; }
    }
  }
}

__device__ __forceinline__ void peer_top16_phase(const Params& P, int bid, int nblk) {
  const int tidx = otid();
  const u16* psc = (const u16*)(P.ws + OFF_PSC);
  unsigned* plist = (unsigned*)(P.ws + OFF_PLIST);
  for (int gid = bid * NTHR + tidx; gid < T_TOK * 16; gid += nblk * NTHR) {
    const u16* src = psc + (long)gid * 128;
    unsigned tk[16];
#pragma unroll
    for (int i = 0; i < 16; ++i) tk[i] = 0u;
#pragma unroll 1
    for (int c8 = 0; c8 < 16; ++c8) {
      const u32x4 v = *(const u32x4*)(src + c8 * 8);
#pragma unroll
      for (int e = 0; e < 8; ++e) {
        const unsigned bits = (e & 1) ? (v[e >> 1] & 0xffff0000u) : (v[e >> 1] << 16);
        const unsigned m = bits ^ ((bits >> 31) ? 0xffffffffu : 0x80000000u);
        const unsigned key = (m & ~127u) | (unsigned)(127 - (c8 * 8 + e));
#pragma unroll
        for (int q = 15; q >= 1; --q) tk[q] = umed3(tk[q - 1], tk[q], key);
        tk[0] = tk[0] > key ? tk[0] : key;
      }
    }
    unsigned* dst = plist + (long)gid * 16;
#pragma unroll
    for (int i = 0; i < 4; ++i) { u32x4 o; o[0] = tk[4 * i]; o[1] = tk[4 * i + 1]; o[2] = tk[4 * i + 2]; o[3] = tk[4 * i + 3]; *(u32x4*)(dst + 4 * i) = o; }
  }
}
__device__ __forceinline__ void peer_combine_phase(const Params& P, char* smem, int bid, int nblk) {
  const int tidx = otid();
  const int tid = tidx;
  const unsigned* plist = (const unsigned*)(P.ws + OFF_PLIST);
  u16* pe = (u16*)(P.ws + OFF_PEIDX); float* pg = (float*)(P.ws + OFF_PGATE);
  unsigned* skeys = (unsigned*)smem + tid * 33;
  for (int gid = bid * NTHR + tid; gid < T_TOK * 8; gid += nblk * NTHR) {
    const unsigned* src = plist + (long)gid * 32;
    unsigned k1[16], k2[16];
#pragma unroll
    for (int q = 0; q < 4; ++q) {
      const u32x4 a = *(const u32x4*)(src + q * 4), c = *(const u32x4*)(src + 16 + q * 4);
      k1[4 * q] = a[0]; k1[4 * q + 1] = a[1]; k1[4 * q + 2] = a[2]; k1[4 * q + 3] = a[3];
      k2[4 * q] = c[0]; k2[4 * q + 1] = c[1]; k2[4 * q + 2] = c[2]; k2[4 * q + 3] = c[3];
    }
#pragma unroll
    for (int i = 0; i < 16; ++i) { skeys[i] = k1[i]; skeys[16 + i] = k2[i]; }
    float s1[16], s2[16];
#pragma unroll
    for (int i = 0; i < 16; ++i) { s1[i] = keyf(k1[i] & ~127u); s2[i] = keyf(k2[i] & ~127u); }
    unsigned tk[16];
#pragma unroll
    for (int i = 0; i < 16; ++i) tk[i] = 0u;
#pragma unroll
    for (int i = 0; i < 16; ++i)
#pragma unroll
      for (int j = 0; j < 16; ++j)
        if ((i + 1) * (j + 1) <= 16) {
          const unsigned key = (fkey(s1[i] + s2[j]) & ~255u) | (unsigned)(255 - (i * 16 + j));
#pragma unroll
          for (int s = 15; s >= 1; --s) tk[s] = umed3(tk[s - 1], tk[s], key);
          tk[0] = tk[0] > key ? tk[0] : key;
        }
    float best[16]; unsigned ex[16]; float mx = -3.0e38f;
#pragma unroll
    for (int k = 0; k < 16; ++k) {
      const int cid = 255 - (int)(tk[k] & 255u); const int i = cid >> 4, j = cid & 15;
      const unsigned ka = skeys[i], kb2 = skeys[16 + j];
      best[k] = keyf(ka & ~127u) + keyf(kb2 & ~127u);
      ex[k] = (unsigned)((127 - (int)(ka & 127u)) * 128 + (127 - (int)(kb2 & 127u)));
      mx = fmaxf(mx, best[k]);
    }
    float sm = 0.f;
#pragma unroll
    for (int k = 0; k < 16; ++k) { best[k] = __expf(best[k] - mx); sm += best[k]; }
    const float inv = 1.f / sm;
#pragma unroll
    for (int k4 = 0; k4 < 4; ++k4) { float4 o; o.x = best[4 * k4] * inv; o.y = best[4 * k4 + 1] * inv; o.z = best[4 * k4 + 2] * inv; o.w = best[4 * k4 + 3] * inv; *(float4*)(pg + (long)gid * 16 + 4 * k4) = o; }
#pragma unroll
    for (int k8 = 0; k8 < 2; ++k8) {
      u32x4 o;
#pragma unroll
      for (int e = 0; e < 4; ++e) o[e] = ex[8 * k8 + 2 * e] | (ex[8 * k8 + 2 * e + 1] << 16);
      *(u32x4*)(pe + (long)gid * 16 + 8 * k8) = o;
    }
  }
}
__device__ __forceinline__ void peer_fused_phase(const Params& P, char* smem, int bid, int nblk) {
  const int tidx = otid();
  const int tid = tidx, lane = tid & 63, wv = tid >> 6;
  const u16* psc = (const u16*)(P.ws + OFF_PSC);
  const u16* h3 = (const u16*)(P.ws + OFF_H);
  const unsigned char* ue = (const unsigned char*)(P.ws + OFF_UEMB); const unsigned char* ve = (const unsigned char*)(P.ws + OFF_VEMB);
  const float* uscl = (const float*)(P.ws + OFF_USCL); const float* vscl = (const float*)(P.ws + OFF_VSCL);
  unsigned* sL = (unsigned*)smem;
  u16* sE = (u16*)(smem + 32768);
  float* sG = (float*)(smem + 65536);
  for (int tb = bid * 128; tb < T_TOK; tb += nblk * 128) {
#pragma unroll 1
    for (int c = 0; c < 4; ++c) {
      __syncthreads();
      {
        const long gid = (long)(tb + c * 32) * 16 + tid;
        const u16* src = psc + gid * 128;
        unsigned tk[16];
#pragma unroll
        for (int i = 0; i < 16; ++i) tk[i] = 0u;
#pragma unroll 1
        for (int c8 = 0; c8 < 16; ++c8) {
          const u32x4 v = *(const u32x4*)(src + c8 * 8);
#pragma unroll
          for (int e = 0; e < 8; ++e) {
            const unsigned bits = (e & 1) ? (v[e >> 1] & 0xffff0000u) : (v[e >> 1] << 16);
            const unsigned m = bits ^ ((bits >> 31) ? 0xffffffffu : 0x80000000u);
            const unsigned key = (m & ~127u) | (unsigned)(127 - (c8 * 8 + e));
#pragma unroll
            for (int q = 15; q >= 1; --q) tk[q] = umed3(tk[q - 1], tk[q], key);
            tk[0] = tk[0] > key ? tk[0] : key;
          }
        }
#pragma unroll
        for (int i = 0; i < 4; ++i) { u32x4 o; o[0] = tk[4 * i]; o[1] = tk[4 * i + 1]; o[2] = tk[4 * i + 2]; o[3] = tk[4 * i + 3]; *(u32x4*)(sL + tid * 16 + 4 * i) = o; }
      }
      __syncthreads();
      if (tid < 256) {
        const unsigned* kk = sL + tid * 32;
        float s1[16], s2[16];
#pragma unroll
        for (int i = 0; i < 16; ++i) { s1[i] = keyf(kk[i] & ~127u); s2[i] = keyf(kk[16 + i] & ~127u); }
        unsigned tk[16];
#pragma unroll
        for (int i = 0; i < 16; ++i) tk[i] = 0u;
#pragma unroll
        for (int i = 0; i < 16; ++i)
#pragma unroll
          for (int j = 0; j < 16; ++j)
            if ((i + 1) * (j + 1) <= 16) {
              const unsigned key = (fkey(s1[i] + s2[j]) & ~255u) | (unsigned)(255 - (i * 16 + j));
#pragma unroll
              for (int q = 15; q >= 1; --q) tk[q] = umed3(tk[q - 1], tk[q], key);
              tk[0] = tk[0] > key ? tk[0] : key;
            }
        float best[16]; unsigned ex[16]; float mx = -3.0e38f;
#pragma unroll
        for (int k = 0; k < 16; ++k) {
          const int cid = 255 - (int)(tk[k] & 255u); const int i = cid >> 4, j = cid & 15;
          const unsigned ka = kk[i], kb2 = kk[16 + j];
          best[k] = keyf(ka & ~127u) + keyf(kb2 & ~127u);
          ex[k] = (unsigned)((127 - (int)(ka & 127u)) * 128 + (127 - (int)(kb2 & 127u)));
          mx = fmaxf(mx, best[k]);
        }
        float sm = 0.f;
#pragma unroll
        for (int k = 0; k < 16; ++k) { best[k] = __expf(best[k] - mx); sm += best[k]; }
        const float inv = 1.f / sm;
        const int eo = (c * 32 + (tid >> 3)) * 128 + (tid & 7) * 16;
#pragma unroll
        for (int k4 = 0; k4 < 4; ++k4) { float4 o; o.x = best[4 * k4] * inv; o.y = best[4 * k4 + 1] * inv; o.z = best[4 * k4 + 2] * inv; o.w = best[4 * k4 + 3] * inv; *(float4*)(sG + eo + 4 * k4) = o; }
#pragma unroll
        for (int k8 = 0; k8 < 2; ++k8) {
          u32x4 o;
#pragma unroll
          for (int e = 0; e < 4; ++e) o[e] = ex[8 * k8 + 2 * e] | (ex[8 * k8 + 2 * e + 1] << 16);
          *(u32x4*)(sE + eo + 8 * k8) = o;
        }
      }
    }
    __syncthreads();
#pragma unroll 1
    for (int it = 0; it < 16; ++it) {
      const int tl = it * 8 + wv, t = tb + tl;
      const u16* sidx = sE + tl * 128; const float* sgate = sG + tl * 128;
    const float rs2t = rsqrtf(((const float*)(P.ws + OFF_SSQ2))[t] * (1.f / DM) + EPSV);
    int xh0 = 0, xh1 = 0, xl0 = 0, xl1 = 0; float sxq;
    {
      const u32x4 v0 = *(const u32x4*)(h3 + (long)t * DM + lane * 16), v1 = *(const u32x4*)(h3 + (long)t * DM + lane * 16 + 8);
      float xa[16];
#pragma unroll
      for (int e = 0; e < 4; ++e) { xa[2 * e] = lo2f(v0[e]); xa[2 * e + 1] = hi2f(v0[e]); xa[8 + 2 * e] = lo2f(v1[e]); xa[8 + 2 * e + 1] = hi2f(v1[e]); }
      float am = 0.f;
#pragma unroll
      for (int e = 0; e < 16; ++e) am = fmaxf(am, fabsf(xa[e]));
#pragma unroll
      for (int o = 32; o >= 1; o >>= 1) am = fmaxf(am, sx(am, o));
      sxq = am > 0.f ? am * (1.f / 119.f) : 1.f;
      const float inv = 1.f / sxq;
#pragma unroll
      for (int e = 0; e < 16; ++e) {
        const int qv = (int)rintf(xa[e] * inv);
        const int lo = ((qv + 8) & 15) - 8, hi = (qv - lo) >> 4;
        const int sh4 = 4 * (e & 7);
        if (e < 8) { xl0 |= (lo & 15) << sh4; xh0 |= (hi & 15) << sh4; } else { xl1 |= (lo & 15) << sh4; xh1 |= (hi & 15) << sh4; }
      }
    }
    f32x2 acc2[8];
#pragma unroll
    for (int e = 0; e < 8; ++e) acc2[e] = (f32x2){0.f, 0.f};
    const int myk = ((lane >> 5) & 1) * 8 + ((lane >> 4) & 1) * 4 + ((lane >> 3) & 1) * 2 + ((lane >> 2) & 1);
    for (int bt = 0; bt < 8; ++bt) {
      u32x2 uu[16], vv[16];
#pragma unroll
      for (int k = 0; k < 16; ++k) {
        const unsigned eo = sidx[bt * 16 + k] * 512u + (unsigned)lane * 8u;
        uu[k] = *(const u32x2*)(ue + (size_t)eo);
        vv[k] = *(const u32x2*)(ve + (size_t)eo);
      }
      const unsigned emy = sidx[bt * 16 + myk];
      const float su = uscl[emy], sv = vscl[emy];
      int pd[16];
#pragma unroll
      for (int k = 0; k < 16; ++k) {
        int ah = __builtin_amdgcn_sdot8((int)uu[k][0], xh0, 0, false); ah = __builtin_amdgcn_sdot8((int)uu[k][1], xh1, ah, false);
        int al = __builtin_amdgcn_sdot8((int)uu[k][0], xl0, 0, false); al = __builtin_amdgcn_sdot8((int)uu[k][1], xl1, al, false);
        pd[k] = (ah << 4) + al;
      }
      int r8[8], r4[4], r2[2], r1;
      {
        const bool u5 = (lane & 32) != 0, u4 = (lane & 16) != 0, u3 = (lane & 8) != 0, u2 = (lane & 4) != 0;
#pragma unroll
        for (int k = 0; k < 8; ++k) { const int mine = u5 ? pd[k + 8] : pd[k]; const int oth = u5 ? pd[k] : pd[k + 8]; r8[k] = mine + sx(oth, 32); }
#pragma unroll
        for (int k = 0; k < 4; ++k) { const int mine = u4 ? r8[k + 4] : r8[k]; const int oth = u4 ? r8[k] : r8[k + 4]; r4[k] = mine + sx(oth, 16); }
#pragma unroll
        for (int k = 0; k < 2; ++k) { const int mine = u3 ? r4[k + 2] : r4[k]; const int oth = u3 ? r4[k] : r4[k + 2]; r2[k] = mine + sx(oth, 8); }
        { const int mine = u2 ? r2[1] : r2[0]; const int oth = u2 ? r2[0] : r2[1]; r1 = mine + sx(oth, 4); }
        r1 += sx(r1, 2); r1 += sx(r1, 1);
      }
      const float dot = (float)r1 * (su * sxq) * rs2t;
      const float act = 0.5f * dot * (1.f + erff(dot * 0.7071067811865475f));
      const float coef = sgate[bt * 16 + myk] * act * sv;
#pragma unroll
      for (int k = 0; k < 16; ++k) {
        const int srcl = ((k >> 3) & 1) * 32 + ((k >> 2) & 1) * 16 + ((k >> 1) & 1) * 8 + (k & 1) * 4;
        const float ck = sh(coef, srcl);
        const f32x2 ck2 = (f32x2){ck, ck};
#pragma unroll
        for (int d = 0; d < 2; ++d) {
#define PEER_V(BS) { const f32x2 q = __builtin_amdgcn_cvt_scalef32_pk_f32_fp4(vv[k][d], 1.0f, BS); acc2[4 * d + BS] = __builtin_elementwise_fma(ck2, q, acc2[4 * d + BS]); }
          PEER_V(0) PEER_V(1) PEER_V(2) PEER_V(3)
#undef PEER_V
        }
      }
    }
    float acc[16];
#pragma unroll
    for (int e = 0; e < 8; ++e) { acc[2 * e] = acc2[e][0]; acc[2 * e + 1] = acc2[e][1]; }
    float* orow = P.out + (long)t * DM + lane * 16;
    float xr[16]; float ss = 0.f;
#pragma unroll
    for (int q = 0; q < 4; ++q) {
      const float4 v = *(const float4*)(orow + q * 4);
      xr[q * 4 + 0] = v.x + acc[q * 4 + 0]; xr[q * 4 + 1] = v.y + acc[q * 4 + 1]; xr[q * 4 + 2] = v.z + acc[q * 4 + 2]; xr[q * 4 + 3] = v.w + acc[q * 4 + 3];
    }
#pragma unroll
    for (int e = 0; e < 16; ++e) ss += xr[e] * xr[e];
    ss = wave_sum(ss);
    const float rs = rsqrtf(ss * (1.f / DM) + EPSV);
#pragma unroll
    for (int q = 0; q < 4; ++q) {
      const float4 gf = *(const float4*)(P.g_final + lane * 16 + q * 4);
      float4 o; o.x = xr[q * 4 + 0] * rs * gf.x; o.y = xr[q * 4 + 1] * rs * gf.y; o.z = xr[q * 4 + 2] * rs * gf.z; o.w = xr[q * 4 + 3] * rs * gf.w;
      *(float4*)(orow + q * 4) = o;
    }
    }
  }
}

#define XB_TMO      128
#define XB_XCNT(j)  (256  + 64 * (j))
#define XB_XSUB(j)  (1280 + 64 * (j))
#define XB_XGEN(j)  (2304 + 64 * (j))
#define XB_TOP      3328
#define XB_TOPGEN   3392
#define XCD_BAR_WORDS 3456
#define XB_SPIN_CAP (1u << 18)

__device__ __forceinline__ unsigned xb_ld(unsigned* p)              { return __hip_atomic_load(p, __ATOMIC_RELAXED, __HIP_MEMORY_SCOPE_AGENT); }
__device__ __forceinline__ unsigned xb_add(unsigned* p, unsigned v) { return __hip_atomic_fetch_add(p, v, __ATOMIC_RELAXED, __HIP_MEMORY_SCOPE_AGENT); }
__device__ __forceinline__ unsigned xb_xcc_id() { return (unsigned)__builtin_amdgcn_s_getreg((3 << 11) | 20) & 0xFu; }
#define XB_SPIN(cond, bar) do { unsigned _sp = 0; while (cond) { __builtin_amdgcn_s_sleep(1); \
    if ((++_sp & 255u) == 0u) { if (xb_ld(&(bar)[XB_TMO])) break; if (_sp > XB_SPIN_CAP) { atomicAdd(&(bar)[XB_TMO], 1u); break; } } } } while (0)

struct XcdBarrier {
    unsigned* bar; unsigned x;
    volatile LAS unsigned* st;
};

__device__ __forceinline__ XcdBarrier xcd_barrier_post(unsigned* bar, volatile LAS unsigned* st) {
    XcdBarrier b; b.bar = bar; b.x = xb_xcc_id(); b.st = st;
    if (threadIdx.x == 0) (void)xb_add(&bar[XB_XCNT(b.x)], 1u);
    return b;
}
__device__ __forceinline__ void xcd_barrier_complete(unsigned* bar, unsigned x, unsigned& nloc, unsigned& nx) {
    const unsigned G = gridDim.x * gridDim.y * gridDim.z;
    unsigned sum, cnt, mine, sp = 0u;
    for (;;) {
        sum = 0u; cnt = 0u; mine = 0u;
#pragma unroll
        for (unsigned j = 0; j < 16; ++j) { const unsigned c = xb_ld(&bar[XB_XCNT(j)]); sum += c; cnt += (c > 0u) ? 1u : 0u; mine = (j == x) ? c : mine; }
        if (sum == G) break;
        __builtin_amdgcn_s_sleep(1);
        if ((++sp & 255u) == 0u) { if (xb_ld(&bar[XB_TMO])) break; if (sp > XB_SPIN_CAP) { atomicAdd(&bar[XB_TMO], 1u); break; } }
    }
    nloc = mine > 0u ? mine : 1u; nx = cnt > 0u ? cnt : 1u;
}

__device__ __forceinline__ void xcd_barrier(const XcdBarrier& b) {
    asm volatile("s_waitcnt vmcnt(0)" ::: "memory");
    __syncthreads();
    if (threadIdx.x == 0) {
        unsigned* bar = b.bar;
        __builtin_amdgcn_s_waitcnt(0);
        unsigned nloc = b.st[0], nx = b.st[1];
        if (nloc == 0u) { xcd_barrier_complete(bar, b.x, nloc, nx); b.st[0] = nloc; b.st[1] = nx; }
        const unsigned old = xb_add(&bar[XB_XSUB(b.x)], 1u);
        const unsigned gen = old / nloc;
        if (old + 1u == (gen + 1u) * nloc) {
            __builtin_amdgcn_fence(__ATOMIC_RELEASE, "agent");
            asm volatile("s_waitcnt vmcnt(0)" ::: "memory");
            const unsigned og = xb_add(&bar[XB_TOP], 1u);
            const unsigned tg = og / nx;
            if (og + 1u == (tg + 1u) * nx) xb_add(&bar[XB_TOPGEN], 1u);
            else XB_SPIN(xb_ld(&bar[XB_TOPGEN]) == tg, bar);
            __builtin_amdgcn_fence(__ATOMIC_ACQUIRE, "agent");
            xb_add(&bar[XB_XGEN(b.x)], 1u);
            asm volatile("s_waitcnt vmcnt(0)" ::: "memory");
        } else {
            XB_SPIN(xb_ld(&bar[XB_XGEN(b.x)]) == gen, bar);
            __builtin_amdgcn_fence(__ATOMIC_ACQUIRE, "agent");
            asm volatile("s_waitcnt vmcnt(0)" ::: "memory");
        }
    }
    __syncthreads();
}

__device__ __forceinline__ GemmP mk_gemm(const u16* A, long lda, long a_bs, const u16* Bt, long ldb, long b_bs, u16* C, long ldc, long c_bs, int M, int N, int K, int nbatch, float scale, int ncols, int tstore) {
  GemmP g; g.A = A; g.lda = lda; g.a_bs = a_bs; g.Bt = Bt; g.ldb = ldb; g.b_bs = b_bs; g.C = C; g.ldc = ldc; g.c_bs = c_bs; g.M = M; g.N = N; g.K = K; g.nbatch = nbatch; g.scale = scale; g.ncols = ncols; g.tstore = tstore;
  return g;
}
#define QCTR_WORD (XCD_BAR_WORDS + 64)

__global__ void __launch_bounds__(NTHR, 2) mega(Params P, CvtJobs J1, CvtJobs J2) {
  extern __shared__ __attribute__((aligned(16))) char smem[];
  const int bid = blockIdx.x, nblk = gridDim.x, rbid = nblk - 1 - bid;
  char* ws = P.ws;
  unsigned* barw = (unsigned*)(ws + OFF_BAR);
  if (threadIdx.x == 0) *(uint4*)(smem + LDS_XB) = make_uint4(0u, 0u, 0u, 0u);
  __syncthreads();
  (void)xcd_barrier_post(barw, (volatile LAS unsigned*)(smem + LDS_XB));
#define GRID_SYNC() do { XcdBarrier bar_; bar_.bar = (unsigned*)(P.ws + OFF_BAR); bar_.x = xb_xcc_id(); bar_.st = (volatile LAS unsigned*)(smem + LDS_XB); xcd_barrier(bar_); } while (0)

  cvt_run(J1, smem, bid, nblk);
  rmsnorm_rows(P.x, P.g_mix, (u16*)(ws + OFF_H), T_TOK, bid, nblk);
  rmsnorm_rows(P.mem, P.g_mem, (u16*)(ws + OFF_MEMN), 1024, rbid, nblk);
  GRID_SYNC();

  {
    const GemmP g = mk_gemm((u16*)(ws + OFF_WUK), 512, 64, (u16*)(ws + OFF_WUQ), 512, 64, (u16*)(ws + OFF_WG2T) + 512l * 256, 256, 256l * 256, 256, 256, 64, 8, 0.125f, 128, 0);
    gemm_bf16_phase(g, smem, rbid, nblk);
  }
  {
    const GemmP g = mk_gemm((u16*)(ws + OFF_WPQ), 2048, 128, (u16*)(ws + OFF_SUBK), 128, 128l * 128, (u16*)(ws + OFF_WEFFT), 1024, 128l * 1024, 1024, 128, 128, 16, 1.f, 128, 1);
    gemm_bf16_phase(g, smem, rbid - 16 < 0 ? rbid - 16 + nblk : rbid - 16, nblk);
  }
  {
    const GemmP g = mk_gemm((u16*)(ws + OFF_MEMN), 1024, 0, (u16*)(ws + OFF_WKT), 1024, 0, (u16*)(ws + OFF_KX), 512, 0, 1024, 512, 1024, 1, 1.f, 128, 0);
    gemm_bf16_phase(g, smem, rbid - 80 < 0 ? rbid - 80 + nblk : rbid - 80, nblk);
  }
  {
    const GemmP g = mk_gemm((u16*)(ws + OFF_WVT), 1024, 0, (u16*)(ws + OFF_MEMN), 1024, 256l * 1024, (u16*)(ws + OFF_VTX), 256, 512l * 256, 512, 256, 1024, 4, 1.f, 128, 2);
    gemm_bf16_phase(g, smem, rbid - 96 < 0 ? rbid - 96 + nblk : rbid - 96, nblk);
  }
  { EpiG1 e; e.ws = ws; pg_phase((const u16*)(ws + OFF_H), (const u16*)(ws + OFF_WINT), T_TOK, 2816, 1024, e, smem, bid, nblk); }
  GRID_SYNC();

  dsa_prep_phase(P, bid, nblk);
  dn_prep_phase(P, bid, nblk);
  GRID_SYNC();

  dn_intra_phase(P, smem, bid, nblk);
  { EpiG2 e; e.qi = (u16*)(ws + OFF_QI); e.qlat = (u16*)P.out; pg_phase((const u16*)(ws + OFF_CQN), (const u16*)(ws + OFF_WG2T), T_TOK, 2560, 256, e, smem, bid, nblk); }
  GRID_SYNC();

  if (bid < 16) dn_scan_phase(P, smem, bid, 16);
  dsa_queue_phase(P, smem, bid, (unsigned*)(P.ws + OFF_BAR) + QCTR_WORD);
  GRID_SYNC();

  dn_gate_phase(P, bid, nblk);
  {
    const GemmP g = mk_gemm((u16*)P.out, 2048, 256, (u16*)(ws + OFF_WUVT), 256, 128l * 256, (u16*)(ws + OFF_MIX), 1024, 64, T_TOK, 128, 256, 8, 1.f, 64, 0);
    gemm_bf16_phase(g, smem, bid, nblk);
  }
  cvt_i4_rows(P.u_emb, P.g_ffn, (unsigned char*)(ws + OFF_UEMB), (float*)(ws + OFF_USCL), 16384, bid, nblk);
  cvt_fp4_rows(P.v_emb, nullptr, (unsigned char*)(ws + OFF_VEMB), (float*)(ws + OFF_VSCL), 16384, bid, nblk);
  GRID_SYNC();

  { EpiResid e; e.R = P.x; e.C = P.out; e.hb = (u16*)(ws + OFF_H); e.ssq = (float*)(ws + OFF_SSQ1); pg_phase((const u16*)(ws + OFF_MIX), (const u16*)(ws + OFF_WOUTT), T_TOK, 1024, 1024, e, smem, bid, nblk); }
  GRID_SYNC();
  { EpiB16 e; e.O = (u16*)(ws + OFF_QX); e.ldc = 512; e.ssq = (const float*)(ws + OFF_SSQ1); pg_phase((const u16*)(ws + OFF_H), (const u16*)(ws + OFF_WQT), T_TOK, 512, 1024, e, smem, bid, nblk); }
  GRID_SYNC();
  xattn_phase(P, smem, bid, nblk);
  GRID_SYNC();
  { EpiResid e; e.R = P.out; e.C = P.out; e.hb = (u16*)(ws + OFF_H); e.ssq = (float*)(ws + OFF_SSQ2); pg_phase((const u16*)(ws + OFF_OX), (const u16*)(ws + OFF_WOT), T_TOK, 1024, 512, e, smem, bid, nblk); }
  GRID_SYNC();
  { EpiB16 e; e.O = (u16*)(ws + OFF_PSC); e.ldc = 2048; e.ssq = (const float*)(ws + OFF_SSQ2); pg_phase((const u16*)(ws + OFF_H), (const u16*)(ws + OFF_WEFFT), T_TOK, 2048, 1024, e, smem, bid, nblk); }
  GRID_SYNC();
  peer_fused_phase(P, smem, bid, nblk);
}

static void add_job(CvtJobs& J, const float* src, u16* dst, int R, int C, long sld, long dld, float scale, int tr, const float* rowscale = nullptr) {
  CvtJob& j = J.j[J.n++]; j.src = src; j.dst = dst; j.rowscale = rowscale; j.R = R; j.C = C; j.sld = sld; j.dld = dld; j.scale = scale; j.transpose = tr;
}

extern "C" void kernel_launch(void* const* d_in, const int* in_sizes, int n_in, void* d_out, int out_size, void* d_ws, size_t ws_size, hipStream_t stream) {
  if (ws_size < WS_NEED) { fprintf(stderr, "workspace too small: %zu < %llu\n", ws_size, (unsigned long long)WS_NEED); return; }
  Params P; memset(&P, 0, sizeof(P));
  const float** pp = (const float**)&P;
  for (int i = 0; i < 29; ++i) pp[i] = (const float*)d_in[i];
  P.out = (float*)d_out; P.ws = (char*)d_ws;
  char* ws = (char*)d_ws;
  static int grid = 0;
  if (!grid) {
    int dev = 0, cus = 0, per_cu = 0;
    (void)hipGetDevice(&dev);
    (void)hipDeviceGetAttribute(&cus, hipDeviceAttributeMultiprocessorCount, dev);
    (void)hipFuncSetAttribute((const void*)mega, hipFuncAttributeMaxDynamicSharedMemorySize, LDS_TOTAL);
    (void)hipOccupancyMaxActiveBlocksPerMultiprocessor(&per_cu, (const void*)mega, NTHR, LDS_TOTAL);
    grid = cus * (per_cu < 1 ? per_cu : 1);
    if (grid <= 0) { fprintf(stderr, "mega kernel not launchable (cus %d, per_cu %d)\n", cus, per_cu); grid = 0; return; }
  }
  (void)hipMemsetAsync(ws + OFF_BAR, 0, 16384, stream);
  (void)hipMemsetAsync(ws + OFF_WINT, 0, 2816ull * 1024 * 2, stream);
  (void)hipMemsetAsync(ws + OFF_WUVT, 0, 8ull * 128 * 256 * 2, stream);
  (void)hipMemsetAsync(ws + OFF_SSQ1, 0, 2 * 256 * 1024, stream);
  CvtJobs J1; memset(&J1, 0, sizeof(J1));
  CvtJobs J2; memset(&J2, 0, sizeof(J2));
  {
    u16* winT = (u16*)(ws + OFF_WINT);
    add_job(J1, P.w_in, winT, 1024, 584, 2640, 1024, 1.f, 1);
    add_job(J1, P.w_in + 2632, winT + 584l * 1024, 1024, 8, 2640, 1024, 1.f, 1);
    add_job(J1, P.w_in + 584, winT + 768l * 1024, 1024, 1536, 2640, 1024, 1.f, 1);
    add_job(J1, P.w_in + 2120, winT + 2304l * 1024, 1024, 512, 2640, 1024, 1.f, 1);
    add_job(J1, P.w_iq, (u16*)(ws + OFF_WG2T), 256, 512, 512, 256, 1.f, 1);
    add_job(J1, P.w_uq, (u16*)(ws + OFF_WUQ), 256, 512, 512, 512, 1.f, 0);
    add_job(J1, P.w_uk, (u16*)(ws + OFF_WUK), 256, 512, 512, 512, 1.f, 0);
    for (int h = 0; h < 8; ++h) add_job(J1, P.w_uv + h * 64, (u16*)(ws + OFF_WUVT) + h * 128l * 256, 256, 64, 512, 256, 1.f, 1);
    add_job(J1, P.w_out, (u16*)(ws + OFF_WOUTT), 1024, 1024, 1024, 1024, 1.f, 1);
    add_job(J1, P.wq_x, (u16*)(ws + OFF_WQT), 1024, 512, 512, 1024, 0.08838834764831845f, 1, P.g_cross);
    add_job(J1, P.wk_x, (u16*)(ws + OFF_WKT), 1024, 512, 512, 1024, 1.f, 1);
    add_job(J1, P.wv_x, (u16*)(ws + OFF_WVT), 1024, 512, 512, 1024, 1.f, 1);
    add_job(J1, P.wo_x, (u16*)(ws + OFF_WOT), 512, 1024, 1024, 512, 1.f, 1);
    add_job(J1, P.w_pq, (u16*)(ws + OFF_WPQ), 1024, 2048, 2048, 2048, 1.f, 0, P.g_ffn);
    add_job(J1, P.sub_keys, (u16*)(ws + OFF_SUBK), 2048, 128, 128, 128, 1.f, 0);
    add_job(J2, P.u_emb, (u16*)(ws + OFF_UEMB), 16384, 1024, 1024, 1024, 1.f, 0);
    add_job(J2, P.v_emb, (u16*)(ws + OFF_VEMB), 16384, 1024, 1024, 1024, 1.f, 0);
  }
  hipLaunchKernelGGL(mega, dim3(grid), dim3(NTHR), LDS_TOTAL, stream, P, J1, J2);
}
```

```cpp
#include <hip/hip_runtime.h>
#include <stdint.h>
#include <stdio.h>
#include <string.h>

typedef unsigned short u16;
typedef __attribute__((ext_vector_type(8))) short bf16x8;
typedef __attribute__((ext_vector_type(4))) short s16x4;
typedef __attribute__((ext_vector_type(4))) float f32x4;
typedef __attribute__((ext_vector_type(4))) unsigned u32x4;
typedef __attribute__((ext_vector_type(2))) unsigned u32x2;
typedef __attribute__((ext_vector_type(2))) float f32x2;
#define LAS __attribute__((address_space(3)))

#define T_TOK 32768
#define SEQ 8192
#define NB 4
#define DM 1024
#define NTHR 512
#define EPSV 1e-6f

__device__ __forceinline__ u16 f2bf(float f) { __bf16 b = (__bf16)f; return __builtin_bit_cast(u16, b); }
__device__ __forceinline__ float bf2f(u16 h) { return __uint_as_float(((unsigned)h) << 16); }
__device__ __forceinline__ unsigned pack2(float a, float b) { return (unsigned)f2bf(a) | ((unsigned)f2bf(b) << 16); }
__device__ __forceinline__ float lo2f(unsigned v) { return __uint_as_float(v << 16); }
__device__ __forceinline__ float hi2f(unsigned v) { return __uint_as_float(v & 0xffff0000u); }
__device__ __forceinline__ int otid() { int t = threadIdx.x; asm volatile("" : "+v"(t)); return t; }
__device__ __forceinline__ int lane_id() { return (int)__builtin_amdgcn_mbcnt_hi(~0u, __builtin_amdgcn_mbcnt_lo(~0u, 0u)); }
template <class T> __device__ __forceinline__ T sx(T v, int m) { return __builtin_bit_cast(T, __builtin_amdgcn_ds_bpermute((lane_id() ^ m) << 2, __builtin_bit_cast(int, v))); }
template <class T> __device__ __forceinline__ T sh(T v, int src) { return __builtin_bit_cast(T, __builtin_amdgcn_ds_bpermute(src << 2, __builtin_bit_cast(int, v))); }
template <class T> __device__ __forceinline__ T su(T v, int d) { const int l = lane_id(); const int src = l - d < 0 ? l : l - d; return __builtin_bit_cast(T, __builtin_amdgcn_ds_bpermute(src << 2, __builtin_bit_cast(int, v))); }
__device__ __forceinline__ float wave_sum(float v) {
#pragma unroll
  for (int o = 32; o >= 1; o >>= 1) v += sx(v, o);
  return v;
}
template <int CTRL> __device__ __forceinline__ float dpp_f(float v) { return __int_as_float(__builtin_amdgcn_update_dpp(0, __float_as_int(v), CTRL, 0xf, 0xf, true)); }
__device__ __forceinline__ float wave_max_u(float v) {
  v = fmaxf(v, dpp_f<0xB1>(v)); v = fmaxf(v, dpp_f<0x4E>(v)); v = fmaxf(v, dpp_f<0x141>(v)); v = fmaxf(v, dpp_f<0x140>(v));
  const int vi = __float_as_int(v);
  const float a = __int_as_float(__builtin_amdgcn_readlane(vi, 0)), b = __int_as_float(__builtin_amdgcn_readlane(vi, 16));
  const float c = __int_as_float(__builtin_amdgcn_readlane(vi, 32)), d = __int_as_float(__builtin_amdgcn_readlane(vi, 48));
  return fmaxf(fmaxf(a, b), fmaxf(c, d));
}
__device__ __forceinline__ float wave_min_u(float v) { return -wave_max_u(-v); }
__device__ __forceinline__ float relu_raw(float x) { return __builtin_amdgcn_fmed3f(x, 0.f, 3.0e38f); }
__device__ __forceinline__ f32x4 mfma16(bf16x8 a, bf16x8 b, f32x4 c) { return __builtin_amdgcn_mfma_f32_16x16x32_bf16(a, b, c, 0, 0, 0); }
__device__ __forceinline__ unsigned umed3(unsigned a, unsigned b, unsigned c) { unsigned r; asm("v_med3_u32 %0, %1, %2, %3" : "=v"(r) : "v"(a), "v"(b), "v"(c)); return r; }
__device__ __forceinline__ unsigned fkey(float f) { unsigned u = __float_as_uint(f); return u ^ ((u >> 31) ? 0xffffffffu : 0x80000000u); }
__device__ __forceinline__ float keyf(unsigned m) { unsigned u = (m & 0x80000000u) ? (m ^ 0x80000000u) : ~m; return __uint_as_float(u); }

#define MB (1024ull * 1024ull)
#define OFF_BAR      0ull
#define OFF_WINT     (1 * MB)
#define OFF_WG2T     (7 * MB)
#define OFF_WUQ      (9 * MB)
#define OFF_WUK      (9 * MB + 512 * 1024)
#define OFF_WUVT     (10 * MB)
#define OFF_WOUTT    (11 * MB)
#define OFF_WQT      (13 * MB)
#define OFF_WKT      (14 * MB)
#define OFF_WVT      (15 * MB)
#define OFF_WOT      (16 * MB)
#define OFF_WPQ      (17 * MB)
#define OFF_SUBK     (21 * MB)
#define OFF_WEFFT    (22 * MB)
#define OFF_MEMN     (26 * MB)
#define OFF_KX       (28 * MB)
#define OFF_VTX      (29 * MB)
#define OFF_KIDXN    (30 * MB)
#define OFF_WIDX     (34 * MB)
#define OFF_GB       (35 * MB)
#define OFF_SSQ1     (36 * MB + 256 * 1024)
#define OFF_SSQ2     (36 * MB + 512 * 1024)
#define OFF_INTRA    (37 * MB)
#define OFF_WDN      (53 * MB)
#define OFF_SEL      (85 * MB)
#define OFF_H        (101 * MB)
#define OFF_QI       (OFF_H)
#define OFF_CQN      (OFF_H + 32 * MB)
#define OFF_CKVN     (OFF_H + 48 * MB)
#define OFF_PA       (165 * MB)
#define OFF_PB       (213 * MB)
#define OFF_SCORES   (OFF_PA)
#define OFF_UEMB     (OFF_SEL)
#define OFF_VEMB     (OFF_SEL + 8 * MB)
#define OFF_USCL     (36 * MB + 64 * 1024)
#define OFF_VSCL     (36 * MB + 128 * 1024)
#define OFF_PSC      (OFF_PB)
#define OFF_BZ       (309 * MB)
#define OFF_QKV      (341 * MB)
#define OFF_QX       (OFF_QKV)
#define OFF_OX       (OFF_QKV + 32 * MB)
#define OFF_PEIDX    (OFF_QKV)
#define OFF_PGATE    (OFF_QKV + 8 * MB)
#define OFF_PLIST    (OFF_QKV + 64 * MB)
#define OFF_MIX      (437 * MB)
#define WS_NEED      (501 * MB)

struct CvtJob { const float* src; u16* dst; const float* rowscale; int R, C; long sld, dld; float scale; int transpose; };
#define MAXJOBS 24
struct CvtJobs { CvtJob j[MAXJOBS]; int n; int pad; };

__device__ __forceinline__ void cvt_run(const CvtJobs& J, char* smem, int bid, int nblk) {
  const int tidx = otid();
  float* tile = (float*)smem;
  for (int ji = 0; ji < J.n; ++ji) {
    const CvtJob jb = J.j[ji];
    if (jb.transpose) continue;
    const long nvec = (long)jb.R * (jb.C >> 2);
    const int cv = jb.C >> 2;
    for (long i = (long)bid * NTHR + tidx; i < nvec; i += (long)nblk * NTHR) {
      const long r = i / cv; const int c = (int)(i - r * cv) * 4;
      const float4 v = *(const float4*)(jb.src + r * jb.sld + c);
      const float sc = jb.rowscale ? jb.scale * jb.rowscale[r] : jb.scale;
      u32x2 o; o[0] = pack2(v.x * sc, v.y * sc); o[1] = pack2(v.z * sc, v.w * sc);
      *(u32x2*)(jb.dst + r * jb.dld + c) = o;
    }
  }
  int total = 0;
  for (int ji = 0; ji < J.n; ++ji) if (J.j[ji].transpose) total += (J.j[ji].R >> 6) * ((J.j[ji].C + 63) >> 6);
  float* tile2 = tile + 64 * 65;
  for (int tg0 = bid; tg0 < total; tg0 += 2 * nblk) {
    float4 v[2][2]; int jis[2], r0s[2], c0s[2]; bool val[2];
#pragma unroll
    for (int u = 0; u < 2; ++u) {
      const int tg = tg0 + u * nblk;
      val[u] = tg < total;
      int ji = 0, t = val[u] ? tg : 0;
      for (;; ++ji) {
        if (!J.j[ji].transpose) continue;
        const int nt = (J.j[ji].R >> 6) * ((J.j[ji].C + 63) >> 6);
        if (t < nt) break;
        t -= nt;
      }
      const int tc = (J.j[ji].C + 63) >> 6;
      jis[u] = ji; r0s[u] = (t / tc) * 64; c0s[u] = (t % tc) * 64;
#pragma unroll
      for (int k = 0; k < 2; ++k) {
        const int idx = tidx + k * NTHR, r = idx >> 4, c4 = (idx & 15) * 4;
        float4 x = make_float4(0.f, 0.f, 0.f, 0.f);
        if (val[u] && c0s[u] + c4 < J.j[ji].C) x = *(const float4*)(J.j[ji].src + (long)(r0s[u] + r) * J.j[ji].sld + c0s[u] + c4);
        v[u][k] = x;
      }
    }
    __syncthreads();
#pragma unroll
    for (int u = 0; u < 2; ++u) {
      float* tl = u ? tile2 : tile;
#pragma unroll
      for (int k = 0; k < 2; ++k) {
        const int idx = tidx + k * NTHR, r = idx >> 4, c4 = (idx & 15) * 4;
        tl[r * 65 + c4] = v[u][k].x; tl[r * 65 + c4 + 1] = v[u][k].y; tl[r * 65 + c4 + 2] = v[u][k].z; tl[r * 65 + c4 + 3] = v[u][k].w;
      }
    }
    __syncthreads();
#pragma unroll
    for (int u = 0; u < 2; ++u) {
      const CvtJob& jb = J.j[jis[u]];
      const float* tl = u ? tile2 : tile;
      const int c = tidx >> 3, r8 = (tidx & 7) * 8;
      if (val[u] && c0s[u] + c < jb.C) {
        float f[8];
#pragma unroll
        for (int e = 0; e < 8; ++e) f[e] = tl[(r8 + e) * 65 + c] * (jb.rowscale ? jb.scale * jb.rowscale[r0s[u] + r8 + e] : jb.scale);
        u32x4 o; o[0] = pack2(f[0], f[1]); o[1] = pack2(f[2], f[3]); o[2] = pack2(f[4], f[5]); o[3] = pack2(f[6], f[7]);
        *(u32x4*)(jb.dst + (long)(c0s[u] + c) * jb.dld + r0s[u] + r8) = o;
      }
    }
  }
}

__device__ __forceinline__ void cvt_fp8_rows(const float* src, unsigned char* dst, float* scl, int nrows, int bid, int nblk) {
  const int tidx = otid();
  const int lane = tidx & 63, wv = tidx >> 6;
  for (int r = bid * 8 + wv; r < nrows; r += nblk * 8) {
    const float* p = src + (long)r * DM + lane * 16;
    float4 v[4]; float am = 0.f;
#pragma unroll
    for (int i = 0; i < 4; ++i) { v[i] = *(const float4*)(p + i * 4); am = fmaxf(am, fmaxf(fmaxf(fabsf(v[i].x), fabsf(v[i].y)), fmaxf(fabsf(v[i].z), fabsf(v[i].w)))); }
#pragma unroll
    for (int o = 32; o >= 1; o >>= 1) am = fmaxf(am, sx(am, o));
    const float sc = am > 0.f ? am * (1.f / 440.f) : 1.f;
    const float inv = 1.f / sc;
    u32x4 o;
#pragma unroll
    for (int i = 0; i < 4; ++i) {
      int w = 0;
      w = __builtin_amdgcn_cvt_pk_fp8_f32(v[i].x * inv, v[i].y * inv, w, false);
      w = __builtin_amdgcn_cvt_pk_fp8_f32(v[i].z * inv, v[i].w * inv, w, true);
      o[i] = (unsigned)w;
    }
    *(u32x4*)(dst + (long)r * DM + lane * 16) = o;
    if (lane == 0) scl[r] = sc;
  }
}

__device__ __forceinline__ void cvt_fp4_rows(const float* src, const float* colscale, unsigned char* dst, float* scl, int nrows, int bid, int nblk) {
  const int tidx = otid();
  const int lane = tidx & 63, wv = tidx >> 6;
  float4 cs[4];
#pragma unroll
  for (int i = 0; i < 4; ++i) cs[i] = colscale ? *(const float4*)(colscale + lane * 16 + i * 4) : make_float4(1.f, 1.f, 1.f, 1.f);
  for (int r = bid * 8 + wv; r < nrows; r += nblk * 8) {
    const float* p = src + (long)r * DM + lane * 16;
    float4 v[4]; float am = 0.f;
#pragma unroll
    for (int i = 0; i < 4; ++i) { v[i] = *(const float4*)(p + i * 4); v[i].x *= cs[i].x; v[i].y *= cs[i].y; v[i].z *= cs[i].z; v[i].w *= cs[i].w; am = fmaxf(am, fmaxf(fmaxf(fabsf(v[i].x), fabsf(v[i].y)), fmaxf(fabsf(v[i].z), fabsf(v[i].w)))); }
#pragma unroll
    for (int o = 32; o >= 1; o >>= 1) am = fmaxf(am, sx(am, o));
    const float sc = am > 0.f ? am * (1.f / 6.f) : 1.f;
    const float inv = 1.f / sc;
    u32x2 o;
#pragma unroll
    for (int d = 0; d < 2; ++d) {
      unsigned w = 0u;
      w = __builtin_amdgcn_cvt_scalef32_pk_fp4_f32(w, v[2 * d].x * inv, v[2 * d].y * inv, 1.0f, 0);
      w = __builtin_amdgcn_cvt_scalef32_pk_fp4_f32(w, v[2 * d].z * inv, v[2 * d].w * inv, 1.0f, 1);
      w = __builtin_amdgcn_cvt_scalef32_pk_fp4_f32(w, v[2 * d + 1].x * inv, v[2 * d + 1].y * inv, 1.0f, 2);
      w = __builtin_amdgcn_cvt_scalef32_pk_fp4_f32(w, v[2 * d + 1].z * inv, v[2 * d + 1].w * inv, 1.0f, 3);
      o[d] = w;
    }
    *(u32x2*)(dst + (long)r * 512 + lane * 8) = o;
    if (lane == 0) scl[r] = sc;
  }
}

__device__ __forceinline__ void cvt_i4_rows(const float* src, const float* colscale, unsigned char* dst, float* scl, int nrows, int bid, int nblk) {
  const int tidx = otid();
  const int lane = tidx & 63, wv = tidx >> 6;
  float4 cs[4];
#pragma unroll
  for (int i = 0; i < 4; ++i) cs[i] = colscale ? *(const float4*)(colscale + lane * 16 + i * 4) : make_float4(1.f, 1.f, 1.f, 1.f);
  for (int r = bid * 8 + wv; r < nrows; r += nblk * 8) {
    const float* p = src + (long)r * DM + lane * 16;
    float x[16]; float am = 0.f, ss = 0.f;
#pragma unroll
    for (int i = 0; i < 4; ++i) {
      const float4 v = *(const float4*)(p + i * 4);
      x[4 * i] = v.x * cs[i].x; x[4 * i + 1] = v.y * cs[i].y; x[4 * i + 2] = v.z * cs[i].z; x[4 * i + 3] = v.w * cs[i].w;
    }
#pragma unroll
    for (int e = 0; e < 16; ++e) { am = fmaxf(am, fabsf(x[e])); ss += x[e] * x[e]; }
#pragma unroll
    for (int o = 32; o >= 1; o >>= 1) { am = fmaxf(am, sx(am, o)); ss += sx(ss, o); }
    const float lim = fminf(am, 2.6f * sqrtf(ss * (1.f / DM)));
    const float sc = lim > 0.f ? lim * (1.f / 7.f) : 1.f;
    const float inv = 1.f / sc;
    u32x2 o;
#pragma unroll
    for (int d = 0; d < 2; ++d) {
      unsigned w = 0u;
#pragma unroll
      for (int i = 0; i < 8; ++i) {
        float qf = rintf(x[8 * d + i] * inv); qf = fminf(fmaxf(qf, -7.f), 7.f);
        w |= ((unsigned)(int)qf & 15u) << (4 * i);
      }
      o[d] = w;
    }
    *(u32x2*)(dst + (long)r * 512 + lane * 8) = o;
    if (lane == 0) scl[r] = sc;
  }
}

__device__ __forceinline__ void rmsnorm_rows(const float* src, const float* g, u16* dst, int nrows, int bid, int nblk) {
  const int tidx = otid();
  const int lane = tidx & 63, wv = tidx >> 6;
  float4 gg[4];
#pragma unroll
  for (int i = 0; i < 4; ++i) gg[i] = *(const float4*)(g + i * 256 + lane * 4);
  for (int r = (bid * 8 + wv) * 2; r < nrows; r += nblk * 16) {
    float4 v[2][4]; float ss[2] = {0.f, 0.f};
#pragma unroll
    for (int k = 0; k < 2; ++k)
#pragma unroll
      for (int i = 0; i < 4; ++i) v[k][i] = *(const float4*)(src + (long)(r + k) * DM + i * 256 + lane * 4);
#pragma unroll
    for (int k = 0; k < 2; ++k) {
#pragma unroll
      for (int i = 0; i < 4; ++i) ss[k] += v[k][i].x * v[k][i].x + v[k][i].y * v[k][i].y + v[k][i].z * v[k][i].z + v[k][i].w * v[k][i].w;
      ss[k] = wave_sum(ss[k]);
      const float rs = rsqrtf(ss[k] * (1.f / DM) + EPSV);
#pragma unroll
      for (int i = 0; i < 4; ++i) {
        u32x2 o; o[0] = pack2(v[k][i].x * rs * gg[i].x, v[k][i].y * rs * gg[i].y); o[1] = pack2(v[k][i].z * rs * gg[i].z, v[k][i].w * rs * gg[i].w);
        *(u32x2*)(dst + (long)(r + k) * DM + i * 256 + lane * 4) = o;
      }
    }
  }
}

template <int LDC>
__device__ __forceinline__ void gemm_tile(const u16* __restrict__ A, long lda, const u16* __restrict__ Bt, long ldb, int K, char* smem) {
  const int tidx = otid();
  const int tid = tidx, lane = tid & 63, wv = tid >> 6, lr = lane & 15, g = lane >> 4;
  const int wm = wv >> 1, wn = wv & 1;
  f32x4 acc[4][4];
#pragma unroll
  for (int i = 0; i < 4; ++i)
#pragma unroll
    for (int j = 0; j < 4; ++j) acc[i][j] = (f32x4){0.f, 0.f, 0.f, 0.f};
  u32x4 ra[4], rb[2];
  const int nk = K >> 6;
  const int srow = tid >> 3, sch = tid & 7;
  const u16* pa = A + (long)srow * lda + sch * 8;
  const u16* pb = Bt + (long)srow * ldb + sch * 8;
  const unsigned lds_off = (unsigned)(srow * 128 + ((sch ^ (srow & 7)) << 4));
#pragma unroll
  for (int i = 0; i < 4; ++i) ra[i] = *(const u32x4*)(pa + (long)(i * 64) * lda);
#pragma unroll
  for (int i = 0; i < 2; ++i) rb[i] = *(const u32x4*)(pb + (long)(i * 64) * ldb);
  __syncthreads();
#pragma unroll
  for (int i = 0; i < 4; ++i) *(u32x4*)(smem + lds_off + i * 8192) = ra[i];
#pragma unroll
  for (int i = 0; i < 2; ++i) *(u32x4*)(smem + 32768 + lds_off + i * 8192) = rb[i];
  __syncthreads();
  for (int kt = 0; kt < nk; ++kt) {
    const char* sA = smem + (kt & 1) * 49152;
    const char* sB = sA + 32768;
    if (kt + 1 < nk) {
#pragma unroll
      for (int i = 0; i < 4; ++i) ra[i] = *(const u32x4*)(pa + (long)(i * 64) * lda + (kt + 1) * 64);
#pragma unroll
      for (int i = 0; i < 2; ++i) rb[i] = *(const u32x4*)(pb + (long)(i * 64) * ldb + (kt + 1) * 64);
    }
#pragma unroll
    for (int ks = 0; ks < 2; ++ks) {
      bf16x8 a[4], b[4];
#pragma unroll
      for (int mi = 0; mi < 4; ++mi) { const int row = wm * 64 + mi * 16 + lr; a[mi] = *(const bf16x8*)(sA + row * 128 + (((ks * 4 + g) ^ (row & 7)) << 4)); }
#pragma unroll
      for (int ni = 0; ni < 4; ++ni) { const int row = wn * 64 + ni * 16 + lr; b[ni] = *(const bf16x8*)(sB + row * 128 + (((ks * 4 + g) ^ (row & 7)) << 4)); }
#pragma unroll
      for (int mi = 0; mi < 4; ++mi)
#pragma unroll
        for (int ni = 0; ni < 4; ++ni) acc[mi][ni] = mfma16(a[mi], b[ni], acc[mi][ni]);
    }
    if (kt + 1 < nk) {
      char* dA = smem + ((kt + 1) & 1) * 49152;
#pragma unroll
      for (int i = 0; i < 4; ++i) *(u32x4*)(dA + lds_off + i * 8192) = ra[i];
#pragma unroll
      for (int i = 0; i < 2; ++i) *(u32x4*)(dA + 32768 + lds_off + i * 8192) = rb[i];
    }
    __syncthreads();
  }
  float* sC = (float*)smem;
#pragma unroll
  for (int mi = 0; mi < 4; ++mi)
#pragma unroll
    for (int ni = 0; ni < 4; ++ni)
#pragma unroll
      for (int r = 0; r < 4; ++r) sC[(wm * 64 + mi * 16 + g * 4 + r) * LDC + wn * 64 + ni * 16 + lr] = acc[mi][ni][r];
  __syncthreads();
}

__device__ __forceinline__ void epi_store_bf16(const char* smem, u16* C, long ldc, float scale, int ncols) {
  const int tidx = otid();
  const float* sC = (const float*)smem;
  const int cv = ncols >> 2;
  for (int i = tidx; i < 256 * cv; i += NTHR) {
    const int r = i / cv, c = (i - r * cv) * 4;
    const float4 v = *(const float4*)(sC + r * 132 + c);
    u32x2 o; o[0] = pack2(v.x * scale, v.y * scale); o[1] = pack2(v.z * scale, v.w * scale);
    *(u32x2*)(C + (long)r * ldc + c) = o;
  }
}
__device__ __forceinline__ void epi_resid_f32(const char* smem, const float* R, float* C, long ldc) {
  const int tidx = otid();
  const float* sC = (const float*)smem;
  for (int i = tidx; i < 256 * 32; i += NTHR) {
    const int r = i >> 5, c = (i & 31) * 4;
    const float4 v = *(const float4*)(sC + r * 132 + c);
    const float4 x = *(const float4*)(R + (long)r * ldc + c);
    float4 o; o.x = v.x + x.x; o.y = v.y + x.y; o.z = v.z + x.z; o.w = v.w + x.w;
    *(float4*)(C + (long)r * ldc + c) = o;
  }
}

namespace pg8 {
#define PG8_LAS __attribute__((address_space(3)))
typedef unsigned short bf16_t;
typedef short bf16x8 __attribute__((ext_vector_type(8)));
typedef float f32x4 __attribute__((ext_vector_type(4)));
typedef unsigned u32x4 __attribute__((ext_vector_type(4)));
constexpr int BM = 256, BK = 64, HALF = 128, HTB = HALF * BK * 2  , STAGE_BYTES = 8 * HTB, NXCD = 8, WGM = 8;

__host__ __device__ __forceinline__ int lds_byte(int r, int c) { const int st = (r >> 4) * 2 + (c >> 5), rr = r & 15, cc = c & 31, ob = rr * 64 + cc * 2; return st * 1024 + (ob ^ (((ob >> 9) & 1) << 5)); }
__host__ __device__ __forceinline__ void stage_rc(int b, int& R, int& C) { const int st = b / 1024, sb = b % 1024, swz = sb ^ (((sb >> 9) & 1) << 5); R = (st >> 1) * 16 + swz / 64; C = (st & 1) * 32 + (swz % 64) / 2; }
__host__ __device__ __forceinline__ int perm32(int rho) { const int n = rho >> 4, i = rho & 15; return 8 * (i >> 2) + 4 * n + (i & 3); }

struct Unit { int pm, pn; };
struct Gemm { const bf16_t* A; const bf16_t* Bt; int M, N, K; };
struct StaticOrder {
    int nM, nN, nwg, G, c;
    __host__ __device__ void init(int M, int N, int G_, int c_) { nM = M / BM; nN = N / BM; nwg = nM * nN; G = G_; c = c_; }
    __host__ __device__ bool next(int i, Unit& u) const {
        const long L = (long)i * G + c; if (L >= nwg) return false;
        int wgid = (int)L; { const int q = nwg / NXCD, r = nwg % NXCD, xcd = wgid % NXCD, off = wgid / NXCD; wgid = (xcd < r ? xcd * (q + 1) : r * (q + 1) + (xcd - r) * q) + off; }
        const int nig = WGM * nN, gid = wgid / nig, fm = gid * WGM, gsz = (nM - fm) < WGM ? (nM - fm) : WGM;
        u.pm = fm + ((wgid % nig) % gsz); u.pn = (wgid % nig) / gsz; return true;
    }
    __device__ __forceinline__ void a_ready(const Unit&) const {}
    __device__ __forceinline__ void done(const Unit&) const {}
};
__device__ __forceinline__ unsigned cvt_pk_bf16(float lo, float hi) { unsigned r; asm volatile("v_cvt_pk_bf16_f32 %0, %1, %2" : "=v"(r) : "v"(lo), "v"(hi)); return r; }
template <class Epi, class Sched, bool STAMP = false>
__device__ __forceinline__ void gemm_phase(PG8_LAS unsigned char* lds, const Gemm g, const Sched& S, const Epi& E, unsigned long long* stamps) {
    const int tid = otid(), wid = __builtin_amdgcn_readfirstlane(tid >> 6), lane = tid & 63, wr = wid >> 2, wc = wid & 3, fr = lane & 15, fq = lane >> 4;
    const int K = g.K, nt = K / BK;
    int ts_lo = 0, ts_hi = 0, nts = 0; const unsigned long long rt_entry = STAMP ? (unsigned long long)wall_clock64() : 0ull;
#define PG8_STAMP() do { if (STAMP && wid == 0 && nts < 64) { const unsigned long long _c = (unsigned long long)clock64(); \
        ts_lo = (lane == nts) ? (int)(unsigned)_c : ts_lo; ts_hi = (lane == nts) ? (int)(unsigned)(_c >> 32) : ts_hi; ++nts; } } while (0)
    PG8_STAMP();
    unsigned voffA[2], voffB[2];
#pragma unroll
    for (int i = 0; i < 2; ++i) { int R, C; stage_rc(tid * 16 + i * 8192, R, C); const int Rb = Epi::PERM ? ((R & ~31) + perm32(R & 31)) : R;
        voffA[i] = (unsigned)(R * K + C) * 2u; voffB[i] = (unsigned)(Rb * K + C) * 2u; }
    const size_t kstep = (size_t)(BK * 2);
    const size_t hstep = (size_t)HALF * K * 2;
    const size_t tstep = 2 * hstep;
    const unsigned ldsw = (unsigned)wid * 1024u;
    const int aoff = lds_byte(wr * 64 + fr, fq * 8), boff = lds_byte(wc * 32 + fr, fq * 8);
#define PG8_SA(b, h) (((b) * 2 + (h)) * HTB)
#define PG8_SB(b, h) ((4 + (b) * 2 + (h)) * HTB)
#define PG8_STAGE(bufoff, gbase, voff) do { _Pragma("unroll") for (int _i = 0; _i < 2; ++_i) \
        __builtin_amdgcn_global_load_lds((const unsigned*)((const char*)(gbase) + (voff)[_i]), (PG8_LAS unsigned*)(lds + (bufoff) + ldsw + _i * 8192), 16, 0, 0); } while (0)
#define PG8_LDA(dst, b, h) do { _Pragma("unroll") for (int m = 0; m < 4; ++m) _Pragma("unroll") for (int k = 0; k < 2; ++k) dst[m][k] = *(const PG8_LAS bf16x8*)(lds + PG8_SA(b, h) + aoff + m * 2048 + k * 1024); } while (0)
#define PG8_LDB(dst, b, h) do { _Pragma("unroll") for (int n = 0; n < 2; ++n) _Pragma("unroll") for (int k = 0; k < 2; ++k) dst[n][k] = *(const PG8_LAS bf16x8*)(lds + PG8_SB(b, h) + boff + n * 2048 + k * 1024); } while (0)
#define PG8_MMA(ai, bj, At, Bt) do { __builtin_amdgcn_s_setprio(1); _Pragma("unroll") for (int m = 0; m < 4; ++m) _Pragma("unroll") for (int n = 0; n < 2; ++n) _Pragma("unroll") for (int k = 0; k < 2; ++k) \
        acc[ai][bj][m][n] = __builtin_amdgcn_mfma_f32_16x16x32_bf16(Bt[n][k], At[m][k], acc[ai][bj][m][n], 0, 0, 0); __builtin_amdgcn_s_setprio(0); } while (0)
#define PG8_WAIT_V(n) asm volatile("s_waitcnt vmcnt(" #n ")" ::: "memory")
#define PG8_WAIT_L(n) asm volatile("s_waitcnt lgkmcnt(" #n ")" ::: "memory")
#define PG8_BAR __builtin_amdgcn_s_barrier()
#define PG8_SCHED __builtin_amdgcn_sched_barrier(0)
    Unit cur, nxt; int ui = 0;
    if (!S.next(0, cur)) return;
    f32x4 acc[2][2][4][2];
#pragma unroll
    for (int a = 0; a < 2; ++a)
#pragma unroll
        for (int b = 0; b < 2; ++b)
#pragma unroll
            for (int m = 0; m < 4; ++m)
#pragma unroll
                for (int n = 0; n < 2; ++n) acc[a][b][m][n] = (f32x4){0.f, 0.f, 0.f, 0.f};
    bf16x8 At[4][2], B0[2][2], B1[2][2];
    const char* cA = (const char*)g.A + (size_t)cur.pm * tstep; const char* cB = (const char*)g.Bt + (size_t)cur.pn * tstep;
    S.a_ready(cur);
    PG8_STAGE(PG8_SB(0, 0), cB, voffB); PG8_STAGE(PG8_SA(0, 0), cA, voffA); PG8_STAGE(PG8_SB(0, 1), cB + hstep, voffB); PG8_STAGE(PG8_SA(0, 1), cA + hstep, voffA);
    if (wr == 1) PG8_BAR;
    PG8_WAIT_V(4); PG8_BAR;
    PG8_STAGE(PG8_SB(1, 0), cB + kstep, voffB); PG8_STAGE(PG8_SA(1, 0), cA + kstep, voffA); PG8_STAGE(PG8_SB(1, 1), cB + hstep + kstep, voffB);
    PG8_WAIT_V(6); PG8_BAR;
    PG8_STAMP();
    for (;;) {
        const bool has_next = S.next(ui + 1, nxt);
        const char* nA = has_next ? (const char*)g.A + (size_t)nxt.pm * tstep : cA; const char* nB = has_next ? (const char*)g.Bt + (size_t)nxt.pn * tstep : cB;
        for (int t = 0; t < nt; t += 2) {
            const bool last = (t == nt - 2);
            const char* a1 = cA + (size_t)(t + 1) * kstep;
            const char* a2 = last ? nA : cA + (size_t)(t + 2) * kstep; const char* b2 = last ? nB : cB + (size_t)(t + 2) * kstep;
            const char* a3 = a2 + kstep; const char* b3 = b2 + kstep;
            if (last && has_next) S.a_ready(nxt);
            PG8_LDB(B0, 0, 0); PG8_SCHED; PG8_LDA(At, 0, 0); PG8_STAGE(PG8_SA(1, 1), a1 + hstep, voffA);
            PG8_WAIT_L(8); PG8_BAR; PG8_WAIT_L(0); PG8_MMA(0, 0, At, B0); PG8_BAR; PG8_SCHED;
            PG8_LDB(B1, 0, 1); PG8_STAGE(PG8_SB(0, 0), b2, voffB);
            PG8_BAR; PG8_WAIT_L(0); PG8_MMA(0, 1, At, B1); PG8_BAR;
            PG8_LDA(At, 0, 1); PG8_STAGE(PG8_SA(0, 0), a2, voffA);
            PG8_BAR; PG8_WAIT_L(0); PG8_MMA(1, 0, At, B0); PG8_BAR; PG8_SCHED;
            PG8_STAGE(PG8_SB(0, 1), b2 + hstep, voffB);
            PG8_WAIT_V(6); PG8_BAR; PG8_MMA(1, 1, At, B1); PG8_BAR;
            PG8_LDB(B0, 1, 0); PG8_SCHED; PG8_LDA(At, 1, 0); PG8_STAGE(PG8_SA(0, 1), a2 + hstep, voffA);
            PG8_WAIT_L(8); PG8_BAR; PG8_WAIT_L(0); PG8_MMA(0, 0, At, B0); PG8_BAR; PG8_SCHED;
            PG8_LDB(B1, 1, 1); PG8_STAGE(PG8_SB(1, 0), b3, voffB);
            PG8_BAR; PG8_WAIT_L(0); PG8_MMA(0, 1, At, B1); PG8_BAR;
            PG8_LDA(At, 1, 1); PG8_STAGE(PG8_SA(1, 0), a3, voffA);
            PG8_BAR; PG8_WAIT_L(0); PG8_MMA(1, 0, At, B0); PG8_BAR; PG8_SCHED;
            PG8_STAGE(PG8_SB(1, 1), b3 + hstep, voffB);
            PG8_WAIT_V(6); PG8_BAR; PG8_MMA(1, 1, At, B1); PG8_BAR;
        }
        PG8_STAMP();
        if constexpr (!Epi::AFTER_DRAIN) { E(acc, cur, wr, wc, fr, fq); S.done(cur); }
        PG8_STAMP();
        if (!has_next) break;
#pragma unroll
        for (int a = 0; a < 2; ++a)
#pragma unroll
            for (int b = 0; b < 2; ++b)
#pragma unroll
                for (int m = 0; m < 4; ++m)
#pragma unroll
                    for (int n = 0; n < 2; ++n) acc[a][b][m][n] = (f32x4){0.f, 0.f, 0.f, 0.f};
        cur = nxt; cA = nA; cB = nB; ++ui;
    }
    PG8_WAIT_V(0);
    if (wr == 0) PG8_BAR;
    PG8_BAR;
    if constexpr (Epi::AFTER_DRAIN) { E.fused(acc, cur, wr, wc, fr, fq, lds, wid, lane); S.done(cur); }
    PG8_STAMP();
    if (STAMP && wid == 0) { stamps[lane] = lane < nts ? (((unsigned long long)(unsigned)ts_hi << 32) | (unsigned)ts_lo) : 0ull;
        if (lane == 62) stamps[62] = rt_entry; if (lane == 63) stamps[63] = (unsigned long long)wall_clock64(); }
#undef PG8_STAMP
#undef PG8_SA
#undef PG8_SB
#undef PG8_STAGE
#undef PG8_LDA
#undef PG8_LDB
#undef PG8_MMA
#undef PG8_WAIT_V
#undef PG8_WAIT_L
#undef PG8_BAR
#undef PG8_SCHED
}
}

__device__ __forceinline__ void pg_store_bf16(const pg8::f32x4 (&acc)[2][2][4][2], u16* base, long ldc, int row0, int col0) {
#pragma unroll
  for (int ai = 0; ai < 2; ++ai)
#pragma unroll
    for (int m = 0; m < 4; ++m) {
      u16* rowp = base + (size_t)(row0 + ai * 128 + m * 16) * ldc + col0;
#pragma unroll
      for (int bj = 0; bj < 2; ++bj) {
        const pg8::f32x4 v0 = acc[ai][bj][m][0], v1 = acc[ai][bj][m][1];
        u32x4 w; w[0] = pg8::cvt_pk_bf16(v0[0], v0[1]); w[1] = pg8::cvt_pk_bf16(v0[2], v0[3]); w[2] = pg8::cvt_pk_bf16(v1[0], v1[1]); w[3] = pg8::cvt_pk_bf16(v1[2], v1[3]);
        *(u32x4*)(rowp + bj * 128) = w;
      }
    }
}
struct EpiG1 {
  static constexpr bool PERM = true, AFTER_DRAIN = false; char* ws;
  __device__ __forceinline__ void operator()(const pg8::f32x4 (&acc)[2][2][4][2], const pg8::Unit& u, int wr, int wc, int fr, int fq) const {
    u16* base; long ldc; int colt;
    if (u.pn < 3) { base = (u16*)(ws + OFF_PA); ldc = 768; colt = u.pn * 256; }
    else if (u.pn < 9) { base = (u16*)(ws + OFF_PB); ldc = 1536; colt = (u.pn - 3) * 256; }
    else { base = (u16*)(ws + OFF_BZ); ldc = 512; colt = (u.pn - 9) * 256; }
    pg_store_bf16(acc, base, ldc, u.pm * 256 + wr * 64 + fr, colt + wc * 32 + 8 * fq);
  }
};
struct EpiG2 {
  static constexpr bool PERM = true, AFTER_DRAIN = false; u16* qi; u16* qlat;
  __device__ __forceinline__ void operator()(const pg8::f32x4 (&acc)[2][2][4][2], const pg8::Unit& u, int wr, int wc, int fr, int fq) const {
    u16* base; long ldc; int colt;
    if (u.pn < 2) { base = qi; ldc = 512; colt = u.pn * 256; } else { base = qlat; ldc = 2048; colt = (u.pn - 2) * 256; }
    pg_store_bf16(acc, base, ldc, u.pm * 256 + wr * 64 + fr, colt + wc * 32 + 8 * fq);
  }
};
struct EpiB16 {
  static constexpr bool PERM = true, AFTER_DRAIN = false; u16* O; long ldc; const float* ssq;
  __device__ __forceinline__ void operator()(const pg8::f32x4 (&acc)[2][2][4][2], const pg8::Unit& u, int wr, int wc, int fr, int fq) const {
    const int row0 = u.pm * 256 + wr * 64 + fr, col0 = u.pn * 256 + wc * 32 + 8 * fq;
#pragma unroll
    for (int ai = 0; ai < 2; ++ai)
#pragma unroll
      for (int m = 0; m < 4; ++m) {
        const int row = row0 + ai * 128 + m * 16;
        const float rs = rsqrtf(ssq[row] * (1.f / DM) + EPSV);
        u16* rowp = O + (size_t)row * ldc + col0;
#pragma unroll
        for (int bj = 0; bj < 2; ++bj) {
          const pg8::f32x4 v0 = acc[ai][bj][m][0] * rs, v1 = acc[ai][bj][m][1] * rs;
          u32x4 w; w[0] = pg8::cvt_pk_bf16(v0[0], v0[1]); w[1] = pg8::cvt_pk_bf16(v0[2], v0[3]); w[2] = pg8::cvt_pk_bf16(v1[0], v1[1]); w[3] = pg8::cvt_pk_bf16(v1[2], v1[3]);
          *(u32x4*)(rowp + bj * 128) = w;
        }
      }
  }
};
template <bool RF32>
struct EpiResidB {
  static constexpr bool PERM = false, AFTER_DRAIN = false; const float* R; u16* hb; float* ssq;
  __device__ __forceinline__ void operator()(const pg8::f32x4 (&acc)[2][2][4][2], const pg8::Unit& u, int wr, int wc, int fr, int fq) const {
    const int row0 = u.pm * 256 + wr * 64 + fr, col0 = u.pn * 256 + wc * 32 + 4 * fq;
#pragma unroll
    for (int ai = 0; ai < 2; ++ai)
#pragma unroll
      for (int m = 0; m < 4; ++m) {
        const int row = row0 + ai * 128 + m * 16;
        const size_t ro = (size_t)row * DM + col0;
        float sq = 0.f;
#pragma unroll
        for (int bj = 0; bj < 2; ++bj)
#pragma unroll
          for (int n = 0; n < 2; ++n) {
            pg8::f32x4 x;
            if (RF32) x = *(const pg8::f32x4*)(R + ro + bj * 128 + n * 16);
            else { const u32x2 xb = *(const u32x2*)(hb + ro + bj * 128 + n * 16); x[0] = lo2f(xb[0]); x[1] = hi2f(xb[0]); x[2] = lo2f(xb[1]); x[3] = hi2f(xb[1]); }
            const pg8::f32x4 y = x + acc[ai][bj][m][n];
            u32x2 hw; hw[0] = pg8::cvt_pk_bf16(y[0], y[1]); hw[1] = pg8::cvt_pk_bf16(y[2], y[3]);
            *(u32x2*)(hb + ro + bj * 128 + n * 16) = hw;
            sq += y[0] * y[0] + y[1] * y[1] + y[2] * y[2] + y[3] * y[3];
          }
        sq += sx(sq, 16); sq += sx(sq, 32);
        if (fq == 0) atomicAdd(ssq + row, sq);
      }
  }
};
struct EpiResid {
  static constexpr bool PERM = false, AFTER_DRAIN = false; const float* R; float* C; u16* hb; float* ssq;
  __device__ __forceinline__ void operator()(const pg8::f32x4 (&acc)[2][2][4][2], const pg8::Unit& u, int wr, int wc, int fr, int fq) const {
    const int row0 = u.pm * 256 + wr * 64 + fr, col0 = u.pn * 256 + wc * 32 + 4 * fq;
#pragma unroll
    for (int ai = 0; ai < 2; ++ai)
#pragma unroll
      for (int m = 0; m < 4; ++m) {
        const int row = row0 + ai * 128 + m * 16;
        const size_t ro = (size_t)row * DM + col0;
        float sq = 0.f;
#pragma unroll
        for (int bj = 0; bj < 2; ++bj)
#pragma unroll
          for (int n = 0; n < 2; ++n) {
            const pg8::f32x4 x = *(const pg8::f32x4*)(R + ro + bj * 128 + n * 16);
            const pg8::f32x4 y = x + acc[ai][bj][m][n];
            *(pg8::f32x4*)(C + ro + bj * 128 + n * 16) = y;
            u32x2 hw; hw[0] = pg8::cvt_pk_bf16(y[0], y[1]); hw[1] = pg8::cvt_pk_bf16(y[2], y[3]);
            *(u32x2*)(hb + ro + bj * 128 + n * 16) = hw;
            sq += y[0] * y[0] + y[1] * y[1] + y[2] * y[2] + y[3] * y[3];
          }
        sq += sx(sq, 16); sq += sx(sq, 32);
        if (fq == 0) atomicAdd(ssq + row, sq);
      }
  }
};
template <class Epi>
__device__ __forceinline__ void pg_phase(const u16* A, const u16* Bt, int M, int N, int K, const Epi& E, char* smem, int bid, int nblk) {
  pg8::Gemm g; g.A = A; g.Bt = Bt; g.M = M; g.N = N; g.K = K;
  pg8::StaticOrder S; S.init(M, N, nblk, bid);
  __syncthreads();
  pg8::gemm_phase<Epi, pg8::StaticOrder, false>((PG8_LAS unsigned char*)smem, g, S, E, nullptr);
  __syncthreads();
}

struct Params {
  const float *x, *mem, *g_mix, *w_in, *g_cq, *g_ckv, *g_kidx, *w_uq, *w_iq, *w_uk, *w_uv, *rel_bias, *conv_w, *A_log, *dt_bias, *g_onorm,
      *w_out, *g_cross, *g_mem, *wq_x, *wk_x, *wv_x, *wo_x, *g_ffn, *w_pq, *sub_keys, *u_emb, *v_emb, *g_final;
  float* out;
  char* ws;
};


__device__ __forceinline__ int perm32_pos(int c);
struct GemmP { const u16* A; long lda, a_bs; const u16* Bt; long ldb, b_bs; u16* C; long ldc, c_bs; int M, N, K, nbatch; float scale; int ncols; int tstore; };
__device__ __forceinline__ void gemm_bf16_phase(const GemmP& p, char* smem, int bid, int nblk) {
  const int tidx = otid();
  const int nm = p.M >> 8, nn = p.N >> 7, per = nm * nn;
  for (int t = bid; t < per * p.nbatch; t += nblk) {
    const int b = t / per, r = t - b * per, mp = r / nn, np = r - mp * nn;
    gemm_tile<132>(p.A + b * p.a_bs + (long)mp * 256 * p.lda, p.lda, p.Bt + b * p.b_bs + (long)np * 128 * p.ldb, p.ldb, p.K, smem);
    if (!p.tstore) epi_store_bf16(smem, p.C + b * p.c_bs + (long)mp * 256 * p.ldc + np * 128, p.ldc, p.scale, p.ncols);
    else if (p.tstore == 2) {
      const float* sC = (const float*)smem;
      u16* C = p.C + b * p.c_bs + (long)mp * 256 * p.ldc + np * 128;
      for (int i = tidx; i < 256 * 128; i += NTHR) { const int m = i >> 7, n = i & 127; C[(long)m * p.ldc + perm32_pos(n)] = f2bf(sC[m * 132 + n] * p.scale); }
    } else {
      const float* sC = (const float*)smem;
      u16* C = p.C + b * p.c_bs + (long)np * 128 * p.ldc + mp * 256;
      for (int i = tidx; i < 256 * 128; i += NTHR) { const int n = i >> 8, m = i & 255; C[(long)n * p.ldc + m] = f2bf(sC[m * 132 + n] * p.scale); }
    }
  }
}

__device__ __forceinline__ void g1_phase(const Params& P, char* smem, int bid, int nblk) {
  const u16* A = (const u16*)(P.ws + OFF_H); const u16* Bt = (const u16*)(P.ws + OFF_WINT);
  for (int t = bid; t < 128 * 21; t += nblk) {
    const int mp = t / 21, np = t - mp * 21;
    gemm_tile<132>(A + (long)mp * 256 * DM, DM, Bt + (long)np * 128 * DM, DM, DM, smem);
    u16* C; long ldc;
    if (np < 5) { C = (u16*)(P.ws + OFF_PA) + np * 128; ldc = 640; }
    else if (np < 17) { C = (u16*)(P.ws + OFF_PB) + (np - 5) * 128; ldc = 1536; }
    else { C = (u16*)(P.ws + OFF_BZ) + (np - 17) * 128; ldc = 512; }
    epi_store_bf16(smem, C + (long)mp * 256 * ldc, ldc, 1.f, 128);
  }
}

__device__ __forceinline__ void g2_phase(const Params& P, char* smem, int bid, int nblk) {
  const u16* A = (const u16*)(P.ws + OFF_CQN); const u16* Bt = (const u16*)(P.ws + OFF_WG2T);
  for (int t = bid; t < 128 * 20; t += nblk) {
    const int mp = t / 20, np = t - mp * 20;
    gemm_tile<132>(A + (long)mp * 256 * 256, 256, Bt + (long)np * 128 * 256, 256, 256, smem);
    if (np < 4) epi_store_bf16(smem, (u16*)(P.ws + OFF_QI) + (long)mp * 256 * 512 + np * 128, 512, 1.f, 128);
    else epi_store_bf16(smem, (u16*)P.out + (long)mp * 256 * 2048 + (np - 4) * 128, 2048, 1.f, 128);
  }
}

struct GemmR { const u16* A; long lda; const u16* Bt; long ldb; const float* R; float* C; int K; };
__device__ __forceinline__ void gemm_resid_phase(const GemmR& p, char* smem, int bid, int nblk) {
  for (int t = bid; t < 128 * 8; t += nblk) {
    const int mp = t >> 3, np = t & 7;
    gemm_tile<132>(p.A + (long)mp * 256 * p.lda, p.lda, p.Bt + (long)np * 128 * p.ldb, p.ldb, p.K, smem);
    epi_resid_f32(smem, p.R + (long)mp * 256 * DM + np * 128, p.C + (long)mp * 256 * DM + np * 128, DM);
  }
}

__device__ __forceinline__ void dsa_prep_phase(const Params& P, int bid, int nblk) {
  const int tidx = otid();
  const int lane = tidx & 63, wv = tidx >> 6;
  const u16* Pa = (const u16*)(P.ws + OFF_PA);
  u16* cqn = (u16*)(P.ws + OFF_CQN); u16* ckvn = (u16*)(P.ws + OFF_CKVN); u16* kidxn = (u16*)(P.ws + OFF_KIDXN); float* widx = (float*)(P.ws + OFF_WIDX);
  const float4 ga = *(const float4*)(P.g_cq + lane * 4), gc = *(const float4*)(P.g_ckv + lane * 4);
  const float gk = P.g_kidx[lane];
  for (int t0 = (bid * 8 + wv) * 4; t0 < T_TOK; t0 += nblk * 32) {
    u32x2 av[4], cv[4]; u16 kv[4], wvv[4];
#pragma unroll
    for (int k = 0; k < 4; ++k) {
      const u16* row = Pa + (long)(t0 + k) * 768;
      av[k] = *(const u32x2*)(row + lane * 4); cv[k] = *(const u32x2*)(row + 256 + lane * 4); kv[k] = row[512 + lane]; wvv[k] = row[576 + (lane & 7)];
    }
#pragma unroll
    for (int k = 0; k < 4; ++k) {
      const int t = t0 + k;
      const float kf = bf2f(kv[k]);
      const float a0 = lo2f(av[k][0]), a1 = hi2f(av[k][0]), a2 = lo2f(av[k][1]), a3 = hi2f(av[k][1]);
      const float c0 = lo2f(cv[k][0]), c1 = hi2f(cv[k][0]), c2 = lo2f(cv[k][1]), c3 = hi2f(cv[k][1]);
      const float sa = wave_sum(a0 * a0 + a1 * a1 + a2 * a2 + a3 * a3), sc = wave_sum(c0 * c0 + c1 * c1 + c2 * c2 + c3 * c3), sk = wave_sum(kf * kf);
      const float ra = rsqrtf(sa * (1.f / 256) + EPSV), rc = rsqrtf(sc * (1.f / 256) + EPSV), rk = rsqrtf(sk * (1.f / 64) + EPSV);
      u32x2 o; o[0] = pack2(a0 * ra * ga.x, a1 * ra * ga.y); o[1] = pack2(a2 * ra * ga.z, a3 * ra * ga.w);
      *(u32x2*)(cqn + (long)t * 256 + lane * 4) = o;
      o[0] = pack2(c0 * rc * gc.x, c1 * rc * gc.y); o[1] = pack2(c2 * rc * gc.z, c3 * rc * gc.w);
      *(u32x2*)(ckvn + (long)t * 256 + lane * 4) = o;
      kidxn[(long)t * 64 + lane] = f2bf(kf * rk * gk);
      if (lane < 8) widx[(long)t * 8 + lane] = bf2f(wvv[k]) * 0.04419417382415922f;
    }
  }
}

__device__ __forceinline__ unsigned xb_xcc_id();
#define IX_CAP 2048
#define IX_CK 0
#define IX_HIST 131072
#define IX_CV 152640
#define IX_CNT 154688
#define IX_NV (IX_CAP / 64)
__device__ __forceinline__ unsigned wave_umax_u(unsigned v) {
#pragma unroll
  for (int o = 32; o >= 1; o >>= 1) { const unsigned t = (unsigned)sx((int)v, o); v = v > t ? v : t; }
  return v;
}
__device__ __forceinline__ unsigned wave_umin_u(unsigned v) { return ~wave_umax_u(~v); }
template <int NV>
__device__ __forceinline__ void compact_query(char* smem, int q, int n, int lane, int wv) {
  unsigned* ck = (unsigned*)(smem + IX_CK) + q * IX_CAP;
  unsigned* hist = (unsigned*)(smem + IX_HIST) + wv * 256;
  unsigned* cval = (unsigned*)(smem + IX_CV) + wv * 64;
  unsigned v[NV];
#pragma unroll
  for (int i = 0; i < NV; ++i) { const int e = i * 64 + lane; v[i] = (e < n) ? ck[e] : 0u; }
  unsigned lo = 0xffffffffu, hi = 0u;
#pragma unroll
  for (int i = 0; i < NV; ++i) { const unsigned x = (i * 64 + lane < n) ? v[i] : 0xffffffffu; lo = lo < x ? lo : x; hi = hi > v[i] ? hi : v[i]; }
  lo = wave_umin_u(lo); hi = wave_umax_u(hi);
  int need = 256;
  unsigned tau = lo;
  for (int iter = 0; iter < 40; ++iter) {
    if (hi == lo) { tau = lo; break; }
    const unsigned range = hi - lo;
    const int nbits = 32 - __clz((int)range);
    const int shift = nbits > 8 ? nbits - 8 : 0;
    for (int i = lane; i < 256; i += 64) hist[i] = 0u;
    __builtin_amdgcn_wave_barrier();
#pragma unroll
    for (int i = 0; i < NV; ++i) { const unsigned x = v[i]; if (x >= lo && x <= hi) atomicAdd(&hist[(x - lo) >> shift], 1u); }
    __builtin_amdgcn_wave_barrier();
    unsigned c[4]; unsigned tot = 0;
#pragma unroll
    for (int j = 0; j < 4; ++j) { c[j] = hist[255 - 4 * lane - j]; tot += c[j]; }
    unsigned incl = tot;
#pragma unroll
    for (int o = 1; o < 64; o <<= 1) { const unsigned t = su(incl, o); if (lane >= o) incl += t; }
    const unsigned excl = incl - tot;
    const bool mine = (excl < (unsigned)need) && (incl >= (unsigned)need);
    int bsel = 0; unsigned above = 0, nstar = 0;
    if (mine) {
      unsigned run = excl;
#pragma unroll
      for (int j = 0; j < 4; ++j) { if (run < (unsigned)need && run + c[j] >= (unsigned)need) { bsel = 255 - 4 * lane - j; above = run; nstar = c[j]; } run += c[j]; }
    }
    const unsigned long long mk = __ballot(mine);
    const int src = __ffsll((long long)mk) - 1;
    bsel = sh(bsel, src); above = sh(above, src); nstar = sh(nstar, src);
    need -= (int)above;
    unsigned nlo = 0xffffffffu, nhi = 0u; int cnt = 0;
#pragma unroll
    for (int i = 0; i < NV; ++i) {
      const unsigned x = v[i];
      const bool in = (x >= lo && x <= hi) && ((int)((x - lo) >> shift) == bsel);
      if (in) { nlo = nlo < x ? nlo : x; nhi = nhi > x ? nhi : x; }
      if (nstar <= 64u) {
        const unsigned long long m = __ballot(in);
        if (in) { const int pos = cnt + __builtin_amdgcn_mbcnt_hi((unsigned)(m >> 32), __builtin_amdgcn_mbcnt_lo((unsigned)m, 0u)); cval[pos] = x; }
        cnt += __popcll(m);
      }
    }
    nlo = wave_umin_u(nlo); nhi = wave_umax_u(nhi);
    if (nstar <= 64u) {
      __builtin_amdgcn_wave_barrier();
      const bool act = lane < (int)nstar;
      const unsigned mv = act ? cval[lane] : 0u;
      int rank = 0;
      for (int j = 0; j < (int)nstar; ++j) rank += (cval[j] > mv) ? 1 : 0;
      const unsigned long long mm = __ballot(act && rank == need - 1);
      const int s2 = __ffsll((long long)mm) - 1;
      tau = (unsigned)sh((int)mv, s2 < 0 ? 0 : s2);
      break;
    }
    lo = nlo; hi = nhi;
  }
  int pos = 0;
#pragma unroll
  for (int i = 0; i < NV; ++i) {
    const bool keep = v[i] >= tau && v[i] != 0u;
    const unsigned long long m = __ballot(keep);
    if (keep) { const int p = pos + __builtin_amdgcn_mbcnt_hi((unsigned)(m >> 32), __builtin_amdgcn_mbcnt_lo((unsigned)m, 0u)); if (p < IX_CAP) ck[p] = v[i]; }
    pos += __popcll(m);
  }
  if (lane == 0) { ((unsigned*)(smem + IX_CNT))[q] = 256u; ((unsigned*)(smem + IX_CNT))[16 + q] = tau; }
}
__device__ __forceinline__ void quick_compact(char* smem, int q, int n, int lane) {
  unsigned* ck = (unsigned*)(smem + IX_CK) + q * IX_CAP;
  unsigned v[IX_NV];
#pragma unroll
  for (int i = 0; i < IX_NV; ++i) { const int e = i * 64 + lane; v[i] = (e < n) ? ck[e] : 0u; }
  const unsigned smp = v[0];
  int rank = 0;
#pragma unroll
  for (int m = 0; m < 64; ++m) rank += ((unsigned)__builtin_amdgcn_readlane((int)smp, m) > smp) ? 1 : 0;
  int r = (64 * 336 + n / 2) / n; r = r < 1 ? 1 : (r > 62 ? 62 : r);
  unsigned thr = 0u; int kept = n; bool ok = false;
  for (int it = 0; it < 6; ++it) {
    const unsigned long long mm = __ballot(rank == r);
    const int src = __ffsll((long long)mm) - 1;
    const unsigned cand = (unsigned)__builtin_amdgcn_readlane((int)smp, src < 0 ? 0 : src);
    int c = 0;
#pragma unroll
    for (int i = 0; i < IX_NV; ++i) c += __popcll(__ballot(v[i] > cand));
    if (c >= 256 && c <= 448) { thr = cand; kept = c; ok = true; break; }
    int r2 = (r * 336 + (c > 0 ? c / 2 : 0)) / (c > 0 ? c : 1);
    if (r2 == r) r2 = (c < 256) ? r + 1 : r - 1;
    r = r2 < 1 ? 1 : (r2 > 62 ? 62 : r2);
  }
  if (!ok) {
    unsigned lo = 0xffffffffu, hi = 0u;
#pragma unroll
    for (int i = 0; i < IX_NV; ++i) { const unsigned x = (i * 64 + lane < n) ? v[i] : 0xffffffffu; lo = lo < x ? lo : x; hi = hi > v[i] ? hi : v[i]; }
    lo = wave_umin_u(lo); hi = wave_umax_u(hi);
    unsigned a = lo, b = hi; thr = 0u; kept = n;
    for (int it = 0; it < 34 && kept > 448; ++it) {
      const unsigned mid = a + ((b - a) >> 1);
      if (mid == a) break;
      int c = 0;
#pragma unroll
      for (int i = 0; i < IX_NV; ++i) c += __popcll(__ballot(v[i] > mid));
      if (c >= 256) { a = mid; thr = mid; kept = c; } else b = mid;
    }
  }
  int pos = 0;
#pragma unroll
  for (int i = 0; i < IX_NV; ++i) {
    const bool keep = v[i] > thr;
    const unsigned long long m = __ballot(keep);
    if (keep) { const int p = pos + __builtin_amdgcn_mbcnt_hi((unsigned)(m >> 32), __builtin_amdgcn_mbcnt_lo((unsigned)m, 0u)); ck[p] = v[i]; }
    pos += __popcll(m);
  }
  if (lane == 0) { ((unsigned*)(smem + IX_CNT))[q] = (unsigned)kept; ((unsigned*)(smem + IX_CNT))[16 + q] = thr; }
}
__device__ __forceinline__ void emit_sorted(char* smem, int q, u16* sel, int lane, int wv) {
  const unsigned* ck = (const unsigned*)(smem + IX_CK) + q * IX_CAP;
  unsigned* bm = (unsigned*)(smem + IX_HIST) + wv * 256;
  for (int i = lane; i < 256; i += 64) bm[i] = 0u;
  __builtin_amdgcn_wave_barrier();
#pragma unroll
  for (int k = 0; k < 4; ++k) { const unsigned idx = 8191u - (ck[k * 64 + lane] & 0x1fffu); atomicOr(&bm[idx >> 5], 1u << (idx & 31)); }
  __builtin_amdgcn_wave_barrier();
  unsigned w[4]; unsigned tot = 0;
#pragma unroll
  for (int j = 0; j < 4; ++j) { w[j] = bm[4 * lane + j]; tot += __popc(w[j]); }
  unsigned incl = tot;
#pragma unroll
  for (int o = 1; o < 64; o <<= 1) { const unsigned t = su(incl, o); if (lane >= o) incl += t; }
  unsigned p = incl - tot;
#pragma unroll
  for (int j = 0; j < 4; ++j) {
    unsigned x = w[j];
    while (x) { const int bb = __ffs((int)x) - 1; if (p < 256u) sel[p] = (u16)(lane * 128 + j * 32 + bb); ++p; x &= x - 1; }
  }
}

#define ATT_ROWB 544
__device__ __forceinline__ int t5_bucket(int rel) {
  const int n = rel < 0 ? -rel : rel;
  const int lg = 8 + (n >= 12) + (n >= 16) + (n >= 23) + (n >= 32) + (n >= 46) + (n >= 64) + (n >= 91);
  return (rel > 0 ? 16 : 0) + (n < 8 ? n : lg);
}
#define DSA_SBIAS 139264
#define DSA_SSEL 140288
#define LDS_XB 148480
#define LDS_UNIT 148496
#define DSA_SBK 148544
#define LDS_TOTAL 163840
__device__ __forceinline__ void attn_query(const Params& P, int tv, const u16* ssel, char* rows, const float* sbias, unsigned char* sbk, int lane) {
  const int t = __builtin_amdgcn_readfirstlane(tv);
  const int lr = lane & 15, g = lane >> 4;
  const u16* ckv = (const u16*)(P.ws + OFF_CKVN);
  u16* qlat = (u16*)P.out;
  const int b = t >> 13, pos = t & 8191, L = ((pos >> 6) + 1) * 64, n = L < 256 ? L : 256;
  const u16* kb = ckv + (long)(b * SEQ) * 256;
  bf16x8 bq[8];
#pragma unroll
  for (int ks = 0; ks < 8; ++ks) {
    bf16x8 v = (bf16x8){0, 0, 0, 0, 0, 0, 0, 0};
    if (lr < 8) v = *(const bf16x8*)(qlat + (long)t * 2048 + lr * 256 + ks * 32 + g * 8);
    bq[ks] = v;
  }
  {
    unsigned pk = 0u;
#pragma unroll
    for (int j = 0; j < 4; ++j) pk |= (unsigned)t5_bucket((int)ssel[lane * 4 + j] - pos) << (8 * j);
    *(unsigned*)(sbk + lane * 4) = pk;
  }
  int nfarblk;
  {
    int c = 0;
#pragma unroll
    for (int j = 0; j < 4; ++j) c += __popcll(__ballot((lane * 4 + j) < n && (int)ssel[lane * 4 + j] <= pos - 91));
    nfarblk = __builtin_amdgcn_readfirstlane(c) >> 4;
  }
  const float farb = sbias[15 * 8 + (lr & 7)];
  __builtin_amdgcn_wave_barrier();
  float m_run = -3.0e38f, l_run = 0.f;
  f32x4 O[16];
#pragma unroll
  for (int i = 0; i < 16; ++i) O[i] = (f32x4){0.f, 0.f, 0.f, 0.f};
  const int nb = n >> 4;
  const int grow = lane >> 5, gch = (lane & 31);
  const int q = lr >> 2, pp = lr & 3;
  u32x4 gr[8];
#pragma unroll 1
  for (int j = 0; j < 2; ++j) {
#pragma unroll
    for (int i = 0; i < 8; ++i) { const unsigned idx = ssel[j * 16 + i * 2 + grow]; gr[i] = *(const u32x4*)((const char*)kb + (size_t)(idx * 512u + (unsigned)gch * 16u)); }
#pragma unroll
    for (int i = 0; i < 8; ++i) *(u32x4*)(rows + j * (16 * ATT_ROWB) + (i * 2 + grow) * ATT_ROWB + (gch ^ (i >> 2)) * 16) = gr[i];
  }
  __builtin_amdgcn_wave_barrier();
  auto qk_soft = [&](int j) -> s16x4 {
    const char* buf = rows + (j & 1) * (16 * ATT_ROWB);
    f32x4 S = (f32x4){0.f, 0.f, 0.f, 0.f}, S1 = (f32x4){0.f, 0.f, 0.f, 0.f};
#pragma unroll
    for (int ks = 0; ks < 8; ks += 2) {
      const bf16x8 a0 = *(const bf16x8*)(buf + lr * ATT_ROWB + ((ks * 4 + g) ^ (lr >> 3)) * 16), a1 = *(const bf16x8*)(buf + lr * ATT_ROWB + (((ks + 1) * 4 + g) ^ (lr >> 3)) * 16);
      S = mfma16(a0, bq[ks], S); S1 = mfma16(a1, bq[ks + 1], S1);
    }
    float mx = -3.0e38f;
    if (j < nfarblk) {
#pragma unroll
      for (int r = 0; r < 4; ++r) { S[r] = S[r] + S1[r] + farb; mx = fmaxf(mx, S[r]); }
    } else {
#pragma unroll
      for (int r = 0; r < 4; ++r) { S[r] = S[r] + S1[r] + sbias[(int)sbk[j * 16 + g * 4 + r] * 8 + (lr & 7)]; mx = fmaxf(mx, S[r]); }
    }
    if (__any(mx > m_run + 8.f)) {
      mx = fmaxf(mx, sx(mx, 16)); mx = fmaxf(mx, sx(mx, 32));
      const float m_new = fmaxf(m_run, mx);
      const float alpha = __expf(m_run - m_new);
      l_run *= alpha; m_run = m_new;
      float al[4];
#pragma unroll
      for (int r = 0; r < 4; ++r) al[r] = sh(alpha, g * 4 + r);
#pragma unroll
      for (int ct = 0; ct < 16; ++ct)
#pragma unroll
        for (int r = 0; r < 4; ++r) O[ct][r] *= al[r];
    }
    float ps = 0.f; s16x4 ap;
#pragma unroll
    for (int r = 0; r < 4; ++r) { const float pv = __expf(S[r] - m_run); ps += pv; ap[r] = (short)f2bf(pv); }
    l_run += ps;
    return ap;
  };
  s16x4 ap = qk_soft(0);
#pragma unroll 1
  for (int kbk = 0; kbk < nb; ++kbk) {
    const char* cur = rows + (kbk & 1) * (16 * ATT_ROWB);
    const bool more2 = (kbk + 2) < nb;
    if (more2) {
#pragma unroll
      for (int i = 0; i < 8; ++i) { const unsigned idx = ssel[(kbk + 2) * 16 + i * 2 + grow]; gr[i] = *(const u32x4*)((const char*)kb + (size_t)(idx * 512u + (unsigned)gch * 16u)); }
    }
    const char* tb0 = cur + (4 * g + q) * ATT_ROWB + ((pp * 8) ^ ((g >> 1) * 16));
#pragma unroll
    for (int ct = 0; ct < 16; ++ct) {
      const s16x4 bv = __builtin_amdgcn_ds_read_tr16_b64_v4i16((LAS s16x4*)(tb0 + ct * 32));
      O[ct] = __builtin_amdgcn_mfma_f32_16x16x16bf16_1k(ap, bv, O[ct], 0, 0, 0);
    }
    if (kbk + 1 < nb) ap = qk_soft(kbk + 1);
    __builtin_amdgcn_wave_barrier();
    if (more2) {
      char* dstb = rows + (kbk & 1) * (16 * ATT_ROWB);
#pragma unroll
      for (int i = 0; i < 8; ++i) *(u32x4*)(dstb + (i * 2 + grow) * ATT_ROWB + (gch ^ (i >> 2)) * 16) = gr[i];
    }
    __builtin_amdgcn_wave_barrier();
  }
  float lt = l_run; lt += sx(lt, 16); lt += sx(lt, 32);
  const float inv = 1.f / lt;
  float iv[4];
#pragma unroll
  for (int r = 0; r < 4; ++r) iv[r] = sh(inv, g * 4 + r);
  if (g < 2) {
#pragma unroll
    for (int ct = 0; ct < 16; ++ct)
#pragma unroll
      for (int r = 0; r < 4; ++r) qlat[(long)t * 2048 + (g * 4 + r) * 256 + ct * 16 + lr] = f2bf(O[ct][r] * iv[r]);
  }
}

__device__ __forceinline__ void dsa_unit(const Params& P, char* smem, int unit, int bid) {
  const int tidx = otid();
  const int tid = tidx, lane = tid & 63, wv = tid >> 6, lr = lane & 15, g = lane >> 4;
  const u16* qi = (const u16*)(P.ws + OFF_QI); const u16* kidx = (const u16*)(P.ws + OFF_KIDXN); const float* widx = (const float*)(P.ws + OFF_WIDX);
  u16* sselw = (u16*)(smem + DSA_SSEL) + wv * 512;
  const float* sbias = (const float*)(smem + DSA_SBIAS);
  unsigned* scnt = (unsigned*)(smem + IX_CNT); unsigned* stau = (unsigned*)(smem + IX_CNT) + 16;
  const int t0 = unit * 16, b = t0 >> 13, pos0 = t0 & 8191, L = ((pos0 >> 6) + 1) * 64;
  __syncthreads();
  if (L > 256) {
    if (tid < 16) { scnt[tid] = (unsigned)(L < 2048 ? L : 2048); stau[tid] = 0u; }
    bf16x8 a[8][2];
#pragma unroll
    for (int h = 0; h < 8; ++h)
#pragma unroll
      for (int ks = 0; ks < 2; ++ks) a[h][ks] = *(const bf16x8*)(qi + (long)(t0 + lr) * 512 + h * 64 + ks * 32 + g * 8);
    float wq[8];
    {
      const float4 w0 = *(const float4*)(widx + (long)(t0 + lr) * 8), w1 = *(const float4*)(widx + (long)(t0 + lr) * 8 + 4);
      wq[0] = w0.x; wq[1] = w0.y; wq[2] = w0.z; wq[3] = w0.w; wq[4] = w1.x; wq[5] = w1.y; wq[6] = w1.z; wq[7] = w1.w;
    }
    unsigned tauk = 0u;
    LAS unsigned* ckq = (LAS unsigned*)(smem + IX_CK) + lr * IX_CAP;
    LAS unsigned* cntq = (LAS unsigned*)(smem + IX_CNT) + lr;
    const u16* kb = kidx + (long)(b * SEQ) * 64;
    const int nkt = L >> 4;
    bf16x8 c0[2], c1[2];
    {
      int k0 = wv; k0 = k0 < nkt ? k0 : nkt - 1;
      c0[0] = *(const bf16x8*)((const char*)kb + (size_t)((unsigned)(k0 * 16 + lr) * 128u + (unsigned)g * 16u)); c0[1] = *(const bf16x8*)((const char*)kb + (size_t)((unsigned)(k0 * 16 + lr) * 128u + 64u + (unsigned)g * 16u));
    }
    __syncthreads();
    const int nti = ((nkt + 63) >> 6) * 8;
#pragma unroll 1
    for (int i = 0; i < nti; ++i) {
      {
        int k1 = wv + 8 * (i + 1); k1 = k1 < nkt ? k1 : nkt - 1;
        c1[0] = *(const bf16x8*)((const char*)kb + (size_t)((unsigned)(k1 * 16 + lr) * 128u + (unsigned)g * 16u)); c1[1] = *(const bf16x8*)((const char*)kb + (size_t)((unsigned)(k1 * 16 + lr) * 128u + 64u + (unsigned)g * 16u));
      }
      const int kt = wv + 8 * i;
      if (kt < nkt) {
        float s[4] = {0.f, 0.f, 0.f, 0.f};
#pragma unroll
        for (int h = 0; h < 8; ++h) {
          f32x4 d = mfma16(c0[0], a[h][0], (f32x4){0.f, 0.f, 0.f, 0.f}); d = mfma16(c0[1], a[h][1], d);
#pragma unroll
          for (int r = 0; r < 4; ++r) s[r] = fmaf(relu_raw(d[r]), wq[h], s[r]);
        }
        if (i < 16) {
#pragma unroll
          for (int r = 0; r < 4; ++r) { const int key = kt * 16 + g * 4 + r; ckq[key] = (fkey(s[r]) & 0xffffe000u) | (unsigned)(8191 - key); }
        } else {
          unsigned kk[4]; bool pr[4]; int np = 0;
#pragma unroll
          for (int r = 0; r < 4; ++r) {
            const int key = kt * 16 + g * 4 + r;
            kk[r] = (fkey(s[r]) & 0xffffe000u) | (unsigned)(8191 - key);
            pr[r] = kk[r] > tauk;
            np += pr[r] ? 1 : 0;
          }
          if (np > 0) {
            unsigned slot = __hip_atomic_fetch_add(cntq, (unsigned)np, __ATOMIC_RELAXED, __HIP_MEMORY_SCOPE_WORKGROUP);
#pragma unroll
            for (int r = 0; r < 4; ++r) { if (pr[r]) { if (slot < (unsigned)IX_CAP) ckq[slot] = kk[r]; ++slot; } }
          }
        }
      }
      c0[0] = c1[0]; c0[1] = c1[1];
      const bool last = (i + 1 >= nti);
      if ((i & 7) == 7 && (i >= 15 || last)) {
        __syncthreads();
#pragma unroll 1
        for (int qq = 0; qq < 2; ++qq) {
          const int q = wv * 2 + qq; const int n = (int)scnt[q];
          const int nn = n > IX_CAP ? IX_CAP : n;
          if (n > 1024) {
            quick_compact(smem, q, nn, lane);
            if (last) compact_query<8>(smem, q, (int)scnt[q], lane, wv);
          } else if (last && n > 512) compact_query<16>(smem, q, nn, lane, wv);
          else if (last && n > 256) compact_query<8>(smem, q, nn, lane, wv);
        }
        __syncthreads();
        tauk = stau[lr];
      }
    }
#pragma unroll 1
    for (int qq = 0; qq < 2; ++qq) emit_sorted(smem, wv * 2 + qq, sselw + qq * 256, lane, wv);
  } else {
#pragma unroll 1
    for (int qq = 0; qq < 2; ++qq) { u16* sel = sselw + qq * 256; for (int j = lane; j < 256; j += 64) sel[j] = (u16)(j < L ? j : 0); }
  }
  __syncthreads();
#pragma unroll 1
  for (int qq = 0; qq < 2; ++qq) attn_query(P, t0 + wv * 2 + qq, sselw + qq * 256, smem + wv * (32 * ATT_ROWB), sbias, (unsigned char*)(smem + DSA_SBK) + (wv * 2 + qq) * 256, lane);
}
__device__ __forceinline__ void dsa_queue_phase(const Params& P, char* smem, int bid, unsigned* qctr) {
  const int tidx = otid();
  const int tid = tidx;
  float* sbias = (float*)(smem + DSA_SBIAS);
  volatile int* sunit = (volatile int*)(smem + LDS_UNIT);
  const int pref = (int)(xb_xcc_id() & 3u);
  __syncthreads();
  for (int i = tid; i < 256; i += NTHR) sbias[i] = P.rel_bias[i];
  int qoff = 0;
  for (;;) {
    __syncthreads();
    if (otid() == 0) {
      int unit = -1; int qo = qoff;
      while (qo < 4) {
        const int bq = (pref + qo) & 3;
        const unsigned v = atomicAdd(qctr + bq * 64, 1u);
        if (v < 512u) { unit = bq * 512 + (511 - (int)v); break; }
        ++qo;
      }
      sunit[0] = unit; sunit[1] = qo;
    }
    __syncthreads();
    const int unit = sunit[0]; qoff = sunit[1];
    if (unit < 0) break;
    dsa_unit(P, smem, unit, bid);
  }
}

__device__ __forceinline__ void dn_prep_phase(const Params& P, int bid, int nblk) {
  const int tidx = otid();
  const int lane = tidx & 63, wv = tidx >> 6, hh = lane >> 4, cg = lane & 15;
  const u16* Pb = (const u16*)(P.ws + OFF_PB); const u16* Pa = (const u16*)(P.ws + OFF_PA);
  u16* qkv = (u16*)(P.ws + OFF_QKV);
  float* gg = (float*)(P.ws + OFF_GB); float* bt = gg + 16 * 8192;
  for (int chk = bid * 8 + wv; chk < T_TOK / 16; chk += nblk * 8) {
    const int t0 = chk * 16, b = t0 >> 13, pos0 = t0 & 8191;
    {
      const int ti = lane >> 2, h2 = lane & 3; const int t = t0 + ti;
      const float abv = bf2f(Pa[(long)t * 768 + 584 + h2]), bbv = bf2f(Pa[(long)t * 768 + 588 + h2]);
      const float z = abv + P.dt_bias[h2];
      const float sp = z > 20.f ? z : log1pf(__expf(z));
      gg[(long)(b * 4 + h2) * 8192 + pos0 + ti] = -__expf(P.A_log[h2]) * sp;
      bt[(long)(b * 4 + h2) * 8192 + pos0 + ti] = 1.f / (1.f + __expf(-bbv));
    }
#pragma unroll 1
    for (int sec = 0; sec < 3; ++sec) {
      const int col = sec * 512 + hh * 128 + cg * 8;
      u32x4 rows[19];
#pragma unroll
      for (int k = 0; k < 19; ++k) {
        u32x4 z = (u32x4){0u, 0u, 0u, 0u};
        if (k >= 3 || pos0 > 0) z = *(const u32x4*)(Pb + (long)(t0 - 3 + k) * 1536 + col);
        rows[k] = z;
      }
      float w[4][8];
#pragma unroll
      for (int j = 0; j < 4; ++j) {
        const float4 w0 = *(const float4*)(P.conv_w + j * 1536 + col), w1 = *(const float4*)(P.conv_w + j * 1536 + col + 4);
        w[j][0] = w0.x; w[j][1] = w0.y; w[j][2] = w0.z; w[j][3] = w0.w; w[j][4] = w1.x; w[j][5] = w1.y; w[j][6] = w1.z; w[j][7] = w1.w;
      }
      u16* dst = qkv + (long)sec * (16l * 8192 * 128) + ((long)(b * 4 + hh) * 8192 + pos0) * 128 + cg * 8;
#pragma unroll
      for (int i = 0; i < 16; ++i) {
        float y[8];
#pragma unroll
        for (int e = 0; e < 8; ++e) y[e] = 0.f;
#pragma unroll
        for (int j = 0; j < 4; ++j) {
          const u32x4 xv = rows[i + j];
          y[0] += w[j][0] * lo2f(xv[0]); y[1] += w[j][1] * hi2f(xv[0]); y[2] += w[j][2] * lo2f(xv[1]); y[3] += w[j][3] * hi2f(xv[1]);
          y[4] += w[j][4] * lo2f(xv[2]); y[5] += w[j][5] * hi2f(xv[2]); y[6] += w[j][6] * lo2f(xv[3]); y[7] += w[j][7] * hi2f(xv[3]);
        }
        float ss = 0.f;
#pragma unroll
        for (int e = 0; e < 8; ++e) { y[e] = y[e] * __builtin_amdgcn_rcpf(1.f + __expf(-y[e])); ss += y[e] * y[e]; }
        ss += sx(ss, 1); ss += sx(ss, 2); ss += sx(ss, 4); ss += sx(ss, 8);
        const float rn = rsqrtf(ss + EPSV);
        const float sc = sec == 0 ? rn * 0.08838834764831845f : (sec == 1 ? rn : 1.f);
        u32x4 o;
#pragma unroll
        for (int e = 0; e < 4; ++e) o[e] = pack2(y[2 * e] * sc, y[2 * e + 1] * sc);
        *(u32x4*)(dst + (long)i * 128) = o;
      }
    }
  }
}

__device__ __forceinline__ int perm32_pos(int c) {
  const int blk = c & ~31, w = c & 31;
  const int hi = w >> 4, gq = (w >> 2) & 3, lo = w & 3;
  return blk + gq * 8 + hi * 4 + lo;
}
__device__ __forceinline__ void dn_intra_phase(const Params& P, char* smem, int bid, int nblk) {
  const int tidx = otid();
  const int tid = tidx, lane = tid & 63, wv = tid >> 6, lr = lane & 15, g = lane >> 4;
  u16* qkv = (u16*)(P.ws + OFF_QKV);
  const float* gg = (const float*)(P.ws + OFF_GB); const float* bt = gg + 16 * 8192; float* cdec = (float*)(P.ws + OFF_GB) + 32 * 8192;
  u16* wdn = (u16*)(P.ws + OFF_WDN); u16* intra = (u16*)(P.ws + OFF_INTRA);
  char* sQ = smem;
  char* sK = smem + 16384;
  char* sV = smem + 32768;
  float* sMT = (float*)(smem + 49152);
  float* sG = (float*)(smem + 66560);
  float* sX = (float*)(smem + 67584);
  u16* sI = (u16*)(smem + 133632);
  float* sT = (float*)(smem + 141824);
  u32x4 pre[6]; float pgv = 0.f, pbv = 0.f;
  if (bid < 2048) {
    const int bh0 = bid >> 7, ch0 = bid & 127;
    const long tb0 = ((long)bh0 * 8192 + ch0 * 64) * 128;
#pragma unroll
    for (int k = 0; k < 6; ++k) {
      const int i = tid + k * NTHR;
      const int which = i >> 10, q = i & 1023;
      pre[k] = *(const u32x4*)(qkv + (long)which * (16l * 8192 * 128) + tb0 + q * 8);
    }
    if (tid < 64) { pgv = gg[(long)bh0 * 8192 + ch0 * 64 + tid]; pbv = bt[(long)bh0 * 8192 + ch0 * 64 + tid]; }
  }
  for (int u = bid; u < 2048; u += nblk) {
    const int tidl = otid();
    const int tid = tidl, lane = tid & 63, wv = tid >> 6, lr = lane & 15, g = lane >> 4;
    const int bh = u >> 7, ch = u & 127;
    const long tbase = ((long)bh * 8192 + ch * 64) * 128;
    u16* tq = qkv + tbase; u16* tk = qkv + 16l * 8192 * 128 + tbase; u16* tv = qkv + 32l * 8192 * 128 + tbase;
    __syncthreads();
#pragma unroll
    for (int k = 0; k < 6; ++k) {
      const int i = tid + k * NTHR;
      const int which = i >> 10, q = i & 1023, row = q >> 4, chk = q & 15;
      *(u32x4*)(smem + which * 16384 + row * 256 + ((chk ^ (row & 15)) << 4)) = pre[k];
    }
    if (tid < 64) {
      float sc = pgv;
#pragma unroll
      for (int o = 1; o < 64; o <<= 1) { const float t = su(sc, o); if (tid >= o) sc += t; }
      sG[tid] = sc; sG[64 + tid] = pbv;
    }
    __syncthreads();
    {
      const int mi = wv & 3; const char* sAop = (wv < 4) ? sK : sQ;
      bf16x8 a[4];
#pragma unroll
      for (int ks = 0; ks < 4; ++ks) { const int row = mi * 16 + lr; a[ks] = *(const bf16x8*)(sAop + row * 256 + (((ks * 4 + g) ^ (row & 15)) << 4)); }
#pragma unroll
      for (int ni = 0; ni < 4; ++ni) {
        f32x4 d = (f32x4){0.f, 0.f, 0.f, 0.f};
#pragma unroll
        for (int ks = 0; ks < 4; ++ks) { const int row = ni * 16 + lr; const bf16x8 bb = *(const bf16x8*)(sK + row * 256 + (((ks * 4 + g) ^ (row & 15)) << 4)); d = mfma16(a[ks], bb, d); }
        const int j = ni * 16 + lr; const float gj = sG[j];
#pragma unroll
        for (int r = 0; r < 4; ++r) {
          const int i = mi * 16 + g * 4 + r; const float gi = sG[i];
          if (wv < 4) { sMT[j * 68 + i] = (j < i) ? sG[64 + i] * d[r] * __expf(gi - gj) : 0.f; }
          else { const float v = (j <= i) ? d[r] * __expf(gi - gj) : 0.f; sI[i * 64 + perm32_pos(j)] = f2bf(v); }
        }
      }
    }
    __syncthreads();
    if (wv == 0) {
      const int bi = lane >> 4, c = lane & 15;
      float t[16];
#pragma unroll
      for (int r = 0; r < 16; ++r) t[r] = (r == c) ? 1.f : 0.f;
#pragma unroll
      for (int q = 0; q < 15; ++q) {
        const float* mcol = sMT + (bi * 16 + q) * 68 + bi * 16;
        float m[16];
#pragma unroll
        for (int q4 = (q + 1) >> 2; q4 < 4; ++q4) { const float4 tt = *(const float4*)(mcol + q4 * 4); m[q4 * 4] = tt.x; m[q4 * 4 + 1] = tt.y; m[q4 * 4 + 2] = tt.z; m[q4 * 4 + 3] = tt.w; }
#pragma unroll
        for (int r = q + 1; r < 16; ++r) t[r] = fmaf(-m[r], t[q], t[r]);
      }
#pragma unroll
      for (int r = 0; r < 16; ++r) sT[bi * 272 + r * 17 + c] = t[r];
    } else if (wv <= 4) {
      const int t2 = tid - 64;
      const float glast = sG[63];
      {
        const int row = t2 >> 2, blk = t2 & 3;
        const float eg = __expf(sG[row]);
        float e[32];
#pragma unroll
        for (int c4 = 0; c4 < 4; ++c4) {
          const u32x4 v = *(const u32x4*)(sQ + row * 256 + (((blk * 4 + c4) ^ (row & 15)) << 4));
#pragma unroll
          for (int k = 0; k < 4; ++k) { e[c4 * 8 + 2 * k] = lo2f(v[k]) * eg; e[c4 * 8 + 2 * k + 1] = hi2f(v[k]) * eg; }
        }
#pragma unroll
        for (int gq = 0; gq < 4; ++gq) {
          u32x4 o;
#pragma unroll
          for (int k = 0; k < 4; ++k) { const int j0 = 2 * k, j1 = 2 * k + 1; o[k] = pack2(e[16 * (j0 >> 2) + 4 * gq + (j0 & 3)], e[16 * (j1 >> 2) + 4 * gq + (j1 & 3)]); }
          *(u32x4*)(tq + row * 128 + blk * 32 + gq * 8) = o;
        }
      }
      {
        const int dk = t2 >> 1, blk = t2 & 1;
        float e[32];
#pragma unroll
        for (int ii = 0; ii < 32; ++ii) {
          const int i = blk * 32 + ii;
          e[ii] = bf2f(*(const u16*)(sK + i * 256 + (((dk >> 3) ^ (i & 15)) << 4) + (dk & 7) * 2)) * __expf(glast - sG[i]);
        }
#pragma unroll
        for (int gq = 0; gq < 4; ++gq) {
          u32x4 o;
#pragma unroll
          for (int k = 0; k < 4; ++k) { const int j0 = 2 * k, j1 = 2 * k + 1; o[k] = pack2(e[16 * (j0 >> 2) + 4 * gq + (j0 & 3)], e[16 * (j1 >> 2) + 4 * gq + (j1 & 3)]); }
          *(u32x4*)(tk + dk * 64 + blk * 32 + gq * 8) = o;
        }
      }
#pragma unroll
      for (int k = 0; k < 2; ++k) { const int q = t2 + k * 256; *(u32x4*)(intra + (long)u * 4096 + q * 8) = *(const u32x4*)(sI + q * 8); }
      if (t2 == 0) cdec[u] = __expf(glast);
    }
    __syncthreads();
    if (u + nblk < 2048) {
      const int u2 = u + nblk; const int bh2 = u2 >> 7, ch2 = u2 & 127;
      const long tb2 = ((long)bh2 * 8192 + ch2 * 64) * 128;
#pragma unroll
      for (int k = 0; k < 6; ++k) {
        const int i = tid + k * NTHR;
        const int which = i >> 10, q = i & 1023;
        pre[k] = *(const u32x4*)(qkv + (long)which * (16l * 8192 * 128) + tb2 + q * 8);
      }
      if (tid < 64) { pgv = gg[(long)bh2 * 8192 + ch2 * 64 + tid]; pbv = bt[(long)bh2 * 8192 + ch2 * 64 + tid]; }
    }
    {
      const bool isv = wv < 4;
      const char* sSrc = isv ? sV : sK;
      f32x4 X[4][2];
#pragma unroll
      for (int bi = 0; bi < 4; ++bi) {
        f32x4 acc[2];
#pragma unroll
        for (int ct = 0; ct < 2; ++ct) {
          const int cc = (wv & 3) * 32 + ct * 16 + lr;
#pragma unroll
          for (int r = 0; r < 4; ++r) {
            const int i = bi * 16 + g * 4 + r;
            const float raw = bf2f(*(const u16*)(sSrc + i * 256 + (((cc >> 3) ^ (i & 15)) << 4) + (cc & 7) * 2));
            acc[ct][r] = raw * sG[64 + i] * (isv ? 1.f : __expf(sG[i]));
          }
        }
#pragma unroll
        for (int bj = 0; bj < bi; ++bj)
#pragma unroll
          for (int s4 = 0; s4 < 4; ++s4) {
            const float a = -sMT[(bj * 16 + 4 * g + s4) * 68 + bi * 16 + lr];
            acc[0] = __builtin_amdgcn_mfma_f32_16x16x4f32(a, X[bj][0][s4], acc[0], 0, 0, 0);
            acc[1] = __builtin_amdgcn_mfma_f32_16x16x4f32(a, X[bj][1][s4], acc[1], 0, 0, 0);
          }
        f32x4 x0 = (f32x4){0.f, 0.f, 0.f, 0.f}, x1 = (f32x4){0.f, 0.f, 0.f, 0.f};
#pragma unroll
        for (int s4 = 0; s4 < 4; ++s4) {
          const float a = sT[bi * 272 + lr * 17 + 4 * g + s4];
          x0 = __builtin_amdgcn_mfma_f32_16x16x4f32(a, acc[0][s4], x0, 0, 0, 0);
          x1 = __builtin_amdgcn_mfma_f32_16x16x4f32(a, acc[1][s4], x1, 0, 0, 0);
        }
        X[bi][0] = x0; X[bi][1] = x1;
#pragma unroll
        for (int r = 0; r < 4; ++r) {
          sX[(bi * 16 + g * 4 + r) * 257 + wv * 32 + lr] = x0[r];
          sX[(bi * 16 + g * 4 + r) * 257 + wv * 32 + 16 + lr] = x1[r];
        }
      }
    }
    __syncthreads();
    for (int it = tid; it < 2048; it += NTHR) {
      u32x4 o;
      if (it < 1024) {
        const int c = it >> 3, i0 = (it & 7) * 8;
#pragma unroll
        for (int k = 0; k < 4; ++k) o[k] = pack2(sX[(i0 + 2 * k) * 257 + c], sX[(i0 + 2 * k + 1) * 257 + c]);
        *(u32x4*)(tv + c * 64 + i0) = o;
      } else {
        const int q = it - 1024, row = q >> 4, pch = q & 15, b32 = pch >> 2, gq = pch & 3;
        const float* xr = sX + row * 257 + 128 + b32 * 32 + 4 * gq;
#pragma unroll
        for (int k = 0; k < 4; ++k) { const int j0 = 2 * k, j1 = 2 * k + 1; o[k] = pack2(xr[16 * (j0 >> 2) + (j0 & 3)], xr[16 * (j1 >> 2) + (j1 & 3)]); }
        *(u32x4*)(wdn + tbase + row * 128 + pch * 8) = o;
      }
    }
  }
}

#define SCAN_BUF 73728
__device__ __forceinline__ void dn_scan_phase(const Params& P, char* smem, int bid, int nblk) {
  const int tidx = otid();
  const int tid = tidx, lane = tid & 63, wv = tid >> 6, lr = lane & 15, g = lane >> 4;
  const u16* qkv = (const u16*)(P.ws + OFF_QKV);
  const u16* wdn = (const u16*)(P.ws + OFF_WDN); const u16* intra = (const u16*)(P.ws + OFF_INTRA);
  const float* cdec = (const float*)(P.ws + OFF_GB) + 32 * 8192;
  u16* mix = (u16*)(P.ws + OFF_MIX);
  for (int bh = bid; bh < 16; bh += nblk) {
    const int b = bh >> 2, hh = bh & 3;
    f32x4 S[8];
#pragma unroll
    for (int i = 0; i < 8; ++i) S[i] = (f32x4){0.f, 0.f, 0.f, 0.f};
    u32x4 st[9];
    unsigned lofs[9];
#pragma unroll
    for (int i = 0; i < 9; ++i) {
      const int q = tid + i * NTHR;
      unsigned o;
      if (q < 1024) o = (unsigned)OFF_WDN + (unsigned)bh * (8192u * 256u) + q * 16;
      else if (q < 4096) o = (unsigned)OFF_QKV + (unsigned)((q >> 10) - 1) * (16u * 8192u * 256u) + (unsigned)bh * (8192u * 256u) + (q & 1023) * 16;
      else o = (unsigned)OFF_INTRA + (unsigned)bh * (128u * 8192u) + (q - 4096) * 16;
      lofs[i] = o;
    }
    const char* wsb = P.ws;
    auto load_chunk = [&](int n) {
#pragma unroll
      for (int i = 0; i < 9; ++i) {
        const unsigned stride = (i < 8) ? 16384u : 8192u;
        st[i] = *(const u32x4*)(wsb + (size_t)(lofs[i] + (unsigned)n * stride));
      }
    };
    auto store_chunk = [&](int bufi) {
      char* base = smem + bufi * SCAN_BUF;
#pragma unroll
      for (int i = 0; i < 9; ++i) {
        const int q = tid + i * NTHR;
        unsigned off;
        if (q < 2048) { const int qq = q & 1023, row = qq >> 4, chk = qq & 15; off = (q >> 10) * 16384 + row * 256 + ((chk ^ (row & 15)) << 4); }
        else if (q < 4096) { const int qq = q & 1023, row = qq >> 3, chk = qq & 7; off = (q >> 10) * 16384 + row * 128 + ((chk ^ (row & 7)) << 4); }
        else { const int qq = q - 4096, row = qq >> 3, chk = qq & 7; off = 65536 + row * 128 + ((chk ^ (row & 7)) << 4); }
        *(u32x4*)(base + off) = st[i];
      }
    };
    __syncthreads();
    load_chunk(0); store_chunk(0); load_chunk(1);
    __syncthreads();
    for (int n = 0; n < 128; ++n) {
      const char* base = smem + (n & 1) * SCAN_BUF;
      const char* sW = base; const char* sQd = base + 16384; const char* sKT = base + 32768; const char* sUT = base + 49152; const char* sA = base + 65536;
      if (n + 1 < 128) { store_chunk((n + 1) & 1); if (n + 2 < 128) load_chunk(n + 2); }
      const float dcy = cdec[bh * 128 + n];
      bf16x8 sb[4];
#pragma unroll
      for (int s = 0; s < 4; ++s)
#pragma unroll
        for (int j = 0; j < 8; ++j) sb[s][j] = (short)f2bf(S[2 * s + (j >> 2)][j & 3]);
      f32x4 vn[4], o[4];
#pragma unroll
      for (int mi = 0; mi < 4; ++mi) {
        f32x4 dw = (f32x4){0.f, 0.f, 0.f, 0.f}, dq = (f32x4){0.f, 0.f, 0.f, 0.f};
        const int row = mi * 16 + lr;
#pragma unroll
        for (int s = 0; s < 4; ++s) {
          const unsigned off = row * 256 + (((s * 4 + g) ^ (row & 15)) << 4);
          dw = mfma16(*(const bf16x8*)(sW + off), sb[s], dw);
          dq = mfma16(*(const bf16x8*)(sQd + off), sb[s], dq);
        }
        const int urow = wv * 16 + lr;
        const int ucol = mi * 16 + g * 4;
        const u32x2 uv = *(const u32x2*)(sUT + urow * 128 + ((((ucol >> 3)) ^ (urow & 7)) << 4) + (ucol & 7) * 2);
        vn[mi][0] = lo2f(uv[0]) - dw[0]; vn[mi][1] = hi2f(uv[0]) - dw[1]; vn[mi][2] = lo2f(uv[1]) - dw[2]; vn[mi][3] = hi2f(uv[1]) - dw[3];
        o[mi] = dq;
      }
      bf16x8 vb[2];
#pragma unroll
      for (int s = 0; s < 2; ++s)
#pragma unroll
        for (int j = 0; j < 8; ++j) vb[s][j] = (short)f2bf(vn[2 * s + (j >> 2)][j & 3]);
#pragma unroll
      for (int mi = 0; mi < 4; ++mi) {
        const int row = mi * 16 + lr;
#pragma unroll
        for (int s = 0; s < 2; ++s) o[mi] = mfma16(*(const bf16x8*)(sA + row * 128 + (((s * 4 + g) ^ (row & 7)) << 4)), vb[s], o[mi]);
      }
#pragma unroll
      for (int m2 = 0; m2 < 8; ++m2) {
        f32x4 d = S[m2];
#pragma unroll
        for (int r = 0; r < 4; ++r) d[r] *= dcy;
        const int row = m2 * 16 + lr;
#pragma unroll
        for (int s = 0; s < 2; ++s) d = mfma16(*(const bf16x8*)(sKT + row * 128 + (((s * 4 + g) ^ (row & 7)) << 4)), vb[s], d);
        S[m2] = d;
      }
#pragma unroll
      for (int mi = 0; mi < 4; ++mi)
#pragma unroll
        for (int r = 0; r < 4; ++r) {
          const long t = (long)b * 8192 + n * 64 + mi * 16 + g * 4 + r;
          mix[t * 1024 + 512 + hh * 128 + wv * 16 + lr] = f2bf(o[mi][r]);
        }
      __syncthreads();
    }
  }
}

__device__ __forceinline__ void dn_gate_phase(const Params& P, int bid, int nblk) {
  const int tidx = otid();
  const int lane = tidx & 63, wv = tidx >> 6, hh = lane >> 4, cg = lane & 15;
  u16* mix = (u16*)(P.ws + OFF_MIX); const u16* bz = (const u16*)(P.ws + OFF_BZ);
  float gn[8];
  {
    const float4 g0 = *(const float4*)(P.g_onorm + cg * 8), g1 = *(const float4*)(P.g_onorm + cg * 8 + 4);
    gn[0] = g0.x; gn[1] = g0.y; gn[2] = g0.z; gn[3] = g0.w; gn[4] = g1.x; gn[5] = g1.y; gn[6] = g1.z; gn[7] = g1.w;
  }
  for (int t0 = (bid * 8 + wv) * 4; t0 < T_TOK; t0 += nblk * 32) {
    u32x4 ov[4], zv[4];
#pragma unroll
    for (int k = 0; k < 4; ++k) {
      ov[k] = *(const u32x4*)(mix + (long)(t0 + k) * 1024 + 512 + hh * 128 + cg * 8);
      zv[k] = *(const u32x4*)(bz + (long)(t0 + k) * 512 + hh * 128 + cg * 8);
    }
#pragma unroll
    for (int k = 0; k < 4; ++k) {
      float o[8], z[8];
#pragma unroll
      for (int e = 0; e < 4; ++e) { o[2 * e] = lo2f(ov[k][e]); o[2 * e + 1] = hi2f(ov[k][e]); z[2 * e] = lo2f(zv[k][e]); z[2 * e + 1] = hi2f(zv[k][e]); }
      float ss = 0.f;
#pragma unroll
      for (int e = 0; e < 8; ++e) ss += o[e] * o[e];
      ss += sx(ss, 1); ss += sx(ss, 2); ss += sx(ss, 4); ss += sx(ss, 8);
      const float rs = rsqrtf(ss * (1.f / 128) + EPSV);
      u32x4 r;
#pragma unroll
      for (int e = 0; e < 4; ++e) {
        const float a = o[2 * e] * rs * gn[2 * e] * (z[2 * e] * __builtin_amdgcn_rcpf(1.f + __expf(-z[2 * e])));
        const float bq = o[2 * e + 1] * rs * gn[2 * e + 1] * (z[2 * e + 1] * __builtin_amdgcn_rcpf(1.f + __expf(-z[2 * e + 1])));
        r[e] = pack2(a, bq);
      }
      *(u32x4*)(mix + (long)(t0 + k) * 1024 + 512 + hh * 128 + cg * 8) = r;
    }
  }
}

__device__ __forceinline__ void xattn_phase(const Params& P, char* smem, int bid, int nblk) {
  const int tidx = otid();
  const int tid = tidx, lane = tid & 63, wv = tid >> 6, lr = lane & 15, g = lane >> 4;
  const u16* qx = (const u16*)(P.ws + OFF_QX); const u16* kx = (const u16*)(P.ws + OFF_KX); const u16* vtx = (const u16*)(P.ws + OFF_VTX);
  u16* ox = (u16*)(P.ws + OFF_OX);
  char* sK = smem; char* sVT = smem + 65536;
  for (int u4 = bid; u4 < 256; u4 += nblk) {
    const int bh = u4 >> 4, b = bh >> 2, hh = bh & 3, grp = u4 & 15;
    __syncthreads();
    for (int i = tid; i < 4096; i += NTHR) {
      const int row = i >> 4, ch = i & 15;
      *(u32x4*)(sK + row * 256 + ((ch ^ (row & 15)) << 4)) = *(const u32x4*)(kx + (long)(b * 256 + row) * 512 + hh * 128 + ch * 8);
    }
    for (int i = tid; i < 4096; i += NTHR) {
      const int row = i >> 5, ch = i & 31;
      *(u32x4*)(sVT + row * 512 + ((ch ^ (row & 15)) << 4)) = *(const u32x4*)(vtx + ((long)b * 512 + hh * 128 + row) * 256 + ch * 8);
    }
    __syncthreads();
    const LAS char* kbs[4]; const LAS char* vbs[8];
#pragma unroll
    for (int ks = 0; ks < 4; ++ks) kbs[ks] = (const LAS char*)sK + lr * 256 + (((ks * 4 + g) ^ lr) << 4);
#pragma unroll
    for (int s2 = 0; s2 < 8; ++s2) vbs[s2] = (const LAS char*)sVT + lr * 512 + (((s2 * 4 + g) ^ lr) << 4);
#pragma unroll 1
    for (int qt = 0; qt < 4; ++qt) {
      asm volatile("" ::: "memory");
      const int t0 = b * 8192 + grp * 512 + qt * 128 + wv * 16;
      bf16x8 bq[4];
#pragma unroll
      for (int ks = 0; ks < 4; ++ks) bq[ks] = *(const bf16x8*)(qx + (long)(t0 + lr) * 512 + hh * 128 + ks * 32 + g * 8);
      f32x4 S[16];
      float mx = -3.0e38f;
#pragma unroll
      for (int m = 0; m < 16; ++m) {
        f32x4 d = (f32x4){0.f, 0.f, 0.f, 0.f};
#pragma unroll
        for (int ks = 0; ks < 4; ++ks) { const bf16x8 a = *(const LAS bf16x8*)(kbs[ks] + m * 4096); d = mfma16(a, bq[ks], d); }
        S[m] = d;
#pragma unroll
        for (int r = 0; r < 4; ++r) mx = fmaxf(mx, d[r]);
      }
      mx = fmaxf(mx, sx(mx, 16)); mx = fmaxf(mx, sx(mx, 32));
      float sum = 0.f;
#pragma unroll
      for (int m = 0; m < 16; ++m)
#pragma unroll
        for (int r = 0; r < 4; ++r) { S[m][r] = __expf(S[m][r] - mx); sum += S[m][r]; }
      sum += sx(sum, 16); sum += sx(sum, 32);
      const float inv = 1.f / sum;
      bf16x8 pb[8];
#pragma unroll
      for (int s2 = 0; s2 < 8; ++s2)
#pragma unroll
        for (int j = 0; j < 8; ++j) pb[s2][j] = (short)f2bf(S[2 * s2 + (j >> 2)][j & 3]);
#pragma unroll
      for (int dt = 0; dt < 8; ++dt) {
        f32x4 o = (f32x4){0.f, 0.f, 0.f, 0.f};
#pragma unroll
        for (int s2 = 0; s2 < 8; ++s2) { const bf16x8 a = *(const LAS bf16x8*)(vbs[s2] + dt * 8192); o = mfma16(a, pb[s2], o); }
        u32x2 w; w[0] = pack2(o[0] * inv, o[1] * inv); w[1] = pack2(o[2] * inv, o[3] * inv);
        *(u32x2*)(ox + (long)(t0 + lr) * 512 + hh * 128 + dt * 16 + g * 4) = w;
      }
    }
  }
}

__device__ __forceinline__ void g6_phase(const Params& P, char* smem, int bid, int nblk) {
  const int tidx = otid();
  const u16* A = (const u16*)(P.ws + OFF_H); const u16* Bt = (const u16*)(P.ws + OFF_WEFFT);
  unsigned* plist = (unsigned*)(P.ws + OFF_PLIST);
  const int tid = tidx;
  for (int t = bid; t < 128 * 16; t += nblk) {
    const int mp = t >> 4, np = t & 15;
    gemm_tile<133>(A + (long)mp * 256 * DM, DM, Bt + (long)np * 128 * DM, DM, DM, smem);
    const float* sC = (const float*)smem;
    const int row = tid >> 1, half = tid & 1;
    const float rs2 = rsqrtf(((const float*)(P.ws + OFF_SSQ2))[mp * 256 + row] * (1.f / DM) + EPSV);
    unsigned tk[16];
#pragma unroll
    for (int i = 0; i < 16; ++i) tk[i] = 0u;
    for (int i = 0; i < 64; ++i) {
      const int c = half * 64 + ((i + half * 16) & 63);
      const unsigned key = (fkey(sC[row * 133 + c] * rs2) & ~127u) | (unsigned)(127 - c);
#pragma unroll
      for (int s = 15; s >= 1; --s) tk[s] = umed3(tk[s - 1], tk[s], key);
      tk[0] = tk[0] > key ? tk[0] : key;
    }
#pragma unroll
    for (int i = 0; i < 16; ++i) {
      const unsigned key = sx(tk[i], 1);
      if (half == 0) {
#pragma unroll
        for (int s = 15; s >= 1; --s) tk[s] = umed3(tk[s - 1], tk[s], key);
        tk[0] = tk[0] > key ? tk[0] : key;
      }
    }
    if (half == 0) {
      unsigned* dst = plist + ((long)(mp * 256 + row) * 16 + np) * 16;
#pragma unroll
      for (int i = 0; i < 4; ++i) { u32x4 o; o[0] = tk[4 * i]; o[1] = tk[4 * i + 1]; o[2] = tk[4 * i + 2]; o[3] = tk[4 * i + 3]; *(u32x4*)(dst + 4 * i) = o; }
    }
  }
}

__device__ __forceinline__ void peer_top16_phase(const Params& P, int bid, int nblk) {
  const int tidx = otid();
  const u16* psc = (const u16*)(P.ws + OFF_PSC);
  unsigned* plist = (unsigned*)(P.ws + OFF_PLIST);
  for (int gid = bid * NTHR + tidx; gid < T_TOK * 16; gid += nblk * NTHR) {
    const u16* src = psc + (long)gid * 128;
    unsigned tk[16];
#pragma unroll
    for (int i = 0; i < 16; ++i) tk[i] = 0u;
#pragma unroll 1
    for (int c8 = 0; c8 < 16; ++c8) {
      const u32x4 v = *(const u32x4*)(src + c8 * 8);
#pragma unroll
      for (int e = 0; e < 8; ++e) {
        const unsigned bits = (e & 1) ? (v[e >> 1] & 0xffff0000u) : (v[e >> 1] << 16);
        const unsigned m = bits ^ ((bits >> 31) ? 0xffffffffu : 0x80000000u);
        const unsigned key = (m & ~127u) | (unsigned)(127 - (c8 * 8 + e));
#pragma unroll
        for (int q = 15; q >= 1; --q) tk[q] = umed3(tk[q - 1], tk[q], key);
        tk[0] = tk[0] > key ? tk[0] : key;
      }
    }
    unsigned* dst = plist + (long)gid * 16;
#pragma unroll
    for (int i = 0; i < 4; ++i) { u32x4 o; o[0] = tk[4 * i]; o[1] = tk[4 * i + 1]; o[2] = tk[4 * i + 2]; o[3] = tk[4 * i + 3]; *(u32x4*)(dst + 4 * i) = o; }
  }
}
__device__ __forceinline__ void peer_combine_phase(const Params& P, char* smem, int bid, int nblk) {
  const int tidx = otid();
  const int tid = tidx;
  const unsigned* plist = (const unsigned*)(P.ws + OFF_PLIST);
  u16* pe = (u16*)(P.ws + OFF_PEIDX); float* pg = (float*)(P.ws + OFF_PGATE);
  unsigned* skeys = (unsigned*)smem + tid * 33;
  for (int gid = bid * NTHR + tid; gid < T_TOK * 8; gid += nblk * NTHR) {
    const unsigned* src = plist + (long)gid * 32;
    unsigned k1[16], k2[16];
#pragma unroll
    for (int q = 0; q < 4; ++q) {
      const u32x4 a = *(const u32x4*)(src + q * 4), c = *(const u32x4*)(src + 16 + q * 4);
      k1[4 * q] = a[0]; k1[4 * q + 1] = a[1]; k1[4 * q + 2] = a[2]; k1[4 * q + 3] = a[3];
      k2[4 * q] = c[0]; k2[4 * q + 1] = c[1]; k2[4 * q + 2] = c[2]; k2[4 * q + 3] = c[3];
    }
#pragma unroll
    for (int i = 0; i < 16; ++i) { skeys[i] = k1[i]; skeys[16 + i] = k2[i]; }
    float s1[16], s2[16];
#pragma unroll
    for (int i = 0; i < 16; ++i) { s1[i] = keyf(k1[i] & ~127u); s2[i] = keyf(k2[i] & ~127u); }
    unsigned tk[16];
#pragma unroll
    for (int i = 0; i < 16; ++i) tk[i] = 0u;
#pragma unroll
    for (int i = 0; i < 16; ++i)
#pragma unroll
      for (int j = 0; j < 16; ++j)
        if ((i + 1) * (j + 1) <= 16) {
          const unsigned key = (fkey(s1[i] + s2[j]) & ~255u) | (unsigned)(255 - (i * 16 + j));
#pragma unroll
          for (int s = 15; s >= 1; --s) tk[s] = umed3(tk[s - 1], tk[s], key);
          tk[0] = tk[0] > key ? tk[0] : key;
        }
    float best[16]; unsigned ex[16]; float mx = -3.0e38f;
#pragma unroll
    for (int k = 0; k < 16; ++k) {
      const int cid = 255 - (int)(tk[k] & 255u); const int i = cid >> 4, j = cid & 15;
      const unsigned ka = skeys[i], kb2 = skeys[16 + j];
      best[k] = keyf(ka & ~127u) + keyf(kb2 & ~127u);
      ex[k] = (unsigned)((127 - (int)(ka & 127u)) * 128 + (127 - (int)(kb2 & 127u)));
      mx = fmaxf(mx, best[k]);
    }
    float sm = 0.f;
#pragma unroll
    for (int k = 0; k < 16; ++k) { best[k] = __expf(best[k] - mx); sm += best[k]; }
    const float inv = 1.f / sm;
#pragma unroll
    for (int k4 = 0; k4 < 4; ++k4) { float4 o; o.x = best[4 * k4] * inv; o.y = best[4 * k4 + 1] * inv; o.z = best[4 * k4 + 2] * inv; o.w = best[4 * k4 + 3] * inv; *(float4*)(pg + (long)gid * 16 + 4 * k4) = o; }
#pragma unroll
    for (int k8 = 0; k8 < 2; ++k8) {
      u32x4 o;
#pragma unroll
      for (int e = 0; e < 4; ++e) o[e] = ex[8 * k8 + 2 * e] | (ex[8 * k8 + 2 * e + 1] << 16);
      *(u32x4*)(pe + (long)gid * 16 + 8 * k8) = o;
    }
  }
}
__device__ __forceinline__ void peer_fused_phase(const Params& P, char* smem, int bid, int nblk) {
  const int tidx = otid();
  const int tid = tidx, lane = tid & 63, wv = tid >> 6;
  const u16* psc = (const u16*)(P.ws + OFF_PSC);
  const u16* h3 = (const u16*)(P.ws + OFF_H);
  const unsigned char* ue = (const unsigned char*)(P.ws + OFF_UEMB); const unsigned char* ve = (const unsigned char*)(P.ws + OFF_VEMB);
  const float* uscl = (const float*)(P.ws + OFF_USCL); const float* vscl = (const float*)(P.ws + OFF_VSCL);
  unsigned* sL = (unsigned*)smem;
  u16* sE = (u16*)(smem + 32768);
  float* sG = (float*)(smem + 65536);
  for (int tb = bid * 128; tb < T_TOK; tb += nblk * 128) {
#pragma unroll 1
    for (int c = 0; c < 4; ++c) {
      __syncthreads();
      {
        const long gid = (long)(tb + c * 32) * 16 + tid;
        const u16* src = psc + gid * 128;
        unsigned tk[16];
#pragma unroll
        for (int i = 0; i < 16; ++i) tk[i] = 0u;
        u32x4 cur[4];
#pragma unroll
        for (int i = 0; i < 4; ++i) cur[i] = *(const u32x4*)(src + i * 8);
#pragma unroll 1
        for (int c4 = 0; c4 < 4; ++c4) {
          u32x4 nx[4];
          const int cn = c4 < 3 ? c4 + 1 : 3;
#pragma unroll
          for (int i = 0; i < 4; ++i) nx[i] = *(const u32x4*)(src + (cn * 4 + i) * 8);
#pragma unroll
          for (int i = 0; i < 4; ++i) {
            const u32x4 v = cur[i];
#pragma unroll
            for (int e = 0; e < 8; ++e) {
              const unsigned bits = (e & 1) ? (v[e >> 1] & 0xffff0000u) : (v[e >> 1] << 16);
              const unsigned m = bits ^ ((bits >> 31) ? 0xffffffffu : 0x80000000u);
              const unsigned key = (m & ~127u) | (unsigned)(127 - ((c4 * 4 + i) * 8 + e));
#pragma unroll
              for (int q = 15; q >= 1; --q) tk[q] = umed3(tk[q - 1], tk[q], key);
              tk[0] = tk[0] > key ? tk[0] : key;
            }
          }
#pragma unroll
          for (int i = 0; i < 4; ++i) cur[i] = nx[i];
        }
#pragma unroll
        for (int i = 0; i < 4; ++i) { u32x4 o; o[0] = tk[4 * i]; o[1] = tk[4 * i + 1]; o[2] = tk[4 * i + 2]; o[3] = tk[4 * i + 3]; *(u32x4*)(sL + tid * 16 + 4 * i) = o; }
      }
      __syncthreads();
      if (tid < 256) {
        const unsigned* kk = sL + tid * 32;
        float s1[16], s2[16];
#pragma unroll
        for (int i = 0; i < 16; ++i) { s1[i] = keyf(kk[i] & ~127u); s2[i] = keyf(kk[16 + i] & ~127u); }
        unsigned tk[16];
#pragma unroll
        for (int i = 0; i < 16; ++i) tk[i] = 0u;
#pragma unroll
        for (int i = 0; i < 16; ++i)
#pragma unroll
          for (int j = 0; j < 16; ++j)
            if ((i + 1) * (j + 1) <= 16) {
              const unsigned key = (fkey(s1[i] + s2[j]) & ~255u) | (unsigned)(255 - (i * 16 + j));
#pragma unroll
              for (int q = 15; q >= 1; --q) tk[q] = umed3(tk[q - 1], tk[q], key);
              tk[0] = tk[0] > key ? tk[0] : key;
            }
        float best[16]; unsigned ex[16]; float mx = -3.0e38f;
#pragma unroll
        for (int k = 0; k < 16; ++k) {
          const int cid = 255 - (int)(tk[k] & 255u); const int i = cid >> 4, j = cid & 15;
          const unsigned ka = kk[i], kb2 = kk[16 + j];
          best[k] = keyf(ka & ~127u) + keyf(kb2 & ~127u);
          ex[k] = (unsigned)((127 - (int)(ka & 127u)) * 128 + (127 - (int)(kb2 & 127u)));
          mx = fmaxf(mx, best[k]);
        }
        float sm = 0.f;
#pragma unroll
        for (int k = 0; k < 16; ++k) { best[k] = __expf(best[k] - mx); sm += best[k]; }
        const float inv = 1.f / sm;
        const int eo = (c * 32 + (tid >> 3)) * 128 + (tid & 7) * 16;
#pragma unroll
        for (int k4 = 0; k4 < 4; ++k4) { float4 o; o.x = best[4 * k4] * inv; o.y = best[4 * k4 + 1] * inv; o.z = best[4 * k4 + 2] * inv; o.w = best[4 * k4 + 3] * inv; *(float4*)(sG + eo + 4 * k4) = o; }
#pragma unroll
        for (int k8 = 0; k8 < 2; ++k8) {
          u32x4 o;
#pragma unroll
          for (int e = 0; e < 4; ++e) o[e] = ex[8 * k8 + 2 * e] | (ex[8 * k8 + 2 * e + 1] << 16);
          *(u32x4*)(sE + eo + 8 * k8) = o;
        }
      }
      else {
      unsigned char* xq8 = (unsigned char*)(P.ws + OFF_MIX); float* sxg = (float*)(P.ws + OFF_MIX + 40ull * MB);
      const int tq0 = tb + c * 32 + (wv - 4) * 8;
      u32x4 pv0 = *(const u32x4*)(h3 + (long)tq0 * DM + lane * 16), pv1 = *(const u32x4*)(h3 + (long)tq0 * DM + lane * 16 + 8);
      float pssq = ((const float*)(P.ws + OFF_SSQ2))[tq0];
#pragma unroll 1
      for (int it = 0; it < 8; ++it) {
        const int t = tq0 + it;
        const float rs2t = rsqrtf(pssq * (1.f / DM) + EPSV);
        const u32x4 v0 = pv0, v1 = pv1;
        {
          const int tn = tq0 + (it < 7 ? it + 1 : 7);
          pv0 = *(const u32x4*)(h3 + (long)tn * DM + lane * 16); pv1 = *(const u32x4*)(h3 + (long)tn * DM + lane * 16 + 8);
          pssq = ((const float*)(P.ws + OFF_SSQ2))[tn];
        }
        int xh0 = 0, xh1 = 0, xl0 = 0, xl1 = 0;
        float xa[16];
#pragma unroll
        for (int e = 0; e < 4; ++e) { xa[2 * e] = lo2f(v0[e]); xa[2 * e + 1] = hi2f(v0[e]); xa[8 + 2 * e] = lo2f(v1[e]); xa[8 + 2 * e + 1] = hi2f(v1[e]); }
        float am = 0.f;
#pragma unroll
        for (int e = 0; e < 16; ++e) am = fmaxf(am, fabsf(xa[e]));
#pragma unroll
        for (int o = 32; o >= 1; o >>= 1) am = fmaxf(am, sx(am, o));
        const float sxq = am > 0.f ? am * (1.f / 119.f) : 1.f;
        const float inv = 1.f / sxq;
#pragma unroll
        for (int e = 0; e < 16; ++e) {
          const int qv = (int)rintf(xa[e] * inv);
          const int lo = ((qv + 8) & 15) - 8, hi = (qv - lo) >> 4;
          const int sh4 = 4 * (e & 7);
          if (e < 8) { xl0 |= (lo & 15) << sh4; xh0 |= (hi & 15) << sh4; } else { xl1 |= (lo & 15) << sh4; xh1 |= (hi & 15) << sh4; }
        }
        unsigned char* dst = xq8 + (size_t)t * 1024 + (lane >> 1) * 32 + (lane & 1) * 8;
        u32x2 oh; oh[0] = (unsigned)xh0; oh[1] = (unsigned)xh1; *(u32x2*)dst = oh;
        u32x2 ol; ol[0] = (unsigned)xl0; ol[1] = (unsigned)xl1; *(u32x2*)(dst + 16) = ol;
        if (lane == 0) sxg[t] = sxq * rs2t;
      }
      }
    }
    __syncthreads();
    unsigned char* xq8 = (unsigned char*)(P.ws + OFF_MIX);
    float* sxg = (float*)(P.ws + OFF_MIX + 40ull * MB);
#define PEER_SH(tl) ((int*)(smem + ((tl) < 64 ? (tl) * 512 : 131072 + ((tl) - 64) * 512)))
    __threadfence();
    __syncthreads();
    {
      const int sub = lane >> 3, ch = lane & 7;
#pragma unroll 1
      for (int kq = 0; kq < 4; ++kq) {
        const unsigned char* uq = ue + (size_t)kq * (16384u * 128u) + ch * 16;
#pragma unroll 1
        for (int it = 0; it < 16; ++it) {
          const int tl = it * 8 + wv, t = tb + tl;
          const u32x4 xh = *(const u32x4*)(xq8 + (size_t)t * 1024 + kq * 256 + ch * 32), xl = *(const u32x4*)(xq8 + (size_t)t * 1024 + kq * 256 + ch * 32 + 16);
          unsigned idw[8];
#pragma unroll
          for (int i = 0; i < 2; ++i) { const u32x4 a = *(const u32x4*)(sE + tl * 128 + sub * 16 + 8 * i); idw[4 * i] = a[0]; idw[4 * i + 1] = a[1]; idw[4 * i + 2] = a[2]; idw[4 * i + 3] = a[3]; }
          const unsigned epair = ((const unsigned*)(sE + tl * 128))[lane];
          float su0 = 0.f, su1 = 0.f, sv0 = 0.f, sv1 = 0.f, sxs = 0.f;
          if (kq == 3) { su0 = uscl[epair & 0xffffu]; su1 = uscl[epair >> 16]; sv0 = vscl[epair & 0xffffu]; sv1 = vscl[epair >> 16]; sxs = sxg[t]; }
          u32x4 uu[16];
#pragma unroll
          for (int j = 0; j < 16; ++j) {
            const unsigned e = (j & 1) ? (idw[j >> 1] >> 16) : (idw[j >> 1] & 0xffffu);
            uu[j] = *(const u32x4*)(uq + (size_t)(e * 128u));
          }
          int pd[16];
#pragma unroll
          for (int j = 0; j < 16; ++j) {
            int ah = 0, al = 0;
#pragma unroll
            for (int d = 0; d < 4; ++d) { ah = __builtin_amdgcn_sdot8((int)uu[j][d], (int)xh[d], ah, false); al = __builtin_amdgcn_sdot8((int)uu[j][d], (int)xl[d], al, false); }
            pd[j] = (ah << 4) + al;
          }
          int r8[8], r4[4], r2[2];
          {
            const bool u2 = (lane & 4) != 0, u1 = (lane & 2) != 0, u0 = (lane & 1) != 0;
#pragma unroll
            for (int k = 0; k < 8; ++k) { const int mine = u2 ? pd[k + 8] : pd[k]; const int oth = u2 ? pd[k] : pd[k + 8]; r8[k] = mine + sx(oth, 4); }
#pragma unroll
            for (int k = 0; k < 4; ++k) { const int mine = u1 ? r8[k + 4] : r8[k]; const int oth = u1 ? r8[k] : r8[k + 4]; r4[k] = mine + sx(oth, 2); }
#pragma unroll
            for (int k = 0; k < 2; ++k) { const int mine = u0 ? r4[k + 2] : r4[k]; const int oth = u0 ? r4[k] : r4[k + 2]; r2[k] = mine + sx(oth, 1); }
          }
          int* hp = PEER_SH(tl) + lane * 2;
          if (kq > 0) { const u32x2 old = *(const u32x2*)hp; r2[0] += (int)old[0]; r2[1] += (int)old[1]; }
          if (kq < 3) { u32x2 o; o[0] = (unsigned)r2[0]; o[1] = (unsigned)r2[1]; *(u32x2*)hp = o; }
          else {
            float* gp = sG + tl * 128 + lane * 2;
            const float2 gate = *(const float2*)gp;
            const float d0 = (float)r2[0] * (su0 * sxs), d1 = (float)r2[1] * (su1 * sxs);
            const float a0 = 0.5f * d0 * (1.f + erff(d0 * 0.7071067811865475f)), a1 = 0.5f * d1 * (1.f + erff(d1 * 0.7071067811865475f));
            float2 cf; cf.x = gate.x * a0 * sv0; cf.y = gate.y * a1 * sv1;
            float cm = fmaxf(fabsf(cf.x), fabsf(cf.y));
#pragma unroll
            for (int o = 32; o >= 1; o >>= 1) cm = fmaxf(cm, sx(cm, o));
            const float scq = cm > 0.f ? cm * (1.f / 119.f) : 1.f;
            const float cinv = 1.f / scq;
            const int q0 = (int)rintf(cf.x * cinv), q1 = (int)rintf(cf.y * cinv);
            const int l0 = ((q0 + 8) & 15) - 8, h0 = (q0 - l0) >> 4, l1 = ((q1 + 8) & 15) - 8, h1 = (q1 - l1) >> 4;
            unsigned wl = ((unsigned)(l0 & 15) | ((unsigned)(l1 & 15) << 4)) << (8 * (lane & 3));
            unsigned wh = ((unsigned)(h0 & 15) | ((unsigned)(h1 & 15) << 4)) << (8 * (lane & 3));
            wl |= (unsigned)sx((int)wl, 1); wl |= (unsigned)sx((int)wl, 2);
            wh |= (unsigned)sx((int)wh, 1); wh |= (unsigned)sx((int)wh, 2);
            __builtin_amdgcn_wave_barrier();
            unsigned* cq = (unsigned*)(sG + tl * 128);
            if ((lane & 3) == 0) { cq[lane >> 2] = wh; cq[16 + (lane >> 2)] = wl; }
            if (lane == 0) sG[tl * 128 + 32] = scq;
          }
        }
      }
    }
#undef PEER_SH
    float4 gfin[4];
#pragma unroll
    for (int q = 0; q < 4; ++q) gfin[q] = *(const float4*)(P.g_final + lane * 16 + q * 4);
    u32x4 pv0 = *(const u32x4*)(h3 + (long)(tb + wv) * DM + lane * 16), pv1 = *(const u32x4*)(h3 + (long)(tb + wv) * DM + lane * 16 + 8);
    u32x2 vA[16], vB[16];
#define PEER_LD(dst, s) { const int s_ = (s) < 127 ? (s) : 127; const u16* si_ = sE + ((s_ >> 3) * 8 + wv) * 128 + (s_ & 7) * 16; \
      _Pragma("unroll") for (int k = 0; k < 16; ++k) { const unsigned eo = si_[k] * 512u + (unsigned)lane * 8u; dst[k] = *(const u32x2*)(ve + (size_t)eo); } }
#define PEER_TR8(W, T) { unsigned X_[8], Y_[8]; \
      _Pragma("unroll") for (int r_ = 0; r_ < 4; ++r_) { const unsigned a_ = W[r_], b_ = W[r_ + 4]; X_[r_] = __builtin_amdgcn_perm(b_, a_, 0x05040100u); X_[r_ + 4] = __builtin_amdgcn_perm(b_, a_, 0x07060302u); } \
      _Pragma("unroll") for (int g_ = 0; g_ < 8; g_ += 4) _Pragma("unroll") for (int r_ = 0; r_ < 2; ++r_) { const unsigned a_ = X_[g_ + r_], b_ = X_[g_ + r_ + 2]; \
        Y_[g_ + r_] = __builtin_amdgcn_perm(b_, a_, 0x06020400u); Y_[g_ + r_ + 2] = __builtin_amdgcn_perm(b_, a_, 0x07030501u); } \
      _Pragma("unroll") for (int g_ = 0; g_ < 8; g_ += 2) { const unsigned a_ = Y_[g_], b_ = Y_[g_ + 1]; T[g_] = (a_ & 0x0f0f0f0fu) | ((b_ & 0x0f0f0f0fu) << 4); T[g_ + 1] = ((a_ >> 4) & 0x0f0f0f0fu) | (b_ & 0xf0f0f0f0u); } }
#define PEER_ACC(vsrc, s) { const unsigned* cq_ = (const unsigned*)(sG + (((s) >> 3) * 8 + wv) * 128) + ((s) & 7) * 2; \
      const int ch0_ = (int)cq_[0], ch1_ = (int)cq_[1], cl0_ = (int)cq_[16], cl1_ = (int)cq_[17]; \
      _Pragma("unroll") for (int d = 0; d < 2; ++d) _Pragma("unroll") for (int rg = 0; rg < 2; ++rg) { \
        unsigned W_[8], T_[8]; \
        _Pragma("unroll") for (int r_ = 0; r_ < 8; ++r_) W_[r_] = vsrc[8 * rg + r_][d]; \
        PEER_TR8(W_, T_) \
        _Pragma("unroll") for (int i_ = 0; i_ < 8; ++i_) { acch[8 * d + i_] = __builtin_amdgcn_sdot8((int)T_[i_], rg ? ch1_ : ch0_, acch[8 * d + i_], false); \
                                                          accl[8 * d + i_] = __builtin_amdgcn_sdot8((int)T_[i_], rg ? cl1_ : cl0_, accl[8 * d + i_], false); } } }
    PEER_LD(vA, 0)
    int acch[16], accl[16];
#pragma unroll 1
    for (int s = 0; s < 128; s += 2) {
      PEER_LD(vB, s + 1)
      if ((s & 7) == 0) {
#pragma unroll
        for (int e = 0; e < 16; ++e) { acch[e] = 0; accl[e] = 0; }
      }
      PEER_ACC(vA, s)
      PEER_LD(vA, s + 2)
      PEER_ACC(vB, s + 1)
      if ((s & 7) == 6) {
        const int it = s >> 3, t = tb + it * 8 + wv;
        const float scq_t = sG[(it * 8 + wv) * 128 + 32];
        const u32x4 v0 = pv0, v1 = pv1;
        {
          const int tn = tb + (it < 15 ? it + 1 : 15) * 8 + wv;
          pv0 = *(const u32x4*)(h3 + (long)tn * DM + lane * 16); pv1 = *(const u32x4*)(h3 + (long)tn * DM + lane * 16 + 8);
        }
        float acc[16];
#pragma unroll
        for (int e = 0; e < 16; ++e) acc[e] = (float)(acch[e] * 16 + accl[e]) * scq_t;
        float* orow = P.out + (long)t * DM + lane * 16;
        float xr[16]; float ss = 0.f;
#pragma unroll
        for (int e = 0; e < 4; ++e) {
          xr[2 * e] = lo2f(v0[e]) + acc[2 * e]; xr[2 * e + 1] = hi2f(v0[e]) + acc[2 * e + 1];
          xr[8 + 2 * e] = lo2f(v1[e]) + acc[8 + 2 * e]; xr[8 + 2 * e + 1] = hi2f(v1[e]) + acc[8 + 2 * e + 1];
        }
#pragma unroll
        for (int e = 0; e < 16; ++e) ss += xr[e] * xr[e];
        ss = wave_sum(ss);
        const float rs = rsqrtf(ss * (1.f / DM) + EPSV);
#pragma unroll
        for (int q = 0; q < 4; ++q) {
          const float4 gf = gfin[q];
          float4 o; o.x = xr[q * 4 + 0] * rs * gf.x; o.y = xr[q * 4 + 1] * rs * gf.y; o.z = xr[q * 4 + 2] * rs * gf.z; o.w = xr[q * 4 + 3] * rs * gf.w;
          *(float4*)(orow + q * 4) = o;
        }
      }
    }
#undef PEER_LD
#undef PEER_TR8
#undef PEER_ACC
  }
}

__device__ __forceinline__ void cvt_one_row(const Params& P, int r, const float4 (&vin)[4], int lane) {
  if (r < 16384) {
    float x[16]; float am = 0.f, ss = 0.f;
#pragma unroll
    for (int i = 0; i < 4; ++i) {
      const float4 c = *(const float4*)(P.g_ffn + lane * 16 + i * 4);
      x[4 * i] = vin[i].x * c.x; x[4 * i + 1] = vin[i].y * c.y; x[4 * i + 2] = vin[i].z * c.z; x[4 * i + 3] = vin[i].w * c.w;
    }
#pragma unroll
    for (int e = 0; e < 16; ++e) { am = fmaxf(am, fabsf(x[e])); ss += x[e] * x[e]; }
#pragma unroll
    for (int o = 32; o >= 1; o >>= 1) { am = fmaxf(am, sx(am, o)); ss += sx(ss, o); }
    const float lim = fminf(am, 2.6f * sqrtf(ss * (1.f / DM)));
    const float sc = lim > 0.f ? lim * (1.f / 7.f) : 1.f;
    const float inv = 1.f / sc;
    u32x2 o;
#pragma unroll
    for (int d = 0; d < 2; ++d) {
      unsigned w = 0u;
#pragma unroll
      for (int i = 0; i < 8; ++i) {
        float qf = rintf(x[8 * d + i] * inv); qf = fminf(fmaxf(qf, -7.f), 7.f);
        w |= ((unsigned)(int)qf & 15u) << (4 * i);
      }
      o[d] = w;
    }
    *(u32x2*)((unsigned char*)(P.ws + OFF_UEMB) + (size_t)(lane >> 4) * (16384u * 128u) + (long)r * 128 + (lane & 15) * 8) = o;
    if (lane == 0) ((float*)(P.ws + OFF_USCL))[r] = sc;
  } else {
    const int rv = r - 16384;
    float x[16]; float am = 0.f, ss = 0.f;
#pragma unroll
    for (int i = 0; i < 4; ++i) { x[4 * i] = vin[i].x; x[4 * i + 1] = vin[i].y; x[4 * i + 2] = vin[i].z; x[4 * i + 3] = vin[i].w; }
#pragma unroll
    for (int e = 0; e < 16; ++e) { am = fmaxf(am, fabsf(x[e])); ss += x[e] * x[e]; }
#pragma unroll
    for (int o = 32; o >= 1; o >>= 1) { am = fmaxf(am, sx(am, o)); ss += sx(ss, o); }
    const float lim = fminf(am, 2.6f * sqrtf(ss * (1.f / DM)));
    const float sc = lim > 0.f ? lim * (1.f / 7.f) : 1.f;
    const float inv = 1.f / sc;
    u32x2 o;
#pragma unroll
    for (int d = 0; d < 2; ++d) {
      unsigned w = 0u;
#pragma unroll
      for (int i = 0; i < 8; ++i) {
        float qf = rintf(x[8 * d + i] * inv); qf = fminf(fmaxf(qf, -7.f), 7.f);
        w |= ((unsigned)(int)qf & 15u) << (4 * i);
      }
      o[d] = w;
    }
    *(u32x2*)((unsigned char*)(P.ws + OFF_VEMB) + (long)rv * 512 + lane * 8) = o;
    if (lane == 0) ((float*)(P.ws + OFF_VSCL))[rv] = sc;
  }
}
template <int K>
__device__ __forceinline__ void barrier_filler(const Params& P, int bid, int nblk) {
  const int tidf = otid();
  const int wvf = tidf >> 6, lane = tidf & 63;
  if (wvf != 0) {
    const int base = K * 3277, lim = (base + 3277 < 32768) ? base + 3277 : 32768;
#pragma unroll 1
    for (int r0 = base + bid * 7 + (wvf - 1); r0 < lim; r0 += 2 * nblk * 7) {
    const int r1 = r0 + nblk * 7;
    const bool ok0 = true, ok1 = r1 < lim;
    float4 va[4], vb[4];
    if (ok0) {
      const float* src = (r0 < 16384 ? P.u_emb + (long)r0 * DM : P.v_emb + (long)(r0 - 16384) * DM) + lane * 16;
#pragma unroll
      for (int i = 0; i < 4; ++i) va[i] = *(const float4*)(src + i * 4);
    }
    if (ok1) {
      const float* src = (r1 < 16384 ? P.u_emb + (long)r1 * DM : P.v_emb + (long)(r1 - 16384) * DM) + lane * 16;
#pragma unroll
      for (int i = 0; i < 4; ++i) vb[i] = *(const float4*)(src + i * 4);
    }
    if (ok0) cvt_one_row(P, r0, va, lane);
    if (ok1) cvt_one_row(P, r1, vb, lane);
    }
  }
}

#define XB_TMO      128
#define XB_XCNT(j)  (256  + 64 * (j))
#define XB_XSUB(j)  (1280 + 64 * (j))
#define XB_XGEN(j)  (2304 + 64 * (j))
#define XB_TOP      3328
#define XB_TOPGEN   3392
#define XCD_BAR_WORDS 3456
#define XB_SPIN_CAP (1u << 18)

__device__ __forceinline__ unsigned xb_ld(unsigned* p)              { return __hip_atomic_load(p, __ATOMIC_RELAXED, __HIP_MEMORY_SCOPE_AGENT); }
__device__ __forceinline__ unsigned xb_add(unsigned* p, unsigned v) { return __hip_atomic_fetch_add(p, v, __ATOMIC_RELAXED, __HIP_MEMORY_SCOPE_AGENT); }
__device__ __forceinline__ unsigned xb_xcc_id() { return (unsigned)__builtin_amdgcn_s_getreg((3 << 11) | 20) & 0xFu; }
#define XB_SPIN(cond, bar) do { unsigned _sp = 0; while (cond) { __builtin_amdgcn_s_sleep(1); \
    if ((++_sp & 255u) == 0u) { if (xb_ld(&(bar)[XB_TMO])) break; if (_sp > XB_SPIN_CAP) { atomicAdd(&(bar)[XB_TMO], 1u); break; } } } } while (0)

struct XcdBarrier {
    unsigned* bar; unsigned x;
    volatile LAS unsigned* st;
};

__device__ __forceinline__ XcdBarrier xcd_barrier_post(unsigned* bar, volatile LAS unsigned* st) {
    XcdBarrier b; b.bar = bar; b.x = xb_xcc_id(); b.st = st;
    if (threadIdx.x == 0) (void)xb_add(&bar[XB_XCNT(b.x)], 1u);
    return b;
}
__device__ __forceinline__ void xcd_barrier_complete(unsigned* bar, unsigned x, unsigned& nloc, unsigned& nx) {
    const unsigned G = gridDim.x * gridDim.y * gridDim.z;
    unsigned sum, cnt, mine, sp = 0u;
    for (;;) {
        sum = 0u; cnt = 0u; mine = 0u;
#pragma unroll
        for (unsigned j = 0; j < 16; ++j) { const unsigned c = xb_ld(&bar[XB_XCNT(j)]); sum += c; cnt += (c > 0u) ? 1u : 0u; mine = (j == x) ? c : mine; }
        if (sum == G) break;
        __builtin_amdgcn_s_sleep(1);
        if ((++sp & 255u) == 0u) { if (xb_ld(&bar[XB_TMO])) break; if (sp > XB_SPIN_CAP) { atomicAdd(&bar[XB_TMO], 1u); break; } }
    }
    nloc = mine > 0u ? mine : 1u; nx = cnt > 0u ? cnt : 1u;
}

__device__ __forceinline__ void xcd_barrier(const XcdBarrier& b) {
    asm volatile("s_waitcnt vmcnt(0)" ::: "memory");
    __syncthreads();
    if (threadIdx.x == 0) {
        unsigned* bar = b.bar;
        __builtin_amdgcn_s_waitcnt(0);
        unsigned nloc = b.st[0], nx = b.st[1];
        if (nloc == 0u) { xcd_barrier_complete(bar, b.x, nloc, nx); b.st[0] = nloc; b.st[1] = nx; }
        const unsigned old = xb_add(&bar[XB_XSUB(b.x)], 1u);
        const unsigned gen = old / nloc;
        if (old + 1u == (gen + 1u) * nloc) {
            __builtin_amdgcn_fence(__ATOMIC_RELEASE, "agent");
            asm volatile("s_waitcnt vmcnt(0)" ::: "memory");
            const unsigned og = xb_add(&bar[XB_TOP], 1u);
            const unsigned tg = og / nx;
            if (og + 1u == (tg + 1u) * nx) xb_add(&bar[XB_TOPGEN], 1u);
            else XB_SPIN(xb_ld(&bar[XB_TOPGEN]) == tg, bar);
            __builtin_amdgcn_fence(__ATOMIC_ACQUIRE, "agent");
            xb_add(&bar[XB_XGEN(b.x)], 1u);
            asm volatile("s_waitcnt vmcnt(0)" ::: "memory");
        } else {
            XB_SPIN(xb_ld(&bar[XB_XGEN(b.x)]) == gen, bar);
            __builtin_amdgcn_fence(__ATOMIC_ACQUIRE, "agent");
            asm volatile("s_waitcnt vmcnt(0)" ::: "memory");
        }
    }
    __syncthreads();
}

template <int K>
__device__ __forceinline__ void xcd_barrier_fill(const XcdBarrier& b, const Params& P, int bid, int nblk) {
    asm volatile("s_waitcnt vmcnt(0)" ::: "memory");
    __syncthreads();
    if (threadIdx.x == 0) {
        unsigned* bar = b.bar;
        __builtin_amdgcn_s_waitcnt(0);
        unsigned nloc = b.st[0], nx = b.st[1];
        if (nloc == 0u) { xcd_barrier_complete(bar, b.x, nloc, nx); b.st[0] = nloc; b.st[1] = nx; }
        const unsigned old = xb_add(&bar[XB_XSUB(b.x)], 1u);
        const unsigned gen = old / nloc;
        if (old + 1u == (gen + 1u) * nloc) {
            __builtin_amdgcn_fence(__ATOMIC_RELEASE, "agent");
            asm volatile("s_waitcnt vmcnt(0)" ::: "memory");
            const unsigned og = xb_add(&bar[XB_TOP], 1u);
            const unsigned tg = og / nx;
            if (og + 1u == (tg + 1u) * nx) xb_add(&bar[XB_TOPGEN], 1u);
            else XB_SPIN(xb_ld(&bar[XB_TOPGEN]) == tg, bar);
            __builtin_amdgcn_fence(__ATOMIC_ACQUIRE, "agent");
            xb_add(&bar[XB_XGEN(b.x)], 1u);
            asm volatile("s_waitcnt vmcnt(0)" ::: "memory");
        } else {
            XB_SPIN(xb_ld(&bar[XB_XGEN(b.x)]) == gen, bar);
            __builtin_amdgcn_fence(__ATOMIC_ACQUIRE, "agent");
            asm volatile("s_waitcnt vmcnt(0)" ::: "memory");
        }
    }
    barrier_filler<K>(P, bid, nblk);
    __syncthreads();
}

__device__ __forceinline__ GemmP mk_gemm(const u16* A, long lda, long a_bs, const u16* Bt, long ldb, long b_bs, u16* C, long ldc, long c_bs, int M, int N, int K, int nbatch, float scale, int ncols, int tstore) {
  GemmP g; g.A = A; g.lda = lda; g.a_bs = a_bs; g.Bt = Bt; g.ldb = ldb; g.b_bs = b_bs; g.C = C; g.ldc = ldc; g.c_bs = c_bs; g.M = M; g.N = N; g.K = K; g.nbatch = nbatch; g.scale = scale; g.ncols = ncols; g.tstore = tstore;
  return g;
}
#define QCTR_WORD (XCD_BAR_WORDS + 64)

__global__ void __launch_bounds__(NTHR, 2) mega(Params P, CvtJobs J1, CvtJobs J2) {
  extern __shared__ __attribute__((aligned(16))) char smem[];
  const int bid = blockIdx.x, nblk = gridDim.x, rbid = nblk - 1 - bid;
  char* ws = P.ws;
  unsigned* barw = (unsigned*)(ws + OFF_BAR);
  if (threadIdx.x == 0) *(uint4*)(smem + LDS_XB) = make_uint4(0u, 0u, 0u, 0u);
  __syncthreads();
  (void)xcd_barrier_post(barw, (volatile LAS unsigned*)(smem + LDS_XB));
#define GRID_SYNC() do { XcdBarrier bar_; bar_.bar = (unsigned*)(P.ws + OFF_BAR); bar_.x = xb_xcc_id(); bar_.st = (volatile LAS unsigned*)(smem + LDS_XB); xcd_barrier(bar_); } while (0)
#define GRID_SYNC_F(K) do { XcdBarrier bar_; bar_.bar = (unsigned*)(P.ws + OFF_BAR); bar_.x = xb_xcc_id(); bar_.st = (volatile LAS unsigned*)(smem + LDS_XB); xcd_barrier_fill<K>(bar_, P, bid, nblk); } while (0)

  {
    const int gt = bid * NTHR + otid(), gn = nblk * NTHR;
    const u32x4 z4 = (u32x4){0u, 0u, 0u, 0u};
    u32x4* wz = (u32x4*)(ws + OFF_WINT + 592ull * 1024 * 2);
    for (int i = gt; i < 176 * 1024 * 2 / 16; i += gn) wz[i] = z4;
    for (int i = gt; i < 8 * 64 * 256 * 2 / 16; i += gn) { const int h = i / (64 * 256 * 2 / 16), r = i % (64 * 256 * 2 / 16); ((u32x4*)(ws + OFF_WUVT + (size_t)h * 128 * 256 * 2 + 64 * 256 * 2))[r] = z4; }
    u32x4* sz = (u32x4*)(ws + OFF_SSQ1);
    for (int i = gt; i < 2 * 256 * 1024 / 16; i += gn) sz[i] = z4;
  }
#pragma unroll 1
  for (int s0 = 0; s0 < 2; ++s0) {
    if ((s0 ^ ((bid >> 3) & 1)) == 0) cvt_run(J1, smem, bid, nblk);
    else {
      rmsnorm_rows(P.x, P.g_mix, (u16*)(ws + OFF_H), T_TOK, bid, nblk);
      rmsnorm_rows(P.mem, P.g_mem, (u16*)(ws + OFF_MEMN), 1024, rbid, nblk);
    }
  }
  GRID_SYNC_F(0);

  {
    const GemmP g = mk_gemm((u16*)(ws + OFF_WUK), 512, 64, (u16*)(ws + OFF_WUQ), 512, 64, (u16*)(ws + OFF_WG2T) + 512l * 256, 256, 256l * 256, 256, 256, 64, 8, 0.125f, 128, 0);
    gemm_bf16_phase(g, smem, rbid, nblk);
  }
  {
    const GemmP g = mk_gemm((u16*)(ws + OFF_WPQ), 2048, 128, (u16*)(ws + OFF_SUBK), 128, 128l * 128, (u16*)(ws + OFF_WEFFT), 1024, 128l * 1024, 1024, 128, 128, 16, 1.f, 128, 1);
    gemm_bf16_phase(g, smem, rbid - 16 < 0 ? rbid - 16 + nblk : rbid - 16, nblk);
  }
  {
    const GemmP g = mk_gemm((u16*)(ws + OFF_MEMN), 1024, 0, (u16*)(ws + OFF_WKT), 1024, 0, (u16*)(ws + OFF_KX), 512, 0, 1024, 512, 1024, 1, 1.f, 128, 0);
    gemm_bf16_phase(g, smem, rbid - 80 < 0 ? rbid - 80 + nblk : rbid - 80, nblk);
  }
  {
    const GemmP g = mk_gemm((u16*)(ws + OFF_WVT), 1024, 0, (u16*)(ws + OFF_MEMN), 1024, 256l * 1024, (u16*)(ws + OFF_VTX), 256, 512l * 256, 512, 256, 1024, 4, 1.f, 128, 2);
    gemm_bf16_phase(g, smem, rbid - 96 < 0 ? rbid - 96 + nblk : rbid - 96, nblk);
  }
  { EpiG1 e; e.ws = ws; pg_phase((const u16*)(ws + OFF_H), (const u16*)(ws + OFF_WINT), T_TOK, 2816, 1024, e, smem, bid, nblk); }
  GRID_SYNC_F(1);

  if ((bid >> 3) & 1) { dn_prep_phase(P, bid, nblk); dsa_prep_phase(P, bid, nblk); }
  else { dsa_prep_phase(P, bid, nblk); dn_prep_phase(P, bid, nblk); }
  GRID_SYNC_F(2);

#pragma unroll 1
  for (int s3 = 0; s3 < 2; ++s3) {
    if ((s3 ^ ((bid >> 3) & 1)) == 0) dn_intra_phase(P, smem, bid, nblk);
    else { EpiG2 e; e.qi = (u16*)(ws + OFF_QI); e.qlat = (u16*)P.out; pg_phase((const u16*)(ws + OFF_CQN), (const u16*)(ws + OFF_WG2T), T_TOK, 2560, 256, e, smem, bid, nblk); }
  }
  GRID_SYNC_F(3);

  if (bid < 16) dn_scan_phase(P, smem, bid, 16);
  dsa_queue_phase(P, smem, bid, (unsigned*)(P.ws + OFF_BAR) + QCTR_WORD);
  GRID_SYNC_F(4);

#pragma unroll 1
  for (int s5 = 0; s5 < 2; ++s5) {
    if ((s5 ^ ((bid >> 3) & 1)) == 0) dn_gate_phase(P, bid, nblk);
    else {
      const GemmP g = mk_gemm((u16*)P.out, 2048, 256, (u16*)(ws + OFF_WUVT), 256, 128l * 256, (u16*)(ws + OFF_MIX), 1024, 64, T_TOK, 128, 256, 8, 1.f, 64, 0);
      gemm_bf16_phase(g, smem, bid, nblk);
    }
  }
  GRID_SYNC_F(5);

  { EpiResidB<true> e; e.R = P.x; e.hb = (u16*)(ws + OFF_H); e.ssq = (float*)(ws + OFF_SSQ1); pg_phase((const u16*)(ws + OFF_MIX), (const u16*)(ws + OFF_WOUTT), T_TOK, 1024, 1024, e, smem, bid, nblk); }
  GRID_SYNC_F(6);
  { EpiB16 e; e.O = (u16*)(ws + OFF_QX); e.ldc = 512; e.ssq = (const float*)(ws + OFF_SSQ1); pg_phase((const u16*)(ws + OFF_H), (const u16*)(ws + OFF_WQT), T_TOK, 512, 1024, e, smem, bid, nblk); }
  GRID_SYNC_F(7);
  xattn_phase(P, smem, bid, nblk);
  GRID_SYNC_F(8);
  { EpiResidB<false> e; e.R = nullptr; e.hb = (u16*)(ws + OFF_H); e.ssq = (float*)(ws + OFF_SSQ2); pg_phase((const u16*)(ws + OFF_OX), (const u16*)(ws + OFF_WOT), T_TOK, 1024, 512, e, smem, bid, nblk); }
  GRID_SYNC_F(9);
  { EpiB16 e; e.O = (u16*)(ws + OFF_PSC); e.ldc = 2048; e.ssq = (const float*)(ws + OFF_SSQ2); pg_phase((const u16*)(ws + OFF_H), (const u16*)(ws + OFF_WEFFT), T_TOK, 2048, 1024, e, smem, bid, nblk); }
  GRID_SYNC();
  peer_fused_phase(P, smem, bid, nblk);
}

static void add_job(CvtJobs& J, const float* src, u16* dst, int R, int C, long sld, long dld, float scale, int tr, const float* rowscale = nullptr) {
  CvtJob& j = J.j[J.n++]; j.src = src; j.dst = dst; j.rowscale = rowscale; j.R = R; j.C = C; j.sld = sld; j.dld = dld; j.scale = scale; j.transpose = tr;
}

extern "C" void kernel_launch(void* const* d_in, const int* in_sizes, int n_in, void* d_out, int out_size, void* d_ws, size_t ws_size, hipStream_t stream) {
  if (ws_size < WS_NEED) { fprintf(stderr, "workspace too small: %zu < %llu\n", ws_size, (unsigned long long)WS_NEED); return; }
  Params P; memset(&P, 0, sizeof(P));
  const float** pp = (const float**)&P;
  for (int i = 0; i < 29; ++i) pp[i] = (const float*)d_in[i];
  P.out = (float*)d_out; P.ws = (char*)d_ws;
  char* ws = (char*)d_ws;
  static int grid = 0;
  if (!grid) {
    int dev = 0, cus = 0, per_cu = 0;
    (void)hipGetDevice(&dev);
    (void)hipDeviceGetAttribute(&cus, hipDeviceAttributeMultiprocessorCount, dev);
    (void)hipFuncSetAttribute((const void*)mega, hipFuncAttributeMaxDynamicSharedMemorySize, LDS_TOTAL);
    (void)hipOccupancyMaxActiveBlocksPerMultiprocessor(&per_cu, (const void*)mega, NTHR, LDS_TOTAL);
    grid = cus * (per_cu < 1 ? per_cu : 1);
    if (grid <= 0) { fprintf(stderr, "mega kernel not launchable (cus %d, per_cu %d)\n", cus, per_cu); grid = 0; return; }
  }
  (void)hipMemsetAsync(ws + OFF_BAR, 0, 16384, stream);
  CvtJobs J1; memset(&J1, 0, sizeof(J1));
  CvtJobs J2; memset(&J2, 0, sizeof(J2));
  {
    u16* winT = (u16*)(ws + OFF_WINT);
    add_job(J1, P.w_in, winT, 1024, 584, 2640, 1024, 1.f, 1);
    add_job(J1, P.w_in + 2632, winT + 584l * 1024, 1024, 8, 2640, 1024, 1.f, 1);
    add_job(J1, P.w_in + 584, winT + 768l * 1024, 1024, 1536, 2640, 1024, 1.f, 1);
    add_job(J1, P.w_in + 2120, winT + 2304l * 1024, 1024, 512, 2640, 1024, 1.f, 1);
    add_job(J1, P.w_iq, (u16*)(ws + OFF_WG2T), 256, 512, 512, 256, 1.f, 1);
    add_job(J1, P.w_uq, (u16*)(ws + OFF_WUQ), 256, 512, 512, 512, 1.f, 0);
    add_job(J1, P.w_uk, (u16*)(ws + OFF_WUK), 256, 512, 512, 512, 1.f, 0);
    for (int h = 0; h < 8; ++h) add_job(J1, P.w_uv + h * 64, (u16*)(ws + OFF_WUVT) + h * 128l * 256, 256, 64, 512, 256, 1.f, 1);
    add_job(J1, P.w_out, (u16*)(ws + OFF_WOUTT), 1024, 1024, 1024, 1024, 1.f, 1);
    add_job(J1, P.wq_x, (u16*)(ws + OFF_WQT), 1024, 512, 512, 1024, 0.08838834764831845f, 1, P.g_cross);
    add_job(J1, P.wk_x, (u16*)(ws + OFF_WKT), 1024, 512, 512, 1024, 1.f, 1);
    add_job(J1, P.wv_x, (u16*)(ws + OFF_WVT), 1024, 512, 512, 1024, 1.f, 1);
    add_job(J1, P.wo_x, (u16*)(ws + OFF_WOT), 512, 1024, 1024, 512, 1.f, 1);
    add_job(J1, P.w_pq, (u16*)(ws + OFF_WPQ), 1024, 2048, 2048, 2048, 1.f, 0, P.g_ffn);
    add_job(J1, P.sub_keys, (u16*)(ws + OFF_SUBK), 2048, 128, 128, 128, 1.f, 0);
    add_job(J2, P.u_emb, (u16*)(ws + OFF_UEMB), 16384, 1024, 1024, 1024, 1.f, 0);
    add_job(J2, P.v_emb, (u16*)(ws + OFF_VEMB), 16384, 1024, 1024, 1024, 1.f, 0);
  }
  hipLaunchKernelGGL(mega, dim3(grid), dim3(NTHR), LDS_TOTAL, stream, P, J1, J2);
}
```
